# Optimizing an MI355X kernel written in HIP

```python
import math
import jax, jax.numpy as jnp
from jax import lax
import numpy as np

D_MODEL = 2048
BATCH = 16
SEQ = 2048
DEPTH = 2

MEM_LEN = 256
D_FF = 5632
BLK = 128
MLA_HEADS = 8
Q_LORA = 512
KV_LORA = 512
NOPE_DIM = 128
ROPE_DIM = 64
MLA_V_DIM = 128
ROPE_THETA = 10000.0
SGU_CHUNK = 128
SGU_GROUPS = 4
SGU_GROUP_DIM = 128
SGU_WIDTH = SGU_GROUPS * SGU_GROUP_DIM
DIL_PATTERNS = ((128, 1), (512, 4), (2048, 16))
DIL_HEADS_PER_GROUP = 4
DIL_HEAD_DIM = 128
DIL_HEADS = DIL_HEADS_PER_GROUP * len(DIL_PATTERNS)
REL_BUCKETS = 32
REL_MAX_DIST = 2048
XA_HEADS = 4
XA_HEAD_DIM = 128
N_BRANCH = 3
MLA_OUT = MLA_HEADS * MLA_V_DIM
SGU_OUT = SGU_WIDTH
DIL_OUT = DIL_HEADS_PER_GROUP * DIL_HEAD_DIM
MIX_WIDTH = MLA_OUT + SGU_OUT + DIL_OUT
IN_SPLITS = (Q_LORA, KV_LORA, ROPE_DIM, 2 * SGU_WIDTH, 3 * DIL_HEADS * DIL_HEAD_DIM, N_BRANCH * D_MODEL)
N_IN = sum(IN_SPLITS)
ALPHA = (2 * DEPTH) ** 0.25
BETA = (8 * DEPTH) ** -0.25
LN_EPS = 1e-5
RMS_EPS = 1e-6
NEG_INF = -1e30

kernel_name = 'hybrid_mla_sgu_dilated_deepnorm'


def layer_norm(x, g, b):
    xf = x.astype(jnp.float32)
    mu = jnp.mean(xf, -1, keepdims=True)
    var = jnp.mean(jnp.square(xf - mu), -1, keepdims=True)
    return ((xf - mu) * lax.rsqrt(var + LN_EPS)).astype(x.dtype) * g + b


def rms_norm(x, g):
    xf = x.astype(jnp.float32)
    return (xf * lax.rsqrt(jnp.mean(jnp.square(xf), -1, keepdims=True) + RMS_EPS)).astype(x.dtype) * g


def swiglu(x, wg, wu, wd):
    return (jax.nn.silu(x @ wg) * (x @ wu)) @ wd


def rope_tables(seq, dtype):
    inv = ROPE_THETA ** (-jnp.arange(0, ROPE_DIM, 2, dtype=jnp.float32) / ROPE_DIM)
    ang = jnp.arange(seq, dtype=jnp.float32)[:, None] * inv[None, :]
    return jnp.cos(ang).astype(dtype), jnp.sin(ang).astype(dtype)


def apply_rope(t, cos, sin):
    half = t.shape[-1] // 2
    t1, t2 = t[..., :half], t[..., half:]
    c, s = cos[None, :, None, :], sin[None, :, None, :]
    return jnp.concatenate([t1 * c - t2 * s, t1 * s + t2 * c], axis=-1)


def t5_bucket(dist):
    exact = REL_BUCKETS // 2
    df = jnp.maximum(dist, 1).astype(jnp.float32)
    large = exact + (jnp.log(df / exact) / math.log(REL_MAX_DIST / exact) * (REL_BUCKETS - exact)).astype(jnp.int32)
    large = jnp.minimum(large, REL_BUCKETS - 1)
    return jnp.where(dist < exact, dist, large)


def causal_block_attention(q, k, v, scale):
    B, S, H, Dk = q.shape
    nb = S // BLK
    qb = q.reshape(B, nb, BLK, H, Dk).transpose(1, 0, 2, 3, 4)
    kpos = jnp.arange(S)

    def one_block(args):
        qblk, i = args
        s = jnp.einsum('bqhd,bkhd->bhqk', qblk, k).astype(jnp.float32) * scale
        qpos = i * BLK + jnp.arange(BLK)
        s = jnp.where(kpos[None, :] <= qpos[:, None], s, NEG_INF)
        p = jax.nn.softmax(s, axis=-1).astype(v.dtype)
        return jnp.einsum('bhqk,bkhd->bqhd', p, v)

    o = lax.map(one_block, (qb, jnp.arange(nb)))
    return o.transpose(1, 0, 2, 3, 4).reshape(B, S, H, v.shape[-1])


def dilated_group_attention(q, k, v, rel_tab, dil, band):
    B, S, Hg, Dh = q.shape
    L = S // dil
    nb = -(-L // BLK)
    Lp = nb * BLK

    def to_sub(t, front):
        t = t.reshape(B, L, dil, Hg, Dh).transpose(0, 2, 1, 3, 4)
        return jnp.pad(t, ((0, 0), (0, 0), (front, Lp - L), (0, 0), (0, 0)))

    def band_keys(tp):
        prev = tp[:, :, :Lp].reshape(B, dil, nb, BLK, Hg, Dh)
        cur = tp[:, :, BLK:].reshape(B, dil, nb, BLK, Hg, Dh)
        return jnp.concatenate([prev, cur], axis=3)

    qs = to_sub(q, 0).reshape(B, dil, nb, BLK, Hg, Dh)
    kb = band_keys(to_sub(k, BLK))
    vb = band_keys(to_sub(v, BLK))
    qi = jnp.arange(BLK)[:, None]
    ki = jnp.arange(2 * BLK)[None, :]
    j = qi + BLK - ki
    in_band = (j >= 0) & (j <= band)
    bias = rel_tab[t5_bucket(jnp.maximum(j, 0) * dil)].astype(jnp.float32).transpose(2, 0, 1)
    key_real = (jnp.arange(nb)[:, None] > 0) | (ki >= BLK)
    mask = in_band[None] & key_real[:, None, :]
    s = jnp.einsum('brnqhd,brnkhd->brnhqk', qs, kb).astype(jnp.float32) * (DIL_HEAD_DIM ** -0.5) + bias
    s = jnp.where(mask[None, None, :, None], s, NEG_INF)
    lse = jax.nn.logsumexp(s, axis=-1)
    p = jnp.exp(s - lse[..., None]).astype(v.dtype)
    o = jnp.einsum('brnhqk,brnkhd->brnqhd', p, vb)
    o = o.reshape(B, dil, Lp, Hg, Dh)[:, :, :L].transpose(0, 2, 1, 3, 4).reshape(B, S, Hg, Dh)
    lse = lse.transpose(0, 1, 2, 4, 3).reshape(B, dil, Lp, Hg)[:, :, :L].transpose(0, 2, 1, 3).reshape(B, S, Hg)
    return o, lse


def mla_branch(c_q, c_kv, k_pe, q_norm, kv_norm, w_uq, w_ukv, cos, sin):
    B, S, _ = c_q.shape
    q = (rms_norm(c_q, q_norm) @ w_uq).reshape(B, S, MLA_HEADS, NOPE_DIM + ROPE_DIM)
    q = jnp.concatenate([q[..., :NOPE_DIM], apply_rope(q[..., NOPE_DIM:], cos, sin)], axis=-1)
    kv = (rms_norm(c_kv, kv_norm) @ w_ukv).reshape(B, S, MLA_HEADS, NOPE_DIM + MLA_V_DIM)
    k_rope = jnp.broadcast_to(apply_rope(k_pe[:, :, None, :], cos, sin), (B, S, MLA_HEADS, ROPE_DIM))
    k = jnp.concatenate([kv[..., :NOPE_DIM], k_rope], axis=-1)
    o = causal_block_attention(q, k, kv[..., NOPE_DIM:], (NOPE_DIM + ROPE_DIM) ** -0.5)
    return o.reshape(B, S, MLA_OUT)


def spatial_gating(z, ln_g, ln_b, ws, bs):
    B, S, _ = z.shape
    u, v = jnp.split(jax.nn.gelu(z, approximate=False), 2, axis=-1)
    v = layer_norm(v, ln_g, ln_b).reshape(B, S // SGU_CHUNK, SGU_CHUNK, SGU_GROUPS, SGU_GROUP_DIM)
    w = ws * jnp.tril(jnp.ones((SGU_CHUNK, SGU_CHUNK), ws.dtype))
    mixed = jnp.einsum('gts,bcsgd->bctgd', w, v) + bs.T[:, :, None]
    return u * mixed.reshape(B, S, SGU_WIDTH)


def dilated_branch(qkv, rel_bias):
    B, S, _ = qkv.shape
    qkv = qkv.reshape(B, S, 3, DIL_HEADS, DIL_HEAD_DIM)
    outs, lses = [], []
    for g, (window, dil) in enumerate(DIL_PATTERNS):
        hs = slice(g * DIL_HEADS_PER_GROUP, (g + 1) * DIL_HEADS_PER_GROUP)
        o, lse = dilated_group_attention(qkv[:, :, 0, hs], qkv[:, :, 1, hs], qkv[:, :, 2, hs],
                                         rel_bias[:, hs], dil, window // dil)
        outs.append(o)
        lses.append(lse)
    wts = jax.nn.softmax(jnp.stack(lses, 0), axis=0).astype(qkv.dtype)
    o = jnp.sum(wts[..., None] * jnp.stack(outs, 0), axis=0)
    return o.reshape(B, S, DIL_OUT)


def hybrid_mixer(h, w_in, q_norm, kv_norm, w_uq, w_ukv, sgu_g, sgu_b, ws, bs, rel_bias, w_branch, w_out, cos, sin):
    B, S, _ = h.shape
    offs = np.cumsum(IN_SPLITS)[:-1].tolist()
    c_q, c_kv, k_pe, z, qkv, gate_in = jnp.split(h @ w_in, offs, axis=-1)
    o_a = mla_branch(c_q, c_kv, k_pe, q_norm, kv_norm, w_uq, w_ukv, cos, sin)
    o_b = spatial_gating(z, sgu_g, sgu_b, ws, bs)
    o_c = dilated_branch(qkv, rel_bias)
    gates = jax.nn.sigmoid(gate_in).reshape(B, S, N_BRANCH, D_MODEL)
    p_a, p_b, p_c = jnp.split(w_branch, [MLA_OUT, MLA_OUT + SGU_OUT], axis=0)
    merged = gates[:, :, 0] * (o_a @ p_a) + gates[:, :, 1] * (o_b @ p_b) + gates[:, :, 2] * (o_c @ p_c)
    return merged @ w_out


def memory_cross_attention(h, mem, wq, wkv, wo):
    B, S, _ = h.shape
    M = mem.shape[1]
    q = (h @ wq).reshape(B, S, XA_HEADS, XA_HEAD_DIM)
    kv = (mem @ wkv).reshape(B, M, 2, XA_HEADS, XA_HEAD_DIM)
    s = jnp.einsum('bqhd,bkhd->bhqk', q, kv[:, :, 0]).astype(jnp.float32) * (XA_HEAD_DIM ** -0.5)
    p = jax.nn.softmax(s, axis=-1).astype(h.dtype)
    o = jnp.einsum('bhqk,bkhd->bqhd', p, kv[:, :, 1]).reshape(B, S, XA_HEADS * XA_HEAD_DIM)
    return o @ wo


def setup_inputs(seed: int = 0) -> dict:
    key = jax.random.key(seed)
    ks = jax.random.split(key, 24)
    D, F = D_MODEL, D_FF

    def nrm(k, shape, fan_in, gain=1.0):
        return jax.random.normal(k, shape, jnp.float32) * (gain * fan_in ** -0.5)

    def noise(k, shape, scale=0.02):
        return jax.random.normal(k, shape, jnp.float32) * scale

    kb1, kb2, kb3 = jax.random.split(ks[17], 3)
    w_branch = jnp.concatenate([nrm(kb1, (DEPTH, MLA_OUT, D), MLA_OUT),
                                nrm(kb2, (DEPTH, SGU_OUT, D), SGU_OUT),
                                nrm(kb3, (DEPTH, DIL_OUT, D), DIL_OUT)], axis=1)
    return {
        'x': jax.random.normal(ks[0], (BATCH, SEQ, D), jnp.float32),
        'mem': jax.random.normal(ks[1], (BATCH, MEM_LEN, D), jnp.float32),
        'ln_g': 1.0 + noise(ks[2], (DEPTH, 4, D)),
        'ln_b': noise(ks[3], (DEPTH, 4, D)),
        'ffn_wg': nrm(ks[4], (DEPTH, 2, D, F), D),
        'ffn_wu': nrm(ks[5], (DEPTH, 2, D, F), D),
        'ffn_wd': nrm(ks[6], (DEPTH, 2, F, D), F, BETA),
        'w_in': nrm(ks[7], (DEPTH, D, N_IN), D),
        'mla_q_norm': 1.0 + noise(ks[8], (DEPTH, Q_LORA)),
        'mla_kv_norm': 1.0 + noise(ks[9], (DEPTH, KV_LORA)),
        'mla_w_uq': nrm(ks[10], (DEPTH, Q_LORA, MLA_HEADS * (NOPE_DIM + ROPE_DIM)), Q_LORA),
        'mla_w_ukv': nrm(ks[11], (DEPTH, KV_LORA, MLA_HEADS * (NOPE_DIM + MLA_V_DIM)), KV_LORA),
        'sgu_ln_g': 1.0 + noise(ks[12], (DEPTH, SGU_WIDTH)),
        'sgu_ln_b': noise(ks[13], (DEPTH, SGU_WIDTH)),
        'sgu_ws': nrm(ks[14], (DEPTH, SGU_GROUPS, SGU_CHUNK, SGU_CHUNK), SGU_CHUNK),
        'sgu_bs': 1.0 + noise(ks[15], (DEPTH, SGU_GROUPS, SGU_CHUNK)),
        'rel_bias': noise(ks[16], (REL_BUCKETS, DIL_HEADS), 0.5),
        'w_branch': w_branch,
        'w_out': nrm(ks[18], (DEPTH, D, D), D, BETA),
        'xa_wq': nrm(ks[19], (DEPTH, D, XA_HEADS * XA_HEAD_DIM), D),
        'xa_wkv': nrm(ks[20], (DEPTH, D, 2 * XA_HEADS * XA_HEAD_DIM), D),
        'xa_wo': nrm(ks[21], (DEPTH, XA_HEADS * XA_HEAD_DIM, D), XA_HEADS * XA_HEAD_DIM, BETA),
    }


def reference(x, mem, ln_g, ln_b, ffn_wg, ffn_wu, ffn_wd, w_in, mla_q_norm, mla_kv_norm, mla_w_uq, mla_w_ukv,
              sgu_ln_g, sgu_ln_b, sgu_ws, sgu_bs, rel_bias, w_branch, w_out, xa_wq, xa_wkv, xa_wo):
    cos, sin = rope_tables(x.shape[1], x.dtype)
    for l in range(DEPTH):
        x = layer_norm(ALPHA * x + 0.5 * swiglu(x, ffn_wg[l, 0], ffn_wu[l, 0], ffn_wd[l, 0]), ln_g[l, 0], ln_b[l, 0])
        y = hybrid_mixer(x, w_in[l], mla_q_norm[l], mla_kv_norm[l], mla_w_uq[l], mla_w_ukv[l],
                         sgu_ln_g[l], sgu_ln_b[l], sgu_ws[l], sgu_bs[l], rel_bias, w_branch[l], w_out[l], cos, sin)
        x = layer_norm(ALPHA * x + y, ln_g[l, 1], ln_b[l, 1])
        x = layer_norm(ALPHA * x + memory_cross_attention(x, mem, xa_wq[l], xa_wkv[l], xa_wo[l]), ln_g[l, 2], ln_b[l, 2])
        x = layer_norm(ALPHA * x + 0.5 * swiglu(x, ffn_wg[l, 1], ffn_wu[l, 1], ffn_wd[l, 1]), ln_g[l, 3], ln_b[l, 3])
    return x
```

```cpp
#include <hip/hip_runtime.h>
#include <cstdio>
#include <cstdint>

namespace pg8 {
#define PG8_LAS __attribute__((address_space(3)))
typedef unsigned short bf16_t;
typedef short bf16x8 __attribute__((ext_vector_type(8)));
typedef float f32x4 __attribute__((ext_vector_type(4)));
typedef float f32x2 __attribute__((ext_vector_type(2)));
typedef unsigned u32x4 __attribute__((ext_vector_type(4)));
typedef unsigned u32x2 __attribute__((ext_vector_type(2)));
constexpr int BM = 256, BK = 64, HALF = 128, HTB = HALF * BK * 2  , STAGE_BYTES = 8 * HTB, NXCD = 8, WGM = 8;

__host__ __device__ __forceinline__ int lds_byte(int r, int c) { const int st = (r >> 4) * 2 + (c >> 5), rr = r & 15, cc = c & 31, ob = rr * 64 + cc * 2; return st * 1024 + (ob ^ (((ob >> 9) & 1) << 5)); }
__host__ __device__ __forceinline__ void stage_rc(int b, int& R, int& C) { const int st = b / 1024, sb = b % 1024, swz = sb ^ (((sb >> 9) & 1) << 5); R = (st >> 1) * 16 + swz / 64; C = (st & 1) * 32 + (swz % 64) / 2; }
__host__ __device__ __forceinline__ int perm32(int rho) { const int n = rho >> 4, i = rho & 15; return 8 * (i >> 2) + 4 * n + (i & 3); }

struct Unit { int pm, pn; };
struct Gemm { const bf16_t* A; const bf16_t* Bt; int lda, M, N, K; };

struct ASeg3 {
    const bf16_t* A0; const bf16_t* A1; const bf16_t* A2; int lda0, lda1, t1, t2;
    __device__ __forceinline__ const char* base(int pm, int tile) const {
        return tile < t1 ? (const char*)A0 + (size_t)pm * 512 * lda0 + (size_t)tile * 128
             : tile < t2 ? (const char*)A1 + (size_t)pm * 512 * lda0 + (size_t)(tile - t1) * 128
                         : (const char*)A2 + (size_t)pm * 512 * lda1 + (size_t)(tile - t2) * 128; }
    __device__ __forceinline__ size_t hstep(int tile) const { return (size_t)256 * (tile < t2 ? lda0 : lda1); }
    __device__ __forceinline__ bool sel(int tile) const { return tile >= t2; }
};
struct StaticOrder {
    int nM, nN, nwg, G, c, wgm;
    __host__ __device__ void init(int M, int N, int G_, int c_) { nM = M / BM; nN = N / BM; nwg = nM * nN; G = G_; c = c_; wgm = (nN == 8) ? 4 : WGM; }
    __host__ __device__ bool next(int i, Unit& u) const {
        const long L = (long)i * G + c; if (L >= nwg) return false;
        int wgid = (int)L; { const int q = nwg / NXCD, r = nwg % NXCD, xcd = wgid % NXCD, off = wgid / NXCD; wgid = (xcd < r ? xcd * (q + 1) : r * (q + 1) + (xcd - r) * q) + off; }
        const int nig = wgm * nN, gid = wgid / nig, fm = gid * wgm, gsz = (nM - fm) < wgm ? (nM - fm) : wgm;
        u.pm = fm + ((wgid % nig) % gsz); u.pn = (wgid % nig) / gsz; return true;
    }
    __device__ __forceinline__ void a_ready(const Unit&) const {}
    __device__ __forceinline__ void done(const Unit&) const {}
};

__device__ __forceinline__ unsigned cvt_pk_bf16(float lo, float hi) { unsigned r; asm volatile("v_cvt_pk_bf16_f32 %0, %1, %2" : "=v"(r) : "v"(lo), "v"(hi)); return r; }
__device__ __forceinline__ f32x2 gelu_pk(f32x2 v) {
    const f32x2 av = __builtin_elementwise_abs(v), d = av * 0.2316418882f + 1.0f;
    f32x2 t; t.x = __builtin_amdgcn_rcpf(d.x); t.y = __builtin_amdgcn_rcpf(d.y);
    f32x2 q = t * 0.5307027145f + (-0.7265760135f); q = q * t + 0.7107068705f; q = q * t + (-0.142248368f); q = q * t + 0.127414796f; q = q * t;
    const f32x2 s = (v * v) * (-0.72134752044f);
    f32x2 e; e.x = __builtin_amdgcn_exp2f(s.x); e.y = __builtin_amdgcn_exp2f(s.y);
    const f32x2 m = v * (q * e), r = v - m;
    f32x2 o; o.x = v.x < 0.f ? m.x : r.x; o.y = v.y < 0.f ? m.y : r.y; return o;
}
template <class Epi, class Sched, bool ALIGN_EPI = false, bool SP2 = false>
__device__ __forceinline__ void gemm_phase(PG8_LAS unsigned char* lds, const Gemm g, const Sched& S, const Epi& E) {
    int tid_ = threadIdx.x; asm volatile("" : "+v"(tid_));
    const int tid = tid_, wid = __builtin_amdgcn_readfirstlane(tid >> 6), lane = tid & 63, wr = wid >> 2, wc = wid & 3, fr = lane & 15, fq = lane >> 4;
    const int K = g.K, nt = K / BK;
    unsigned voffA[2], voffB[2];
#pragma unroll
    for (int i = 0; i < 2; ++i) { int R, C; stage_rc(tid * 16 + i * 8192, R, C); const int Rb = Epi::PERM ? ((R & ~31) + perm32(R & 31)) : R;
        voffA[i] = (unsigned)(R * g.lda + C) * 2u; voffB[i] = (unsigned)(Rb * K + C) * 2u; }
    const size_t kstep = (size_t)(BK * 2);
    const size_t hstepB = (size_t)HALF * K * 2, hstepA = (size_t)HALF * g.lda * 2;
    const size_t tstepA = 2 * hstepA, tstepB = 2 * hstepB;
    const unsigned ldsw = (unsigned)wid * 1024u;
    const int aoff = lds_byte(wr * 64 + fr, fq * 8), boff = lds_byte(wc * 32 + fr, fq * 8);
#define PG8_SA(b, h) (((b) * 2 + (h)) * HTB)
#define PG8_SB(b, h) ((4 + (b) * 2 + (h)) * HTB)
#define PG8_STAGE(bufoff, gbase, voff) do { _Pragma("unroll") for (int _i = 0; _i < 2; ++_i) \
        __builtin_amdgcn_global_load_lds((const unsigned*)((const char*)(gbase) + (voff)[_i]), (PG8_LAS unsigned*)(lds + (bufoff) + ldsw + _i * 8192), 16, 0, 0); } while (0)
#define PG8_LDA(dst, b, h) do { _Pragma("unroll") for (int m = 0; m < 4; ++m) _Pragma("unroll") for (int k = 0; k < 2; ++k) dst[m][k] = *(const PG8_LAS bf16x8*)(lds + PG8_SA(b, h) + aoff + m * 2048 + k * 1024); } while (0)
#define PG8_LDB(dst, b, h) do { _Pragma("unroll") for (int n = 0; n < 2; ++n) _Pragma("unroll") for (int k = 0; k < 2; ++k) dst[n][k] = *(const PG8_LAS bf16x8*)(lds + PG8_SB(b, h) + boff + n * 2048 + k * 1024); } while (0)
#define PG8_MMA(ai, bj, At, Bt) do { __builtin_amdgcn_s_setprio(1); _Pragma("unroll") for (int m = 0; m < 4; ++m) _Pragma("unroll") for (int n = 0; n < 2; ++n) _Pragma("unroll") for (int k = 0; k < 2; ++k) \
        acc[ai][bj][m][n] = __builtin_amdgcn_mfma_f32_16x16x32_bf16(Bt[n][k], At[m][k], acc[ai][bj][m][n], 0, 0, 0); __builtin_amdgcn_s_setprio(0); } while (0)
#define PG8_WAIT_V(n) asm volatile("s_waitcnt vmcnt(" #n ")" ::: "memory")
#define PG8_WAIT_L(n) asm volatile("s_waitcnt lgkmcnt(" #n ")" ::: "memory")
#define PG8_BAR __builtin_amdgcn_s_barrier()
#define PG8_SCHED __builtin_amdgcn_sched_barrier(0)
    Unit cur, nxt; int ui = 0;
    if (!S.next(0, cur)) return;
    f32x4 acc[2][2][4][2];
#pragma unroll
    for (int a = 0; a < 2; ++a)
#pragma unroll
        for (int b = 0; b < 2; ++b)
#pragma unroll
            for (int m = 0; m < 4; ++m)
#pragma unroll
                for (int n = 0; n < 2; ++n) acc[a][b][m][n] = (f32x4){0.f, 0.f, 0.f, 0.f};
    bf16x8 At[4][2], B0[2][2], B1[2][2];
    const char* cA = (const char*)g.A + (size_t)cur.pm * tstepA; const char* cB = (const char*)g.Bt + (size_t)cur.pn * tstepB;
    S.a_ready(cur);
    if constexpr (SP2) {
        PG8_STAGE(PG8_SB(0, 0), cB, voffB); PG8_STAGE(PG8_SB(0, 1), cB + hstepB, voffB); PG8_STAGE(PG8_SA(0, 0), cA, voffA); PG8_STAGE(PG8_SA(0, 1), cA + hstepA, voffA);
        if (wr == 1) PG8_BAR;
        PG8_WAIT_V(2); PG8_BAR;
        PG8_STAGE(PG8_SB(1, 0), cB + kstep, voffB); PG8_STAGE(PG8_SA(1, 0), cA + kstep, voffA); PG8_STAGE(PG8_SB(1, 1), cB + hstepB + kstep, voffB);
        PG8_WAIT_V(6); PG8_BAR;
    } else {
        PG8_STAGE(PG8_SB(0, 0), cB, voffB); PG8_STAGE(PG8_SA(0, 0), cA, voffA); PG8_STAGE(PG8_SB(0, 1), cB + hstepB, voffB); PG8_STAGE(PG8_SA(0, 1), cA + hstepA, voffA);
        if (wr == 1) PG8_BAR;
        PG8_WAIT_V(4); PG8_BAR;
        PG8_STAGE(PG8_SB(1, 0), cB + kstep, voffB); PG8_STAGE(PG8_SA(1, 0), cA + kstep, voffA); PG8_STAGE(PG8_SB(1, 1), cB + hstepB + kstep, voffB);
        PG8_WAIT_V(6); PG8_BAR;
    }
    for (;;) {
        const bool has_next = S.next(ui + 1, nxt);
        const char* nA = has_next ? (const char*)g.A + (size_t)nxt.pm * tstepA : cA; const char* nB = has_next ? (const char*)g.Bt + (size_t)nxt.pn * tstepB : cB;
        for (int t = 0; t < nt; t += 2) {
            const bool last = (t == nt - 2);
            const char* a1 = cA + (size_t)(t + 1) * kstep;
            const char* a2 = last ? nA : cA + (size_t)(t + 2) * kstep; const char* b2 = last ? nB : cB + (size_t)(t + 2) * kstep;
            const char* a3 = a2 + kstep; const char* b3 = b2 + kstep;
            if (last && has_next) S.a_ready(nxt);
            if constexpr (SP2) {
            PG8_LDB(B0, 0, 0); PG8_LDB(B1, 0, 1); PG8_SCHED; PG8_LDA(At, 0, 0); PG8_STAGE(PG8_SA(1, 1), a1 + hstepA, voffA);
            PG8_WAIT_V(8); PG8_WAIT_L(0); PG8_BAR; PG8_MMA(0, 0, At, B0); PG8_MMA(0, 1, At, B1); PG8_BAR; PG8_SCHED;
            PG8_LDA(At, 0, 1); PG8_STAGE(PG8_SB(0, 0), b2, voffB); PG8_STAGE(PG8_SB(0, 1), b2 + hstepB, voffB); PG8_STAGE(PG8_SA(0, 0), a2, voffA);
            PG8_WAIT_V(8); PG8_WAIT_L(0); PG8_BAR; PG8_MMA(1, 0, At, B0); PG8_MMA(1, 1, At, B1); PG8_BAR; PG8_SCHED;
            PG8_LDB(B0, 1, 0); PG8_LDB(B1, 1, 1); PG8_SCHED; PG8_LDA(At, 1, 0); PG8_STAGE(PG8_SA(0, 1), a2 + hstepA, voffA);
            PG8_WAIT_V(8); PG8_WAIT_L(0); PG8_BAR; PG8_MMA(0, 0, At, B0); PG8_MMA(0, 1, At, B1); PG8_BAR; PG8_SCHED;
            PG8_LDA(At, 1, 1); PG8_STAGE(PG8_SB(1, 0), b3, voffB); PG8_STAGE(PG8_SB(1, 1), b3 + hstepB, voffB); PG8_STAGE(PG8_SA(1, 0), a3, voffA);
            PG8_WAIT_V(8); PG8_WAIT_L(0); PG8_BAR; PG8_MMA(1, 0, At, B0); PG8_MMA(1, 1, At, B1); PG8_BAR; PG8_SCHED;
            } else {
            PG8_LDB(B0, 0, 0); PG8_SCHED; PG8_LDA(At, 0, 0); PG8_STAGE(PG8_SA(1, 1), a1 + hstepA, voffA);
            PG8_WAIT_L(8); PG8_BAR; PG8_WAIT_L(0); PG8_MMA(0, 0, At, B0); PG8_BAR; PG8_SCHED;
            PG8_LDB(B1, 0, 1); PG8_STAGE(PG8_SB(0, 0), b2, voffB);
            PG8_BAR; PG8_WAIT_L(0); PG8_MMA(0, 1, At, B1); PG8_BAR;
            PG8_LDA(At, 0, 1); PG8_STAGE(PG8_SA(0, 0), a2, voffA);
            PG8_BAR; PG8_WAIT_L(0); PG8_MMA(1, 0, At, B0); PG8_BAR; PG8_SCHED;
            PG8_STAGE(PG8_SB(0, 1), b2 + hstepB, voffB);
            PG8_WAIT_V(6); PG8_BAR; PG8_MMA(1, 1, At, B1); PG8_BAR;
            PG8_LDB(B0, 1, 0); PG8_SCHED; PG8_LDA(At, 1, 0); PG8_STAGE(PG8_SA(0, 1), a2 + hstepA, voffA);
            PG8_WAIT_L(8); PG8_BAR; PG8_WAIT_L(0); PG8_MMA(0, 0, At, B0); PG8_BAR; PG8_SCHED;
            PG8_LDB(B1, 1, 1); PG8_STAGE(PG8_SB(1, 0), b3, voffB);
            PG8_BAR; PG8_WAIT_L(0); PG8_MMA(0, 1, At, B1); PG8_BAR;
            PG8_LDA(At, 1, 1); PG8_STAGE(PG8_SA(1, 0), a3, voffA);
            PG8_BAR; PG8_WAIT_L(0); PG8_MMA(1, 0, At, B0); PG8_BAR; PG8_SCHED;
            PG8_STAGE(PG8_SB(1, 1), b3 + hstepB, voffB);
            PG8_WAIT_V(6); PG8_BAR; PG8_MMA(1, 1, At, B1); PG8_BAR;
            }
        }
        if constexpr (ALIGN_EPI) { if (wr == 0) PG8_BAR; }
        if constexpr (!Epi::AFTER_DRAIN) { E(acc, cur, wr, wc, fr, fq); S.done(cur); }
        if (!has_next) break;
#pragma unroll
        for (int a = 0; a < 2; ++a)
#pragma unroll
            for (int b = 0; b < 2; ++b)
#pragma unroll
                for (int m = 0; m < 4; ++m)
#pragma unroll
                    for (int n = 0; n < 2; ++n) acc[a][b][m][n] = (f32x4){0.f, 0.f, 0.f, 0.f};
        cur = nxt; cA = nA; cB = nB; ++ui;
        if constexpr (ALIGN_EPI) { if (wr == 1) PG8_BAR; }
    }
    PG8_WAIT_V(0);
    if constexpr (!ALIGN_EPI) { if (wr == 0) PG8_BAR; }
    PG8_BAR;
    if constexpr (Epi::AFTER_DRAIN) { E.fused(acc, cur, wr, wc, fr, fq, lds, wid, lane); S.done(cur); }
#undef PG8_SA
#undef PG8_SB
#undef PG8_STAGE
#undef PG8_LDA
#undef PG8_LDB
#undef PG8_MMA
#undef PG8_WAIT_V
#undef PG8_WAIT_L
#undef PG8_BAR
#undef PG8_SCHED
}
template <class Epi, class Sched, bool ALIGN_EPI, class ASrc>
__device__ __forceinline__ void gemm_phase_seg(PG8_LAS unsigned char* lds, const Gemm g, const ASrc AS, const Sched& S, const Epi& E) {
    constexpr bool SP2 = true;
    int tid_ = threadIdx.x; asm volatile("" : "+v"(tid_));
    const int tid = tid_, wid = __builtin_amdgcn_readfirstlane(tid >> 6), lane = tid & 63, wr = wid >> 2, wc = wid & 3, fr = lane & 15, fq = lane >> 4;
    const int K = g.K, nt = K / BK;
    unsigned voffA[2], voffA2[2], voffB[2];
#pragma unroll
    for (int i = 0; i < 2; ++i) { int R, C; stage_rc(tid * 16 + i * 8192, R, C); const int Rb = Epi::PERM ? ((R & ~31) + perm32(R & 31)) : R;
        voffA[i] = (unsigned)(R * AS.lda0 + C) * 2u; voffA2[i] = (unsigned)(R * AS.lda1 + C) * 2u; voffB[i] = (unsigned)(Rb * K + C) * 2u; }
    const size_t kstep = (size_t)(BK * 2);
    const size_t hstepB = (size_t)HALF * K * 2, tstepB = 2 * hstepB;
    const unsigned ldsw = (unsigned)wid * 1024u;
    const int aoff = lds_byte(wr * 64 + fr, fq * 8), boff = lds_byte(wc * 32 + fr, fq * 8);
#define PG8_SA(b, h) (((b) * 2 + (h)) * HTB)
#define PG8_SB(b, h) ((4 + (b) * 2 + (h)) * HTB)
#define PG8_STAGE(bufoff, gbase, voff) do { _Pragma("unroll") for (int _i = 0; _i < 2; ++_i) \
        __builtin_amdgcn_global_load_lds((const unsigned*)((const char*)(gbase) + (voff)[_i]), (PG8_LAS unsigned*)(lds + (bufoff) + ldsw + _i * 8192), 16, 0, 0); } while (0)
#define PG8_LDA(dst, b, h) do { _Pragma("unroll") for (int m = 0; m < 4; ++m) _Pragma("unroll") for (int k = 0; k < 2; ++k) dst[m][k] = *(const PG8_LAS bf16x8*)(lds + PG8_SA(b, h) + aoff + m * 2048 + k * 1024); } while (0)
#define PG8_LDB(dst, b, h) do { _Pragma("unroll") for (int n = 0; n < 2; ++n) _Pragma("unroll") for (int k = 0; k < 2; ++k) dst[n][k] = *(const PG8_LAS bf16x8*)(lds + PG8_SB(b, h) + boff + n * 2048 + k * 1024); } while (0)
#define PG8_MMA(ai, bj, At, Bt) do { __builtin_amdgcn_s_setprio(1); _Pragma("unroll") for (int m = 0; m < 4; ++m) _Pragma("unroll") for (int n = 0; n < 2; ++n) _Pragma("unroll") for (int k = 0; k < 2; ++k) \
        acc[ai][bj][m][n] = __builtin_amdgcn_mfma_f32_16x16x32_bf16(Bt[n][k], At[m][k], acc[ai][bj][m][n], 0, 0, 0); __builtin_amdgcn_s_setprio(0); } while (0)
#define PG8_WAIT_V(n) asm volatile("s_waitcnt vmcnt(" #n ")" ::: "memory")
#define PG8_WAIT_L(n) asm volatile("s_waitcnt lgkmcnt(" #n ")" ::: "memory")
#define PG8_BAR __builtin_amdgcn_s_barrier()
#define PG8_SCHED __builtin_amdgcn_sched_barrier(0)
    Unit cur, nxt; int ui = 0;
    if (!S.next(0, cur)) return;
    f32x4 acc[2][2][4][2];
#pragma unroll
    for (int a = 0; a < 2; ++a)
#pragma unroll
        for (int b = 0; b < 2; ++b)
#pragma unroll
            for (int m = 0; m < 4; ++m)
#pragma unroll
                for (int n = 0; n < 2; ++n) acc[a][b][m][n] = (f32x4){0.f, 0.f, 0.f, 0.f};
    bf16x8 At[4][2], B0[2][2], B1[2][2];
    const char* cB = (const char*)g.Bt + (size_t)cur.pn * tstepB;
    S.a_ready(cur);
    if constexpr (SP2) {
        PG8_STAGE(PG8_SB(0, 0), cB, voffB); PG8_STAGE(PG8_SB(0, 1), cB + hstepB, voffB); PG8_STAGE(PG8_SA(0, 0), AS.base(cur.pm, 0), voffA); PG8_STAGE(PG8_SA(0, 1), AS.base(cur.pm, 0) + AS.hstep(0), voffA);
        if (wr == 1) PG8_BAR;
        PG8_WAIT_V(2); PG8_BAR;
        PG8_STAGE(PG8_SB(1, 0), cB + kstep, voffB); PG8_STAGE(PG8_SA(1, 0), AS.base(cur.pm, 1), voffA); PG8_STAGE(PG8_SB(1, 1), cB + hstepB + kstep, voffB);
        PG8_WAIT_V(6); PG8_BAR;
    }
    for (;;) {
        const bool has_next = S.next(ui + 1, nxt);
        const int npm = has_next ? nxt.pm : cur.pm; const char* nB = has_next ? (const char*)g.Bt + (size_t)nxt.pn * tstepB : cB;
        for (int t = 0; t < nt; t += 2) {
            const bool last = (t == nt - 2);
            if (t == AS.t1) E.mid(acc, cur, 0, wr, wc, fr, fq);
            if (t == AS.t2) E.mid(acc, cur, 1, wr, wc, fr, fq);
            const char* a1 = AS.base(cur.pm, t + 1); const size_t h1 = AS.hstep(t + 1); const bool s1 = AS.sel(t + 1);
            const char* a2 = last ? AS.base(npm, 0) : AS.base(cur.pm, t + 2); const char* b2 = last ? nB : cB + (size_t)(t + 2) * kstep;
            const char* a3 = last ? AS.base(npm, 1) : AS.base(cur.pm, t + 3); const char* b3 = b2 + kstep;
            const size_t h2 = last ? AS.hstep(0) : AS.hstep(t + 2); const bool s2 = last ? false : AS.sel(t + 2);
            const unsigned v1a[2] = {s1 ? voffA2[0] : voffA[0], s1 ? voffA2[1] : voffA[1]}, v2a[2] = {s2 ? voffA2[0] : voffA[0], s2 ? voffA2[1] : voffA[1]};
            if (last && has_next) S.a_ready(nxt);
            if constexpr (SP2) {
            PG8_LDB(B0, 0, 0); PG8_LDB(B1, 0, 1); PG8_SCHED; PG8_LDA(At, 0, 0); PG8_STAGE(PG8_SA(1, 1), a1 + h1, v1a);
            PG8_WAIT_V(8); PG8_WAIT_L(0); PG8_BAR; PG8_MMA(0, 0, At, B0); PG8_MMA(0, 1, At, B1); PG8_BAR; PG8_SCHED;
            PG8_LDA(At, 0, 1); PG8_STAGE(PG8_SB(0, 0), b2, voffB); PG8_STAGE(PG8_SB(0, 1), b2 + hstepB, voffB); PG8_STAGE(PG8_SA(0, 0), a2, v2a);
            PG8_WAIT_V(8); PG8_WAIT_L(0); PG8_BAR; PG8_MMA(1, 0, At, B0); PG8_MMA(1, 1, At, B1); PG8_BAR; PG8_SCHED;
            PG8_LDB(B0, 1, 0); PG8_LDB(B1, 1, 1); PG8_SCHED; PG8_LDA(At, 1, 0); PG8_STAGE(PG8_SA(0, 1), a2 + h2, v2a);
            PG8_WAIT_V(8); PG8_WAIT_L(0); PG8_BAR; PG8_MMA(0, 0, At, B0); PG8_MMA(0, 1, At, B1); PG8_BAR; PG8_SCHED;
            PG8_LDA(At, 1, 1); PG8_STAGE(PG8_SB(1, 0), b3, voffB); PG8_STAGE(PG8_SB(1, 1), b3 + hstepB, voffB); PG8_STAGE(PG8_SA(1, 0), a3, v2a);
            PG8_WAIT_V(8); PG8_WAIT_L(0); PG8_BAR; PG8_MMA(1, 0, At, B0); PG8_MMA(1, 1, At, B1); PG8_BAR; PG8_SCHED;
            }
        }
        if constexpr (ALIGN_EPI) { if (wr == 0) PG8_BAR; }
        if constexpr (!Epi::AFTER_DRAIN) { E(acc, cur, wr, wc, fr, fq); S.done(cur); }
        if (!has_next) break;
#pragma unroll
        for (int a = 0; a < 2; ++a)
#pragma unroll
            for (int b = 0; b < 2; ++b)
#pragma unroll
                for (int m = 0; m < 4; ++m)
#pragma unroll
                    for (int n = 0; n < 2; ++n) acc[a][b][m][n] = (f32x4){0.f, 0.f, 0.f, 0.f};
        cur = nxt; cB = nB; ++ui;
        if constexpr (ALIGN_EPI) { if (wr == 1) PG8_BAR; }
    }
    PG8_WAIT_V(0);
    if constexpr (!ALIGN_EPI) { if (wr == 0) PG8_BAR; }
    PG8_BAR;
    if constexpr (Epi::AFTER_DRAIN) { E.fused(acc, cur, wr, wc, fr, fq, lds, wid, lane); S.done(cur); }
#undef PG8_SA
#undef PG8_SB
#undef PG8_STAGE
#undef PG8_LDA
#undef PG8_LDB
#undef PG8_MMA
#undef PG8_WAIT_V
#undef PG8_WAIT_L
#undef PG8_BAR
#undef PG8_SCHED
}
}

constexpr int NWAVES = 8, NTHR = NWAVES * 64;
constexpr int D = 2048, BATCH = 16, SEQ = 2048, M = BATCH * SEQ, FF = 5632, MEM = 256, DEPTH = 2;
constexpr int N_IN_SRC = 12864, NWIN = 6912  , NWIN_SRC = 6720, NGATE = 6144;
constexpr int QKVW = 4608, ZW = 1024, QW = 1536, KVW = 2048;
#ifndef H_NT
#define H_NT 0
#endif
#ifndef FF_PAD
#define FF_PAD 0
#endif
constexpr int FF_LD = FF + FF_PAD;
constexpr float LN_EPS = 1e-5f, RMS_EPS = 1e-6f, ALPHA = 1.41421356237309515f, LOG2E = 1.4426950408889634f, LN2 = 0.6931471805599453f;
constexpr float NEGBIG = -1e30f;

constexpr size_t MiB = 1u << 20;
constexpr size_t WS_CTL = 0, CTL_ZERO_BYTES = 4 * MiB;
constexpr size_t CTL_SSQ = 256 * 1024;
constexpr size_t CTL_STATS = 1 * MiB;
constexpr size_t CTL_SNT = 3 * MiB;
constexpr int SNT_FFN0 = 0, SNT_FFN1 = 11264, SNT_WIN = 22528, SNT_GATE = 29440, SNT_XQ = 35584, SNT_N = 36096;
constexpr size_t WS_TAB = 4 * MiB;
constexpr size_t TAB_COS = WS_TAB, TAB_SIN = WS_TAB + 256 * 1024, TAB_BIAS = WS_TAB + 512 * 1024, TAB_SGUW = WS_TAB + 640 * 1024;
constexpr int BIAS_STRIDE = 132;
constexpr size_t WS_W = 5 * MiB;
constexpr size_t W_GU0 = WS_W, W_D0 = W_GU0 + 44 * MiB, W_GU1 = W_D0 + 22 * MiB, W_D1 = W_GU1 + 44 * MiB, W_IN = W_D1 + 22 * MiB, W_GATE = W_IN + 27 * MiB,
                 W_UQ = W_GATE + 24 * MiB, W_UKV = W_UQ + 2 * MiB, W_PA = W_UKV + 2 * MiB, W_PB = W_PA + 4 * MiB, W_PC = W_PB + 2 * MiB, W_OUT = W_PC + 2 * MiB,
                 W_XQ = W_OUT + 8 * MiB, W_XKV = W_XQ + 2 * MiB, W_XO = W_XKV + 4 * MiB, W_END = W_XO + 2 * MiB;
static_assert(W_END <= 218 * MiB, "weights");
constexpr size_t WS_XB = 218 * MiB;
constexpr size_t WS_MEMB = 346 * MiB;
constexpr size_t WS_KVX = 362 * MiB;
constexpr size_t WS_LSE = 370 * MiB;
constexpr size_t WS_R = 372 * MiB;
constexpr size_t R_H = WS_R;
constexpr size_t R_KPE = WS_R, R_CQ = WS_R + 4 * MiB, R_CKV = WS_R + 36 * MiB, R_OA = R_CQ  , R_Z = WS_R + 68 * MiB, R_QKV = WS_R + 132 * MiB,
                 R_QM = WS_R + 420 * MiB, R_KVM = WS_R + 516 * MiB, R_OC = WS_R + 644 * MiB, R_END = WS_R + 676 * MiB;
constexpr size_t R_GATE = R_QKV, R_MERGED = R_KVM;
constexpr size_t R_QX = R_QM, R_OX = R_QM + 32 * MiB;
constexpr size_t WS_NEED = R_END;
static_assert((size_t)M * FF_LD * 2 <= 420 * MiB && R_GATE + (size_t)M * NGATE * 2 == R_KVM && R_QM + 96 * MiB == R_KVM && R_MERGED + 128 * MiB <= R_OC, "overlays");

constexpr int CW_BAR = 4096;

constexpr int LDS_BYTES = 147456;
constexpr int LDSCTL_OFF = 143360, MISC_OFF = LDSCTL_OFF;

#define GAS __attribute__((address_space(1)))
#define LAS __attribute__((address_space(3)))
typedef unsigned short bf16;
typedef pg8::f32x4 f32x4;
typedef pg8::f32x2 f32x2;
typedef pg8::u32x4 u32x4;
typedef pg8::u32x2 u32x2;
typedef pg8::bf16x8 bf16x8;
typedef short s16x4 __attribute__((ext_vector_type(4)));
typedef GAS unsigned gu32;
#define LDS_WAIT() asm volatile("s_waitcnt lgkmcnt(0)" ::: "memory")
#define VM_WAIT() asm volatile("s_waitcnt vmcnt(0)" ::: "memory")
__device__ __forceinline__ float bf2f(unsigned short b) { return __uint_as_float(((unsigned)b) << 16); }
__device__ __forceinline__ float bflo(unsigned w) { return __uint_as_float(w << 16); }
__device__ __forceinline__ float bfhi(unsigned w) { return __uint_as_float(w & 0xffff0000u); }
typedef float f32x2v_t __attribute__((ext_vector_type(2)));
typedef __bf16 bf16x2v_t __attribute__((ext_vector_type(2)));
__device__ __forceinline__ unsigned pk2(float lo, float hi) { const f32x2v_t v = {lo, hi}; const bf16x2v_t b = __builtin_convertvector(v, bf16x2v_t); return __builtin_bit_cast(unsigned, b); }
__device__ __forceinline__ float fsigmoid(float x) { return __builtin_amdgcn_rcpf(1.0f + __builtin_amdgcn_exp2f(-LOG2E * x)); }
__device__ __forceinline__ int lane_id_local() { int z = 0; asm volatile("" : "+v"(z)); return __builtin_amdgcn_mbcnt_hi(-1, __builtin_amdgcn_mbcnt_lo(-1, z)); }
__device__ __forceinline__ float shx(float v, int m) { return __builtin_bit_cast(float, __builtin_amdgcn_ds_bpermute((lane_id_local() ^ m) << 2, __builtin_bit_cast(int, v))); }
__device__ __forceinline__ float shx_l(float v, int m, int lane) { return __builtin_bit_cast(float, __builtin_amdgcn_ds_bpermute((lane ^ m) << 2, __builtin_bit_cast(int, v))); }
__device__ __forceinline__ float wave_sum(float v) {
#pragma unroll
    for (int o = 1; o < 64; o <<= 1) v += shx(v, o);
    return v;
}
__device__ __forceinline__ float wave_max(float v) {
#pragma unroll
    for (int o = 1; o < 64; o <<= 1) v = fmaxf(v, shx(v, o));
    return v;
}

#define XB_TMO      128
#define XB_XCNT(j)  (256  + 64 * (j))
#define XB_XSUB(j)  (1280 + 64 * (j))
#define XB_XGEN(j)  (2304 + 64 * (j))
#define XB_TOP      3328
#define XB_TOPGEN   3392
#define XCD_BAR_WORDS 3456
#define XB_SPIN_CAP (1u << 20)

__device__ __forceinline__ unsigned xb_ld(unsigned* p)              { return __hip_atomic_load(p, __ATOMIC_RELAXED, __HIP_MEMORY_SCOPE_AGENT); }
__device__ __forceinline__ unsigned xb_add(unsigned* p, unsigned v) { return __hip_atomic_fetch_add(p, v, __ATOMIC_RELAXED, __HIP_MEMORY_SCOPE_AGENT); }
__device__ __forceinline__ unsigned xb_xcc_id() { return (unsigned)__builtin_amdgcn_s_getreg((3 << 11) | 20) & 0xFu; }
#define XB_SPIN(cond, bar) do { unsigned _sp = 0; while (cond) { __builtin_amdgcn_s_sleep(1); \
    if ((++_sp & 255u) == 0u) { if (xb_ld(&(bar)[XB_TMO])) break; if (_sp > XB_SPIN_CAP) { atomicAdd(&(bar)[XB_TMO], 1u); break; } } } } while (0)

struct XcdBarrier { unsigned* bar; unsigned x; volatile LAS unsigned* st; };

__device__ __forceinline__ XcdBarrier xcd_barrier_post(unsigned* bar, volatile LAS unsigned* st) {
    XcdBarrier b; b.bar = bar; b.x = xb_xcc_id(); b.st = st;
    if (threadIdx.x == 0) (void)xb_add(&bar[XB_XCNT(b.x)], 1u);
    return b;
}
__device__ __forceinline__ void xcd_barrier_complete(unsigned* bar, unsigned x, unsigned& nloc, unsigned& nx) {
    const unsigned G = gridDim.x * gridDim.y * gridDim.z;
    unsigned sum, cnt, mine, sp = 0u;
    for (;;) {
        sum = 0u; cnt = 0u; mine = 0u;
#pragma unroll
        for (unsigned j = 0; j < 16; ++j) { const unsigned c = xb_ld(&bar[XB_XCNT(j)]); sum += c; cnt += (c > 0u) ? 1u : 0u; mine = (j == x) ? c : mine; }
        if (sum == G) break;
        __builtin_amdgcn_s_sleep(1);
        if ((++sp & 255u) == 0u) { if (xb_ld(&bar[XB_TMO])) break; if (sp > XB_SPIN_CAP) { atomicAdd(&bar[XB_TMO], 1u); break; } }
    }
    nloc = mine > 0u ? mine : 1u; nx = cnt > 0u ? cnt : 1u;
}
__device__ __forceinline__ void xcd_barrier(const XcdBarrier& b) {
    asm volatile("s_waitcnt vmcnt(0)" ::: "memory");
    __syncthreads();
    if (threadIdx.x == 0) {
        unsigned* bar = b.bar; { size_t z_ = 0; asm volatile("" : "+s"(z_)); bar += z_; }
        __builtin_amdgcn_s_waitcnt(0);
        unsigned nloc = b.st[0], nx = b.st[1];
        if (nloc == 0u) { xcd_barrier_complete(bar, b.x, nloc, nx); b.st[0] = nloc; b.st[1] = nx; }
        const unsigned old = xb_add(&bar[XB_XSUB(b.x)], 1u);
        const unsigned gen = old / nloc;
        if (old + 1u == (gen + 1u) * nloc) {
            __builtin_amdgcn_fence(__ATOMIC_RELEASE, "agent");
            asm volatile("s_waitcnt vmcnt(0)" ::: "memory");
            const unsigned og = xb_add(&bar[XB_TOP], 1u);
            const unsigned tg = og / nx;
            if (og + 1u == (tg + 1u) * nx) xb_add(&bar[XB_TOPGEN], 1u);
            else XB_SPIN(xb_ld(&bar[XB_TOPGEN]) == tg, bar);
            __builtin_amdgcn_fence(__ATOMIC_ACQUIRE, "agent");
            xb_add(&bar[XB_XGEN(b.x)], 1u);
            asm volatile("s_waitcnt vmcnt(0)" ::: "memory");
        } else {
            XB_SPIN(xb_ld(&bar[XB_XGEN(b.x)]) == gen, bar);
            __builtin_amdgcn_fence(__ATOMIC_ACQUIRE, "agent");
            asm volatile("s_waitcnt vmcnt(0)" ::: "memory");
        }
    }
    __syncthreads();
}

__device__ __forceinline__ u32x4 ld16_sc1_nowait(const void* p) { u32x4 v; asm volatile("global_load_dwordx4 %0, %1, off sc0 sc1" : "=v"(v) : "v"(p) : "memory"); return v; }
__device__ __forceinline__ u32x4 ld16_sc1(const void* p) { u32x4 v; asm volatile("global_load_dwordx4 %0, %1, off sc0 sc1\n\ts_waitcnt vmcnt(0)" : "=v"(v) : "v"(p) : "memory"); return v; }
using pg8::Unit;
struct LnFold {
    const float* stats; const float* sn; const float* tn;
    __device__ __forceinline__ void row(int r, float& mu, float& rs) const {
        if (!stats) { mu = 0.f; rs = 1.f; return; }
        const f32x2 st = *(const f32x2*)(stats + 2 * (size_t)r); const float m_ = st.x * (1.0f / D); rs = __builtin_amdgcn_rsqf(st.y * (1.0f / D) - m_ * m_ + LN_EPS); mu = -m_ * rs;
    }
    __device__ __forceinline__ void cols(int c, float (&s)[8], float (&t)[8]) const {
        if (!stats) {
#pragma unroll
            for (int j = 0; j < 8; ++j) { s[j] = 0.f; t[j] = 0.f; }
            return; }
        const f32x4 s0 = *(const f32x4*)(sn + c), s1 = *(const f32x4*)(sn + c + 4), t0 = *(const f32x4*)(tn + c), t1 = *(const f32x4*)(tn + c + 4);
        s[0] = s0.x; s[1] = s0.y; s[2] = s0.z; s[3] = s0.w; s[4] = s1.x; s[5] = s1.y; s[6] = s1.z; s[7] = s1.w;
        t[0] = t0.x; t[1] = t0.y; t[2] = t0.z; t[3] = t0.w; t[4] = t1.x; t[5] = t1.y; t[6] = t1.z; t[7] = t1.w;
    }
};
struct EpiSwiglu {
    static constexpr bool PERM = true, AFTER_DRAIN = false;
    bf16* H; LnFold ln;
    __device__ __forceinline__ void operator()(const f32x4 (&acc)[2][2][4][2], const Unit& u, int wr, int wc, int fr, int fq) const {
        const int row0 = u.pm * 256 + wr * 64 + fr, col0 = u.pn * 128 + wc * 32 + 8 * fq, wrow = u.pn * 256 + wc * 32 + 8 * fq;
        float sg[8], tg[8], su[8], tu[8];
        ln.cols(wrow, sg, tg); ln.cols(wrow + 128, su, tu);
#pragma unroll
        for (int ai = 0; ai < 2; ++ai)
#pragma unroll
            for (int m = 0; m < 4; ++m) {
                const int row = row0 + ai * 128 + m * 16;
                float mu, rs; ln.row(row, mu, rs);
                float h[8];
#pragma unroll
                for (int n = 0; n < 2; ++n)
#pragma unroll
                    for (int j = 0; j < 4; ++j) { const float g = __builtin_fmaf(rs, acc[ai][0][m][n][j], __builtin_fmaf(mu, sg[4 * n + j], tg[4 * n + j])), up = __builtin_fmaf(rs, acc[ai][1][m][n][j], __builtin_fmaf(mu, su[4 * n + j], tu[4 * n + j]));
                        h[4 * n + j] = g * fsigmoid(g) * up; }
                u32x4 w; w.x = pk2(h[0], h[1]); w.y = pk2(h[2], h[3]); w.z = pk2(h[4], h[5]); w.w = pk2(h[6], h[7]);
                if (H_NT) __builtin_nontemporal_store(w, (u32x4*)(H + (size_t)row * FF_LD + col0)); else *(u32x4*)(H + (size_t)row * FF_LD + col0) = w;
            }
    }
};
struct EpiResidLn {
    static constexpr bool PERM = true, AFTER_DRAIN = false;
    const float* xin;
    bf16* ZB; const bf16* zl_in; bf16* zl_out; const float* stats_prev; const float* g_prev; const float* b_prev; float* stats_out; float alpha, scale;
    __device__ __forceinline__ void operator()(const f32x4 (&acc)[2][2][4][2], const Unit& u, int wr, int wc, int fr, int fq) const {
        const int row0 = u.pm * 256 + wr * 64 + fr;
        float gg[2][8], bb[2][8];
#pragma unroll
        for (int bj = 0; bj < 2; ++bj) { const int col = u.pn * 256 + bj * 128 + wc * 32 + 8 * fq;
            if (xin) {
#pragma unroll
                for (int j = 0; j < 8; ++j) { gg[bj][j] = 1.f; bb[bj][j] = 0.f; }
            } else { const f32x4 g0 = *(const f32x4*)(g_prev + col), g1 = *(const f32x4*)(g_prev + col + 4), b0 = *(const f32x4*)(b_prev + col), b1 = *(const f32x4*)(b_prev + col + 4);
                gg[bj][0] = g0.x; gg[bj][1] = g0.y; gg[bj][2] = g0.z; gg[bj][3] = g0.w; gg[bj][4] = g1.x; gg[bj][5] = g1.y; gg[bj][6] = g1.z; gg[bj][7] = g1.w;
                bb[bj][0] = b0.x; bb[bj][1] = b0.y; bb[bj][2] = b0.z; bb[bj][3] = b0.w; bb[bj][4] = b1.x; bb[bj][5] = b1.y; bb[bj][6] = b1.z; bb[bj][7] = b1.w; } }
#pragma unroll
        for (int ap = 0; ap < 4; ++ap) {
            const int ai = ap >> 1;
            f32x4 pv[2][2][2]; f32x2 st[2];
#pragma unroll
            for (int mm = 0; mm < 2; ++mm) {
                const int m = 2 * (ap & 1) + mm, row = row0 + ai * 128 + m * 16;
                st[mm] = xin ? (f32x2){0.f, 0.f} : *(const f32x2*)(stats_prev + 2 * (size_t)row);
#pragma unroll
                for (int bj = 0; bj < 2; ++bj) { const size_t off = (size_t)row * D + u.pn * 256 + bj * 128 + wc * 32 + 8 * fq;
                    if (xin) { pv[mm][bj][0] = *(const f32x4*)(xin + off); pv[mm][bj][1] = *(const f32x4*)(xin + off + 4); }
                    else { const u32x4 h = *(const u32x4*)(ZB + off), l = *(const u32x4*)(zl_in + off);
                        pv[mm][bj][0] = (f32x4){bflo(h.x) + bflo(l.x), bfhi(h.x) + bfhi(l.x), bflo(h.y) + bflo(l.y), bfhi(h.y) + bfhi(l.y)};
                        pv[mm][bj][1] = (f32x4){bflo(h.z) + bflo(l.z), bfhi(h.z) + bfhi(l.z), bflo(h.w) + bflo(l.w), bfhi(h.w) + bfhi(l.w)}; } }
            }
#pragma unroll
            for (int mm = 0; mm < 2; ++mm) {
                const int m = 2 * (ap & 1) + mm, row = row0 + ai * 128 + m * 16;
                float mu = 0.f, rs = 1.f;
                if (!xin) { mu = st[mm].x * (1.0f / D); rs = __builtin_amdgcn_rsqf(st[mm].y * (1.0f / D) - mu * mu + LN_EPS); }
                float s1 = 0.f, s2 = 0.f;
#pragma unroll
                for (int bj = 0; bj < 2; ++bj) {
                    const size_t off = (size_t)row * D + u.pn * 256 + bj * 128 + wc * 32 + 8 * fq;
                    float z[8], zr[8];
#pragma unroll
                    for (int j = 0; j < 8; ++j) { const float xp = (pv[mm][bj][j >> 2][j & 3] - mu) * rs * gg[bj][j] + bb[bj][j]; z[j] = alpha * xp + scale * acc[ai][bj][m][j >> 2][j & 3]; s1 += z[j]; s2 += z[j] * z[j]; }
                    u32x4 o; o.x = pk2(z[0], z[1]); o.y = pk2(z[2], z[3]); o.z = pk2(z[4], z[5]); o.w = pk2(z[6], z[7]);
                    zr[0] = z[0] - bflo(o.x); zr[1] = z[1] - bfhi(o.x); zr[2] = z[2] - bflo(o.y); zr[3] = z[3] - bfhi(o.y); zr[4] = z[4] - bflo(o.z); zr[5] = z[5] - bfhi(o.z); zr[6] = z[6] - bflo(o.w); zr[7] = z[7] - bfhi(o.w);
                    u32x4 ol; ol.x = pk2(zr[0], zr[1]); ol.y = pk2(zr[2], zr[3]); ol.z = pk2(zr[4], zr[5]); ol.w = pk2(zr[6], zr[7]);
                    *(u32x4*)(ZB + off) = o; *(u32x4*)(zl_out + off) = ol;
                }
                s1 += shx(s1, 16); s1 += shx(s1, 32); s2 += shx(s2, 16); s2 += shx(s2, 32);
                if (fq < 2) unsafeAtomicAdd(stats_out + 2 * (size_t)row + fq, fq ? s2 : s1);
            }
            asm volatile("" ::: "memory");
        }
    }
};
template <int MODE  > struct EpiBf {
    static constexpr bool PERM = true, AFTER_DRAIN = false;
    bf16* O; int ldc; const float* ssq; const float* cosT; const float* sinT; LnFold ln;
    __device__ __forceinline__ void operator()(const f32x4 (&acc)[2][2][4][2], const Unit& u, int wr, int wc, int fr, int fq) const {
        const int row0 = u.pm * 256 + wr * 64 + fr;
        float sc[2][8], tc[2][8];
#pragma unroll
        for (int bj = 0; bj < 2; ++bj) ln.cols(u.pn * 256 + bj * 128 + wc * 32 + 8 * fq, sc[bj], tc[bj]);
#pragma unroll
        for (int ai = 0; ai < 2; ++ai)
#pragma unroll
            for (int m = 0; m < 4; ++m) {
                const int row = row0 + ai * 128 + m * 16;
                float rs = 1.f;
                if (MODE == 1 || MODE == 2) rs = __builtin_amdgcn_rsqf(ssq[row] * (1.0f / 512.0f) + RMS_EPS);
                float mu, lr; ln.row(row, mu, lr);
#pragma unroll
                for (int bj = 0; bj < 2; ++bj) {
                    const int col0 = u.pn * 256 + bj * 128 + wc * 32 + 8 * fq;
                    float v[8];
#pragma unroll
                    for (int n = 0; n < 2; ++n)
#pragma unroll
                        for (int j = 0; j < 4; ++j) v[4 * n + j] = __builtin_fmaf(lr, acc[ai][bj][m][n][j], __builtin_fmaf(mu, sc[bj][4 * n + j], tc[bj][4 * n + j])) * rs;
                    if (MODE == 2) {
                        const int hd = col0 / 192, w = col0 - hd * 192;
                        if (w >= 128) {
                            const int pos = row & (SEQ - 1), jj0 = (w - 128) >> 1;
                            const f32x4 c = *(const f32x4*)(cosT + pos * 32 + jj0), s = *(const f32x4*)(sinT + pos * 32 + jj0);
#pragma unroll
                            for (int p = 0; p < 4; ++p) { const float a = v[2 * p], b = v[2 * p + 1]; v[2 * p] = a * c[p] - b * s[p]; v[2 * p + 1] = a * s[p] + b * c[p]; }
                        }
                    }
                    u32x4 o; o.x = pk2(v[0], v[1]); o.y = pk2(v[2], v[3]); o.z = pk2(v[4], v[5]); o.w = pk2(v[6], v[7]);
                    *(u32x4*)(O + (size_t)row * ldc + col0) = o;
                }
            }
    }
};
struct EpiWin {
    static constexpr bool PERM = true, AFTER_DRAIN = false;
    bf16 *CQ, *CKV, *Z, *QKV, *KPE; float* ssq_q; float* ssq_kv; const float* cosT; const float* sinT; LnFold ln;
    __device__ __forceinline__ void operator()(const f32x4 (&acc)[2][2][4][2], const Unit& u, int wr, int wc, int fr, int fq) const {
        const int row0 = u.pm * 256 + wr * 64 + fr, pn = u.pn;
        bf16* base; int ldc, ct; int kind;
        float* ssq = nullptr;
        if (pn < 2) { base = CQ; ldc = 512; ct = pn; kind = 1; ssq = ssq_q; }
        else if (pn < 4) { base = CKV; ldc = 512; ct = pn - 2; kind = 1; ssq = ssq_kv; }
        else if (pn < 8) { base = Z; ldc = ZW; ct = pn - 4; kind = 2; }
        else if (pn < 26) { base = QKV; ldc = QKVW; ct = pn - 8; kind = 0; }
        else { base = KPE; ldc = 64; ct = 0; kind = 3; }
        float sc[2][8], tc[2][8];
#pragma unroll
        for (int bj = 0; bj < 2; ++bj) ln.cols(pn * 256 + bj * 128 + wc * 32 + 8 * fq, sc[bj], tc[bj]);
#pragma unroll
        for (int ai = 0; ai < 2; ++ai)
#pragma unroll
            for (int m = 0; m < 4; ++m) {
                const int row = row0 + ai * 128 + m * 16;
                float mu, lr; ln.row(row, mu, lr);
                float sq = 0.f;
#pragma unroll
                for (int bj = 0; bj < 2; ++bj) {
                    const int cl = bj * 128 + wc * 32 + 8 * fq;
                    float v[8];
#pragma unroll
                    for (int n = 0; n < 2; ++n)
#pragma unroll
                        for (int j = 0; j < 4; ++j) v[4 * n + j] = __builtin_fmaf(lr, acc[ai][bj][m][n][j], __builtin_fmaf(mu, sc[bj][4 * n + j], tc[bj][4 * n + j]));
                    if (kind == 1) {
#pragma unroll
                        for (int j = 0; j < 8; ++j) sq += v[j] * v[j];
                    }
                    if (kind == 2) {
#pragma unroll
                        for (int p = 0; p < 4; ++p) { const f32x2 g = pg8::gelu_pk((f32x2){v[2 * p], v[2 * p + 1]}); v[2 * p] = g.x; v[2 * p + 1] = g.y; }
                    }
                    if (kind == 3) {
                        if (cl < 64) {
                            const int pos = row & (SEQ - 1), jj0 = cl >> 1;
                            const f32x4 c = *(const f32x4*)(cosT + pos * 32 + jj0), s = *(const f32x4*)(sinT + pos * 32 + jj0);
#pragma unroll
                            for (int p = 0; p < 4; ++p) { const float a = v[2 * p], b = v[2 * p + 1]; v[2 * p] = a * c[p] - b * s[p]; v[2 * p + 1] = a * s[p] + b * c[p]; }
                        }
                    }
                    if (kind != 3 || cl < 64) {
                        u32x4 o; o.x = pk2(v[0], v[1]); o.y = pk2(v[2], v[3]); o.z = pk2(v[4], v[5]); o.w = pk2(v[6], v[7]);
                        *(u32x4*)(base + (size_t)row * ldc + ct * 256 + cl) = o;
                    }
                }
                if (kind == 1) {
                    sq += shx(sq, 16); sq += shx(sq, 32);
                    if (fq == 0) unsafeAtomicAdd(ssq + row, sq);
                }
            }
    }
};
struct EpiGate8 {
    static constexpr bool PERM = true, AFTER_DRAIN = false;
    unsigned char* O; LnFold ln;
    __device__ __forceinline__ void operator()(const f32x4 (&acc)[2][2][4][2], const Unit& u, int wr, int wc, int fr, int fq) const {
        const int row0 = u.pm * 256 + wr * 64 + fr;
        float sc[2][8], tc[2][8];
#pragma unroll
        for (int bj = 0; bj < 2; ++bj) ln.cols(u.pn * 256 + bj * 128 + wc * 32 + 8 * fq, sc[bj], tc[bj]);
#pragma unroll
        for (int ai = 0; ai < 2; ++ai)
#pragma unroll
            for (int m = 0; m < 4; ++m) {
                const int row = row0 + ai * 128 + m * 16;
                float mu, lr; ln.row(row, mu, lr);
#pragma unroll
                for (int bj = 0; bj < 2; ++bj) {
                    const int col0 = u.pn * 256 + bj * 128 + wc * 32 + 8 * fq;
                    unsigned b[8];
#pragma unroll
                    for (int n = 0; n < 2; ++n)
#pragma unroll
                        for (int j = 0; j < 4; ++j) b[4 * n + j] = (unsigned)(fsigmoid(__builtin_fmaf(lr, acc[ai][bj][m][n][j], __builtin_fmaf(mu, sc[bj][4 * n + j], tc[bj][4 * n + j]))) * 255.0f + 0.5f);
                    *(u32x2*)(O + (size_t)row * NGATE + col0) = (u32x2){b[0] | (b[1] << 8) | (b[2] << 16) | (b[3] << 24), b[4] | (b[5] << 8) | (b[6] << 16) | (b[7] << 24)};
                }
            }
    }
};
struct EpiMerge {
    static constexpr bool PERM = true, AFTER_DRAIN = false;
    const unsigned char* GATE; bf16* MG;
    template <int WHICH> __device__ __forceinline__ void scale(f32x4 (&acc)[2][2][4][2], const Unit& u, int wr, int wc, int fr_, int fq_) const {
        int fr = fr_, fq = fq_; asm volatile("" : "+v"(fr), "+v"(fq));
        const int row0 = u.pm * 256 + wr * 64 + fr;
#pragma unroll
        for (int ai = 0; ai < 2; ++ai) {
            u32x2 gn[4][2], gd[4][2];
#pragma unroll
            for (int m = 0; m < 4; ++m)
#pragma unroll
                for (int bj = 0; bj < 2; ++bj) {
                    const unsigned char* gp = GATE + (size_t)(row0 + ai * 128 + m * 16) * NGATE + u.pn * 256 + bj * 128 + wc * 32 + 8 * fq;
                    gn[m][bj] = *(const u32x2*)(gp + 2048 * WHICH);
                    if (WHICH < 2) gd[m][bj] = *(const u32x2*)(gp + 2048 * (WHICH + 1)); else gd[m][bj] = (u32x2){0u, 0u};
                }
#pragma unroll
            for (int m = 0; m < 4; ++m)
#pragma unroll
                for (int bj = 0; bj < 2; ++bj)
#pragma unroll
                    for (int j = 0; j < 8; ++j) {
                        const unsigned nb = ((j < 4 ? gn[m][bj].x : gn[m][bj].y) >> (8 * (j & 3))) & 255u, db = ((j < 4 ? gd[m][bj].x : gd[m][bj].y) >> (8 * (j & 3))) & 255u;
                        const float num = (float)(WHICH == 0 ? nb : (nb > 1u ? nb : 1u));
                        const float s = WHICH < 2 ? num * __builtin_amdgcn_rcpf((float)(db > 1u ? db : 1u)) : num * (1.0f / 255.0f);
                        acc[ai][bj][m][j >> 2][j & 3] *= s;
                    }
        }
    }
    __device__ __forceinline__ void mid(f32x4 (&acc)[2][2][4][2], const Unit& u, int which, int wr, int wc, int fr, int fq) const {
        if (which == 0) scale<0>(acc, u, wr, wc, fr, fq); else scale<1>(acc, u, wr, wc, fr, fq);
    }
    __device__ __forceinline__ void operator()(f32x4 (&acc)[2][2][4][2], const Unit& u, int wr, int wc, int fr, int fq) const {
        scale<2>(acc, u, wr, wc, fr, fq);
        const int row0 = u.pm * 256 + wr * 64 + fr;
#pragma unroll
        for (int ai = 0; ai < 2; ++ai)
#pragma unroll
            for (int m = 0; m < 4; ++m)
#pragma unroll
                for (int bj = 0; bj < 2; ++bj) {
                    const f32x4 a = acc[ai][bj][m][0], b = acc[ai][bj][m][1];
                    u32x4 o; o.x = pk2(a.x, a.y); o.y = pk2(a.z, a.w); o.z = pk2(b.x, b.y); o.w = pk2(b.z, b.w);
                    *(u32x4*)(MG + (size_t)(row0 + ai * 128 + m * 16) * D + u.pn * 256 + bj * 128 + wc * 32 + 8 * fq) = o;
                }
    }
};

struct Frame {
    LAS unsigned char* lds;
    gu32* ctl;
    unsigned char* ws;
    int wave, vcu, G, gw, NGW;
    float* out;
};
constexpr int PTR_OFF = LDSCTL_OFF + 256;
__device__ __forceinline__ const float* inptr(const Frame& F, int i) {
    int z = 0; asm volatile("" : "+v"(z));
    const volatile LAS unsigned* p = (const volatile LAS unsigned*)(F.lds + PTR_OFF + 8 * i + z);
    const unsigned lo = __builtin_amdgcn_readfirstlane(p[0]), hi = __builtin_amdgcn_readfirstlane(p[1]);
    return (const float*)(((unsigned long long)hi << 32) | lo);
}
#define INP(i) inptr(F, (i))
__device__ __forceinline__ int tid_opaque() { int t = (int)threadIdx.x; asm volatile("" : "+v"(t)); return t; }
#define TID_ tid_opaque()
#define LANE_ (tid_opaque() & 63)
template <class T> __device__ __forceinline__ T* wsp(const Frame& F, size_t off) { return (T*)(F.ws + off); }
__device__ __forceinline__ size_t szero() { size_t z = 0; asm volatile("" : "+s"(z)); return z; }
__device__ __forceinline__ unsigned char* ws_launder(unsigned char* p) { return p + szero(); }
__device__ __forceinline__ int vlaunder(int v) { asm volatile("" : "+v"(v)); return v; }

__device__ __forceinline__ int rowmap(int mode, int n) {
    switch (mode) {
        case 1: return 256 * (n >> 7) + (n & 127);
        case 2: return 256 * (n >> 7) + 128 + (n & 127);
        case 3: {
            if (n < 1024) return n;
            if (n < 1088) { const int j = n - 1024; return 6656 + 2 * (j & 31) + (j >> 5); }
            return n - 64; }
        case 4: { const int hd = n / 192, w = n - hd * 192; if (w < 128) return n; const int j = w - 128; return hd * 192 + 128 + 2 * (j & 31) + (j >> 5); }
        default: return n;
    }
}
struct TrJob { const float* src; const float* ks; const float* lnb; float* sn; int ldw, K, nblk, mode, r; size_t dstoff; bool hit; };
__device__ __forceinline__ void tr_load(const TrJob& j, f32x4 (&v)[16], int lane) {
    const int k0 = 64 * (j.r / j.nblk), n0 = 64 * (j.r % j.nblk);
#pragma unroll
    for (int i = 0; i < 16; ++i) { const int kk = 4 * i + (lane >> 4); v[i] = *(const f32x4*)(j.src + (size_t)(k0 + kk) * j.ldw + n0 + 4 * (lane & 15)); }
}
__device__ __forceinline__ void tr_store(const TrJob& j, const f32x4 (&v)[16], unsigned char* ws, LAS float* scr, LAS float* tmp, int lane) {
    const int k0 = 64 * (j.r / j.nblk), n0 = 64 * (j.r % j.nblk);
    bf16* WT = (bf16*)(ws + j.dstoff);
    f32x4 ts = (f32x4){0.f, 0.f, 0.f, 0.f};
#pragma unroll
    for (int i = 0; i < 16; ++i) { const int kk = 4 * i + (lane >> 4); f32x4 x = v[i];
        if (j.lnb) ts += x * j.lnb[k0 + kk];
        if (j.ks) x = x * j.ks[k0 + kk];
        LAS float* d = scr + kk * 65 + 4 * (lane & 15); d[0] = x.x; d[1] = x.y; d[2] = x.z; d[3] = x.w; }
    if (j.lnb) {
#pragma unroll
        for (int e = 0; e < 4; ++e) { float t = ts[e]; t += shx(t, 16); t += shx(t, 32); ts[e] = t; }
        if ((lane >> 4) == 0) {
#pragma unroll
            for (int e = 0; e < 4; ++e) tmp[4 * (lane & 15) + e] = ts[e];
        }
    }
    LDS_WAIT(); asm volatile("" ::: "memory");
    const int c8 = lane & 7;
#pragma unroll
    for (int jj = 0; jj < 8; ++jj) { const int n = (lane >> 3) + 8 * jj; const LAS float* s = scr + (8 * c8) * 65 + n;
        u32x4 o; o.x = pk2(s[0 * 65], s[1 * 65]); o.y = pk2(s[2 * 65], s[3 * 65]); o.z = pk2(s[4 * 65], s[5 * 65]); o.w = pk2(s[6 * 65], s[7 * 65]);
        const int drow = rowmap(j.mode, n0 + n);
        *(GAS u32x4*)(WT + (size_t)drow * j.K + k0 + 8 * c8) = o;
        if (j.lnb) { float sv = ((bflo(o.x) + bfhi(o.x)) + (bflo(o.y) + bfhi(o.y))) + ((bflo(o.z) + bfhi(o.z)) + (bflo(o.w) + bfhi(o.w)));
            sv += shx(sv, 1); sv += shx(sv, 2); sv += shx(sv, 4);
            if (c8 == 0) tmp[64 + n] = sv; } }
    LDS_WAIT(); asm volatile("" ::: "memory");
    if (j.lnb) {
        const int drow = rowmap(j.mode, n0 + lane);
        unsafeAtomicAdd(j.sn + SNT_N + drow, tmp[lane]); unsafeAtomicAdd(j.sn + drow, tmp[64 + lane]);
        LDS_WAIT(); asm volatile("" ::: "memory");
    }
}
__device__ __forceinline__ void cvt_rows(const Frame& F, const float* src, bf16* dst, size_t n) {
    for (size_t i = ((size_t)F.gw * 64 + LANE_) * 8; i < n; i += (size_t)F.NGW * 64 * 8) {
        const f32x4 a = *(const f32x4*)(src + i), b = *(const f32x4*)(src + i + 4);
        u32x4 o; o.x = pk2(a.x, a.y); o.y = pk2(a.z, a.w); o.z = pk2(b.x, b.y); o.w = pk2(b.z, b.w);
        *(u32x4*)(dst + i) = o; }
}
__device__ __forceinline__ int t5_bucket(int dist) {
    if (dist < 16) return dist;
    const float df = (float)dist;
    int large = 16 + (int)(logf(df / 16.0f) / logf(128.0f) * 16.0f);
    return large < 31 ? large : 31;
}
__device__ __forceinline__ void p0_prologue(const Frame& F_, int l) {
    Frame F = F_;  F.ws = F_.ws + szero();
    LAS float* scr = (LAS float*)(F.lds + F.wave * 16640);
    LAS float* tmp = (LAS float*)(F.lds + 8 * 16640 + F.wave * 512);
#define TRJOB(SRC, LDW, KK, NN, DSTOFF, MODE, KS, LNB, SNOFF) if (!j.hit) { const int items = ((KK) / 64) * ((NN) / 64); if (r < items) { j.hit = true; j.src = (SRC); j.ldw = (LDW); j.K = (KK); j.nblk = (NN) / 64; \
        j.dstoff = (DSTOFF); j.mode = (MODE); j.ks = (KS); j.lnb = (LNB); j.sn = snt + (SNOFF); j.r = r; } else r -= items; }
    const float* wg = INP(4) + (size_t)l * 2 * D * FF; const float* wu = INP(5) + (size_t)l * 2 * D * FF; const float* wd = INP(6) + (size_t)l * 2 * FF * D;
    const float* win = INP(7) + (size_t)l * D * N_IN_SRC;
    const float* wbr = INP(17) + (size_t)l * D * D;
    const float* lng = INP(2); const float* lnb = INP(3);
    const float* g_f0 = l ? lng + (size_t)((l - 1) * 4 + 3) * D : nullptr; const float* b_f0 = l ? lnb + (size_t)((l - 1) * 4 + 3) * D : nullptr;
    const float* g_m = lng + (size_t)(l * 4 + 0) * D; const float* b_m = lnb + (size_t)(l * 4 + 0) * D;
    const float* g_x = lng + (size_t)(l * 4 + 1) * D; const float* b_x = lnb + (size_t)(l * 4 + 1) * D;
    const float* g_f1 = lng + (size_t)(l * 4 + 2) * D; const float* b_f1 = lnb + (size_t)(l * 4 + 2) * D;
    float* snt = (float*)(F.ws + CTL_SNT) + (size_t)l * 2 * SNT_N;
    constexpr int ITEMS = 6 * (D / 64) * (FF / 64) + (D / 64) * (N_IN_SRC / 64) + (512 / 64) * ((QW + KVW) / 64) + 2 * (D / 64) * (D / 64) + (D / 64) * ((512 + 1024) / 64) + (512 / 64) * (D / 64);
    auto select = [&](int it) -> TrJob {
        TrJob j; j.hit = false; j.src = nullptr; j.ks = nullptr; j.lnb = nullptr; j.sn = nullptr; j.ldw = 0; j.K = 0; j.nblk = 1; j.mode = 0; j.r = 0; j.dstoff = 0;
        if (it >= ITEMS) return j;
        int r = it;
        TRJOB(wg, FF, D, FF, W_GU0, 1, g_f0, b_f0, SNT_FFN0)
        TRJOB(wu, FF, D, FF, W_GU0, 2, g_f0, b_f0, SNT_FFN0)
        TRJOB(wd, D, FF, D, W_D0, 0, nullptr, nullptr, 0)
        TRJOB(wg + (size_t)D * FF, FF, D, FF, W_GU1, 1, g_f1, b_f1, SNT_FFN1)
        TRJOB(wu + (size_t)D * FF, FF, D, FF, W_GU1, 2, g_f1, b_f1, SNT_FFN1)
        TRJOB(wd + (size_t)FF * D, D, FF, D, W_D1, 0, nullptr, nullptr, 0)
        TRJOB(win, N_IN_SRC, D, NWIN_SRC, W_IN, 3, g_m, b_m, SNT_WIN)
        TRJOB(win + NWIN_SRC, N_IN_SRC, D, NGATE, W_GATE, 0, g_m, b_m, SNT_GATE)
        TRJOB(INP(10) + (size_t)l * 512 * QW, QW, 512, QW, W_UQ, 4, INP(8) + l * 512, nullptr, 0)
        TRJOB(INP(11) + (size_t)l * 512 * KVW, KVW, 512, KVW, W_UKV, 0, INP(9) + l * 512, nullptr, 0)
        TRJOB(wbr, D, D, D, W_PA, 0, nullptr, nullptr, 0)
        TRJOB(INP(18) + (size_t)l * D * D, D, D, D, W_OUT, 0, nullptr, nullptr, 0)
        TRJOB(INP(19) + (size_t)l * D * 512, 512, D, 512, W_XQ, 0, g_x, b_x, SNT_XQ)
        TRJOB(INP(20) + (size_t)l * D * 1024, 1024, D, 1024, W_XKV, 0, nullptr, nullptr, 0)
        TRJOB(INP(21) + (size_t)l * 512 * D, D, 512, D, W_XO, 0, nullptr, nullptr, 0)
        return j;
    };
    {
        f32x4 va[16], vb[16];
        int it = F.gw; TrJob ja = select(it); if (ja.hit) tr_load(ja, va, LANE_);
        while (ja.hit) {
            TrJob jb = select(it + F.NGW); if (jb.hit) tr_load(jb, vb, LANE_);
            tr_store(ja, va, F.ws, scr, tmp, LANE_);
            if (!jb.hit) break;
            it += 2 * F.NGW; ja = select(it); if (ja.hit) tr_load(ja, va, LANE_);
            tr_store(jb, vb, F.ws, scr, tmp, LANE_);
        }
    }
#undef TRJOB
    { bf16* pad = wsp<bf16>(F, W_IN) + (size_t)NWIN_SRC * D; const size_t n = (size_t)(NWIN - NWIN_SRC) * D;
      const unsigned z_ = (unsigned)vlaunder(0);
      for (size_t i = ((size_t)F.gw * 64 + LANE_) * 8; i < n; i += (size_t)F.NGW * 64 * 8) *(u32x4*)(pad + i) = (u32x4){z_, z_, z_, z_}; }
    { const float* ws_ = INP(14) + (size_t)l * 4 * 128 * 128; bf16* o = wsp<bf16>(F, TAB_SGUW);
      for (int i = F.gw * 64 + LANE_; i < 4 * 128 * 128; i += F.NGW * 64) { const int t = (i >> 7) & 127, s = i & 127; o[i] = (bf16)(pk2(s <= t ? ws_[i] : 0.f, 0.f) & 0xffffu); } }
    if (l == 0) {
        cvt_rows(F, INP(0), wsp<bf16>(F, WS_XB), (size_t)M * D);
        cvt_rows(F, INP(1), wsp<bf16>(F, WS_MEMB), (size_t)BATCH * MEM * D);
        float* cosT = wsp<float>(F, TAB_COS); float* sinT = wsp<float>(F, TAB_SIN);
        for (int i = F.gw * 64 + LANE_; i < SEQ * 32; i += F.NGW * 64) { const int pos = i >> 5, j = i & 31;
            const float inv = powf(10000.0f, -(float)(2 * j) / 64.0f); const float ang = (float)pos * inv; cosT[i] = cosf(ang); sinT[i] = sinf(ang); }
        float* bt = wsp<float>(F, TAB_BIAS); const float* rel = INP(16);
        for (int i = F.gw * 64 + LANE_; i < 12 * BIAS_STRIDE; i += F.NGW * 64) { const int gh = i / BIAS_STRIDE, j = i - gh * BIAS_STRIDE; const int g = gh >> 2;
            const int dil = g == 0 ? 1 : (g == 1 ? 4 : 16);
            bt[i] = j <= 128 ? rel[t5_bucket(j * dil) * 12 + gh] * LOG2E : 0.f; }
    }
}

__device__ __forceinline__ void ln_final(const Frame& F, const bf16* ZH, const bf16* ZLo, float* out, const float* g, const float* b) {
    const int lane_ = vlaunder(LANE_);
    for (int m = F.gw; m < M; m += F.NGW) {
        const GAS u32x4* hr = (const GAS u32x4*)(ZH + (size_t)m * D) + lane_; const GAS u32x4* lr = (const GAS u32x4*)(ZLo + (size_t)m * D) + lane_;
        float v[4][8]; float s = 0.f;
#pragma unroll
        for (int j = 0; j < 4; ++j) { const u32x4 h = hr[64 * j], l = lr[64 * j];
            v[j][0] = bflo(h.x) + bflo(l.x); v[j][1] = bfhi(h.x) + bfhi(l.x); v[j][2] = bflo(h.y) + bflo(l.y); v[j][3] = bfhi(h.y) + bfhi(l.y);
            v[j][4] = bflo(h.z) + bflo(l.z); v[j][5] = bfhi(h.z) + bfhi(l.z); v[j][6] = bflo(h.w) + bflo(l.w); v[j][7] = bfhi(h.w) + bfhi(l.w);
#pragma unroll
            for (int e = 0; e < 8; ++e) s += v[j][e]; }
        const float mean = wave_sum(s) * (1.f / D); float s2 = 0.f;
#pragma unroll
        for (int j = 0; j < 4; ++j)
#pragma unroll
            for (int e = 0; e < 8; ++e) { v[j][e] -= mean; s2 += v[j][e] * v[j][e]; }
        const float rstd = 1.f / sqrtf(wave_sum(s2) * (1.f / D) + LN_EPS);
        GAS f32x4* orow = (GAS f32x4*)(out + (size_t)m * D);
#pragma unroll
        for (int j = 0; j < 4; ++j) { const int c = 8 * (lane_ + 64 * j);
            const f32x4 g0 = *(const f32x4*)(g + c), g1 = *(const f32x4*)(g + c + 4), b0 = *(const f32x4*)(b + c), b1 = *(const f32x4*)(b + c + 4);
            orow[2 * (lane_ + 64 * j)] = (f32x4){v[j][0] * rstd * g0.x + b0.x, v[j][1] * rstd * g0.y + b0.y, v[j][2] * rstd * g0.z + b0.z, v[j][3] * rstd * g0.w + b0.w};
            orow[2 * (lane_ + 64 * j) + 1] = (f32x4){v[j][4] * rstd * g1.x + b1.x, v[j][5] * rstd * g1.y + b1.y, v[j][6] * rstd * g1.z + b1.z, v[j][7] * rstd * g1.w + b1.w}; }
    }
}

constexpr int AT_KN = 0, AT_KR = 16384, AT_V = 24576, AT_BUF = 43008, AT_BIAS = 4 * (16384 + 18432);
constexpr int VPITCH = 288;
template <int DK, int QT, int NWV, class Src, class Msk>
__device__ __forceinline__ void attn_unit(const Frame& F, const Src& src, const Msk& msk, int kt0, int kt1) {
    constexpr int KS = DK / 32, NKC = DK == 192 ? 3 : 2, NT = 64 * NWV, NI = 1024 / NT, BUFB = (NWV == 8) ? AT_BUF : (AT_KR + 18432), OFF_V = (NWV == 8) ? AT_V : AT_KR;
    static_assert(NWV == 8 || DK == 128, "the half-workgroup form has no rope buffer");
    const int tid_ = vlaunder(TID_), lane = tid_ & 63, tid = tid_ & (NT - 1), w = F.wave & (NWV - 1), q16 = lane & 15, kq = lane >> 4;
    LAS unsigned char* lds = F.lds + (F.wave / NWV) * (2 * BUFB);
    bf16x8 qf[QT][KS];
#pragma unroll
    for (int qt = 0; qt < QT; ++qt) { const bf16* qr = src.qrow(w * 16 * QT + 16 * qt + q16);
#pragma unroll
        for (int ks = 0; ks < KS; ++ks) qf[qt][ks] = *(const bf16x8*)(qr + 32 * ks + 8 * kq); }
    f32x4 o[QT][8];
    float mrun[QT], lrun[QT];
    float z0 = 0.f; asm volatile("" : "+v"(z0));
#pragma unroll
    for (int qt = 0; qt < QT; ++qt) { mrun[qt] = NEGBIG; lrun[qt] = z0;
#pragma unroll
        for (int dt = 0; dt < 8; ++dt) o[qt][dt] = (f32x4){z0, z0, z0, z0}; }
    u32x4 kr[NI + (DK == 192 ? 1 : 0)], vr[NI];
#define AT_LOAD(kt) do { const int kb = 64 * (kt); \
        _Pragma("unroll") for (int i = 0; i < NI; ++i) { const int it = tid + NT * i, row = it >> 4, ch = it & 15; kr[i] = *(const u32x4*)src.kptr(kb + row, ch); vr[i] = *(const u32x4*)src.vptr(kb + row, ch); } \
        if (DK == 192) { const int row = tid >> 3, ch = tid & 7; kr[NI] = *(const u32x4*)src.kptr(kb + row, 16 + ch); } } while (0)
#define AT_STORE(buf) do { LAS unsigned char* bb = lds + (buf) * BUFB; \
        _Pragma("unroll") for (int i = 0; i < NI; ++i) { const int it = tid + NT * i, row = it >> 4, ch = it & 15; \
            *(LAS u32x4*)(bb + AT_KN + row * 256 + ((ch ^ (row & 15)) << 4)) = kr[i]; *(LAS u32x4*)(bb + OFF_V + row * VPITCH + (ch << 4)) = vr[i]; } \
        if (DK == 192) { const int row = tid >> 3, ch = tid & 7; *(LAS u32x4*)(bb + AT_KR + row * 128 + ((ch ^ ((row >> 1) & 7)) << 4)) = kr[NI]; } } while (0)
    AT_LOAD(kt0); AT_STORE(0);
    __syncthreads();
    for (int kt = kt0; kt < kt1; ++kt) {
        const int buf = (kt - kt0) & 1;
        if (kt + 1 < kt1) AT_LOAD(kt + 1);
        if (msk.active(w, kt)) {
            const LAS unsigned char* bb = lds + buf * BUFB;
            f32x4 s[QT][4];
#pragma unroll
            for (int qt = 0; qt < QT; ++qt)
#pragma unroll
                for (int sub = 0; sub < 4; ++sub) s[qt][sub] = (f32x4){0.f, 0.f, 0.f, 0.f};
#pragma unroll
            for (int sub = 0; sub < 4; ++sub) {
                const int row = 16 * sub + q16;
#pragma unroll
                for (int ks = 0; ks < KS; ++ks) {
                    bf16x8 kf;
                    if (ks < 4) kf = *(const LAS bf16x8*)(bb + AT_KN + row * 256 + (((4 * ks + kq) ^ q16) << 4));
                    else        kf = *(const LAS bf16x8*)(bb + AT_KR + row * 128 + (((4 * (ks - 4) + kq) ^ (q16 >> 1)) << 4));
#pragma unroll
                    for (int qt = 0; qt < QT; ++qt) s[qt][sub] = __builtin_amdgcn_mfma_f32_16x16x32_bf16(kf, qf[qt][ks], s[qt][sub], 0, 0, 0);
                }
            }
            bf16x8 pf[QT][2];
#pragma unroll
            for (int qt = 0; qt < QT; ++qt) {
                const int ql = w * 16 * QT + 16 * qt + q16;
                float mx = NEGBIG;
#pragma unroll
                for (int sub = 0; sub < 4; ++sub)
#pragma unroll
                    for (int j = 0; j < 4; ++j) { const float v = msk.apply(s[qt][sub][j], ql, 64 * kt + 16 * sub + 4 * kq + j); s[qt][sub][j] = v; mx = fmaxf(mx, v); }
                mx = fmaxf(mx, shx(mx, 16)); mx = fmaxf(mx, shx(mx, 32));
                const float mnew = fmaxf(mrun[qt], mx), alpha = __builtin_amdgcn_exp2f(mrun[qt] - mnew);
                mrun[qt] = mnew;
                float rs = 0.f;
#pragma unroll
                for (int sub = 0; sub < 4; ++sub)
#pragma unroll
                    for (int j = 0; j < 4; ++j) { const float p = __builtin_amdgcn_exp2f(s[qt][sub][j] - mnew); s[qt][sub][j] = p; rs += p; }
                lrun[qt] = lrun[qt] * alpha + rs;
#pragma unroll
                for (int dt = 0; dt < 8; ++dt) o[qt][dt] *= alpha;
#pragma unroll
                for (int c = 0; c < 2; ++c) {
                    u32x4 pw; pw.x = pk2(s[qt][2 * c][0], s[qt][2 * c][1]); pw.y = pk2(s[qt][2 * c][2], s[qt][2 * c][3]);
                    pw.z = pk2(s[qt][2 * c + 1][0], s[qt][2 * c + 1][1]); pw.w = pk2(s[qt][2 * c + 1][2], s[qt][2 * c + 1][3]);
                    pf[qt][c] = __builtin_bit_cast(bf16x8, pw);
                }
            }
            const LAS unsigned char* vb = bb + OFF_V + (4 * kq + (q16 >> 2)) * VPITCH + (q16 & 3) * 8;
#pragma unroll
            for (int c = 0; c < 2; ++c)
#pragma unroll
                for (int dt = 0; dt < 8; ++dt) {
                    const s16x4 lo = __builtin_bit_cast(s16x4, __builtin_amdgcn_ds_read_tr16_b64_v4i16((LAS s16x4*)(vb + (32 * c) * VPITCH + dt * 32)));
                    const s16x4 hi = __builtin_bit_cast(s16x4, __builtin_amdgcn_ds_read_tr16_b64_v4i16((LAS s16x4*)(vb + (32 * c + 16) * VPITCH + dt * 32)));
                    const bf16x8 vf = __builtin_shufflevector(lo, hi, 0, 1, 2, 3, 4, 5, 6, 7);
#pragma unroll
                    for (int qt = 0; qt < QT; ++qt) o[qt][dt] = __builtin_amdgcn_mfma_f32_16x16x32_bf16(vf, pf[qt][c], o[qt][dt], 0, 0, 0);
                }
        }
        if (kt + 1 < kt1) AT_STORE(buf ^ 1);
        __syncthreads();
    }
#undef AT_LOAD
#undef AT_STORE
#pragma unroll
    for (int qt = 0; qt < QT; ++qt) {
        float l = lrun[qt]; l += shx(l, 16); l += shx(l, 32);
        const float inv = 1.0f / l;
        const int ql = w * 16 * QT + 16 * qt + q16;
        bf16* orow = src.orow(ql);
#pragma unroll
        for (int dt = 0; dt < 8; ++dt) { const f32x4 v = o[qt][dt] * inv; *(u32x2*)(orow + 16 * dt + 4 * kq) = (u32x2){pk2(v.x, v.y), pk2(v.z, v.w)}; }
        if (kq == 0) src.put_lse(ql, (mrun[qt] + __builtin_amdgcn_logf(l)) * LN2);
    }
}

struct MlaSrc {
    const bf16* Q; const bf16* KV; const bf16* KPE; bf16* O; size_t rb; int h, q0;
    __device__ __forceinline__ const bf16* qrow(int r) const { return Q + (rb + q0 + r) * QW + h * 192; }
    __device__ __forceinline__ const bf16* kptr(int key, int ch) const { return ch < 16 ? KV + (rb + key) * KVW + h * 256 + ch * 8 : KPE + (rb + key) * 64 + (ch - 16) * 8; }
    __device__ __forceinline__ const bf16* vptr(int key, int ch) const { return KV + (rb + key) * KVW + h * 256 + 128 + ch * 8; }
    __device__ __forceinline__ bf16* orow(int r) const { return O + (rb + q0 + r) * 1024 + h * 128; }
    __device__ __forceinline__ void put_lse(int, float) const {}
};
struct MlaMsk {
    int q0; float c;
    __device__ __forceinline__ bool active(int w, int kt) const { return 64 * kt <= q0 + 32 * w + 31; }
    __device__ __forceinline__ float apply(float s, int ql, int key) const { return key <= q0 + ql ? s * c : NEGBIG; }
};
struct XaSrc {
    const bf16* Q; const bf16* KVX; bf16* O; size_t rb, kb; int h, q0;
    __device__ __forceinline__ const bf16* qrow(int r) const { return Q + (rb + q0 + r) * 512 + h * 128; }
    __device__ __forceinline__ const bf16* kptr(int key, int ch) const { return KVX + (kb + key) * 1024 + h * 128 + ch * 8; }
    __device__ __forceinline__ const bf16* vptr(int key, int ch) const { return KVX + (kb + key) * 1024 + 512 + h * 128 + ch * 8; }
    __device__ __forceinline__ bf16* orow(int r) const { return O + (rb + q0 + r) * 512 + h * 128; }
    __device__ __forceinline__ void put_lse(int, float) const {}
};
struct XaMsk {
    float c;
    __device__ __forceinline__ bool active(int, int) const { return true; }
    __device__ __forceinline__ float apply(float s, int, int) const { return s * c; }
};
struct DilSrc {
    bf16* QKV; float* LSE; size_t rb; int dil, r, n, col;
    __device__ __forceinline__ size_t row(int sub) const { return rb + (size_t)sub * dil + r; }
    __device__ __forceinline__ const bf16* qrow(int q) const { return QKV + row(128 * n + q) * QKVW + col; }
    __device__ __forceinline__ const bf16* kptr(int k, int ch) const { return QKV + row(128 * (n - 1) + k) * QKVW + 1536 + col + ch * 8; }
    __device__ __forceinline__ const bf16* vptr(int k, int ch) const { return QKV + row(128 * (n - 1) + k) * QKVW + 3072 + col + ch * 8; }
    __device__ __forceinline__ bf16* orow(int q) const { return QKV + row(128 * n + q) * QKVW + col; }
    __device__ __forceinline__ void put_lse(int q, float v) const { LSE[row(128 * n + q) * 4] = v; }
};
struct DilMsk {
    const LAS float* bias; float c;
    __device__ __forceinline__ bool active(int w, int kt) const { return 64 * kt + 63 >= 32 * w && 64 * kt <= 32 * w + 31 + 128; }
    __device__ __forceinline__ float apply(float s, int ql, int k) const { const int j = ql + 128 - k; const int jc = j < 0 ? 0 : (j > 128 ? 128 : j); const float bv = bias[jc]; return (j >= 0 && j <= 128) ? s * c + bv : NEGBIG; }
};

constexpr int SG_PITCH = 1056;
__device__ __forceinline__ void sgu_unit(const Frame& F, bf16* Z, const float* lng, const float* lnb, const bf16* SW, const float* bs, int unit) {
    const int lane = vlaunder(LANE_), w = F.wave, q16 = lane & 15, kq = lane >> 4;
    const size_t m0 = (size_t)unit * 128;
    LAS unsigned char* lds = F.lds;
    float gg[8], bb[8];
    { const f32x4 g0 = *(const f32x4*)(lng + 8 * lane), g1 = *(const f32x4*)(lng + 8 * lane + 4), b0 = *(const f32x4*)(lnb + 8 * lane), b1 = *(const f32x4*)(lnb + 8 * lane + 4);
      gg[0] = g0.x; gg[1] = g0.y; gg[2] = g0.z; gg[3] = g0.w; gg[4] = g1.x; gg[5] = g1.y; gg[6] = g1.z; gg[7] = g1.w;
      bb[0] = b0.x; bb[1] = b0.y; bb[2] = b0.z; bb[3] = b0.w; bb[4] = b1.x; bb[5] = b1.y; bb[6] = b1.z; bb[7] = b1.w; }
#pragma unroll 1
    for (int hb = 0; hb < 2; ++hb) {
        u32x4 raw[8]; float s[8], q[8];
#pragma unroll
        for (int i = 0; i < 8; ++i) raw[i] = *(const u32x4*)(Z + (m0 + 16 * w + 8 * hb + i) * ZW + 512 + 8 * lane);
#pragma unroll
        for (int i = 0; i < 8; ++i) s[i] = ((bflo(raw[i].x) + bfhi(raw[i].x)) + (bflo(raw[i].y) + bfhi(raw[i].y))) + ((bflo(raw[i].z) + bfhi(raw[i].z)) + (bflo(raw[i].w) + bfhi(raw[i].w)));
#pragma unroll
        for (int o = 1; o < 64; o <<= 1) {
#pragma unroll
            for (int i = 0; i < 8; ++i) s[i] += shx_l(s[i], o, lane); }
#pragma unroll
        for (int i = 0; i < 8; ++i) { const float mean = s[i] * (1.f / 512.f); s[i] = mean;
            const float v[8] = {bflo(raw[i].x) - mean, bfhi(raw[i].x) - mean, bflo(raw[i].y) - mean, bfhi(raw[i].y) - mean, bflo(raw[i].z) - mean, bfhi(raw[i].z) - mean, bflo(raw[i].w) - mean, bfhi(raw[i].w) - mean};
            float a2 = 0.f;
#pragma unroll
            for (int j = 0; j < 8; ++j) a2 += v[j] * v[j];
            q[i] = a2; }
#pragma unroll
        for (int o = 1; o < 64; o <<= 1) {
#pragma unroll
            for (int i = 0; i < 8; ++i) q[i] += shx_l(q[i], o, lane); }
#pragma unroll
        for (int i = 0; i < 8; ++i) { const float mean = s[i], rstd = 1.f / sqrtf(q[i] * (1.f / 512.f) + LN_EPS);
            float v[8] = {bflo(raw[i].x), bfhi(raw[i].x), bflo(raw[i].y), bfhi(raw[i].y), bflo(raw[i].z), bfhi(raw[i].z), bflo(raw[i].w), bfhi(raw[i].w)};
#pragma unroll
            for (int j = 0; j < 8; ++j) v[j] = (v[j] - mean) * rstd * gg[j] + bb[j];
            u32x4 o; o.x = pk2(v[0], v[1]); o.y = pk2(v[2], v[3]); o.z = pk2(v[4], v[5]); o.w = pk2(v[6], v[7]);
            *(LAS u32x4*)(lds + (16 * w + 8 * hb + i) * SG_PITCH + lane * 16) = o; }
    }
    __syncthreads();
    const int g = w >> 1, th = w & 1;
    bf16x8 wf[4][4];
#pragma unroll
    for (int tt = 0; tt < 4; ++tt) { const bf16* wr_ = SW + (size_t)g * 128 * 128 + (size_t)(16 * (4 * th + tt) + q16) * 128;
#pragma unroll
        for (int ks = 0; ks < 4; ++ks) { const u32x2 a = *(const u32x2*)(wr_ + 32 * ks + 4 * kq), b = *(const u32x2*)(wr_ + 32 * ks + 16 + 4 * kq);
            wf[tt][ks] = __builtin_bit_cast(bf16x8, (u32x4){a.x, a.y, b.x, b.y}); } }
    const LAS unsigned char* vb = lds + (4 * kq + (q16 >> 2)) * SG_PITCH + g * 256 + (q16 & 3) * 8;
#pragma unroll 1
    for (int dt = 0; dt < 8; ++dt) {
        f32x4 acc[4];
#pragma unroll
        for (int tt = 0; tt < 4; ++tt) acc[tt] = (f32x4){0.f, 0.f, 0.f, 0.f};
#pragma unroll
        for (int ks = 0; ks < 4; ++ks) {
            const s16x4 lo = __builtin_bit_cast(s16x4, __builtin_amdgcn_ds_read_tr16_b64_v4i16((LAS s16x4*)(vb + (32 * ks) * SG_PITCH + dt * 32)));
            const s16x4 hi = __builtin_bit_cast(s16x4, __builtin_amdgcn_ds_read_tr16_b64_v4i16((LAS s16x4*)(vb + (32 * ks + 16) * SG_PITCH + dt * 32)));
            const bf16x8 af = __builtin_shufflevector(lo, hi, 0, 1, 2, 3, 4, 5, 6, 7);
#pragma unroll
            for (int tt = 0; tt < 4; ++tt) acc[tt] = __builtin_amdgcn_mfma_f32_16x16x32_bf16(af, wf[tt][ks], acc[tt], 0, 0, 0);
        }
#pragma unroll
        for (int tt = 0; tt < 4; ++tt) {
            const int t = 16 * (4 * th + tt) + q16;
            const float bias = bs[g * 128 + t];
            bf16* up = Z + (m0 + t) * ZW + g * 128 + 16 * dt + 4 * kq;
            const u32x2 uu = *(const u32x2*)up;
            const float o0 = bflo(uu.x) * (acc[tt].x + bias), o1 = bfhi(uu.x) * (acc[tt].y + bias), o2 = bflo(uu.y) * (acc[tt].z + bias), o3 = bfhi(uu.y) * (acc[tt].w + bias);
            *(u32x2*)up = (u32x2){pk2(o0, o1), pk2(o2, o3)};
        }
    }
    __syncthreads();
}

__device__ __forceinline__ void dil_combine(const Frame& F, const bf16* QKV, const float* LSE, bf16* OC) {
    const int lane = vlaunder(LANE_), hh = lane >> 4;
    for (int m = F.gw; m < M; m += F.NGW) {
        const float l0 = LSE[((size_t)0 * M + m) * 4 + hh], l1 = LSE[((size_t)1 * M + m) * 4 + hh], l2 = LSE[((size_t)2 * M + m) * 4 + hh];
        const float mx = fmaxf(l0, fmaxf(l1, l2));
        float w0 = __expf(l0 - mx), w1 = __expf(l1 - mx), w2 = __expf(l2 - mx);
        const float inv = 1.0f / (w0 + w1 + w2); w0 *= inv; w1 *= inv; w2 *= inv;
        const bf16* qr = QKV + (size_t)m * QKVW + hh * 128 + (lane & 15) * 8;
        const u32x4 a = *(const u32x4*)qr, b = *(const u32x4*)(qr + 512), c = *(const u32x4*)(qr + 1024);
        u32x4 o;
        o.x = pk2(w0 * bflo(a.x) + w1 * bflo(b.x) + w2 * bflo(c.x), w0 * bfhi(a.x) + w1 * bfhi(b.x) + w2 * bfhi(c.x));
        o.y = pk2(w0 * bflo(a.y) + w1 * bflo(b.y) + w2 * bflo(c.y), w0 * bfhi(a.y) + w1 * bfhi(b.y) + w2 * bfhi(c.y));
        o.z = pk2(w0 * bflo(a.z) + w1 * bflo(b.z) + w2 * bflo(c.z), w0 * bfhi(a.z) + w1 * bfhi(b.z) + w2 * bfhi(c.z));
        o.w = pk2(w0 * bflo(a.w) + w1 * bflo(b.w) + w2 * bflo(c.w), w0 * bfhi(a.w) + w1 * bfhi(b.w) + w2 * bfhi(c.w));
        *(u32x4*)(OC + (size_t)m * 512 + hh * 128 + (lane & 15) * 8) = o;
    }
}

struct Args { const float* in[22]; float* out; unsigned char* ws; };
#define GEMM_CALL(EPI, E, Aptr, LDA, Bptr, MM, NN, KK) do { pg8::Gemm g_{(Aptr), (Bptr), (LDA), (MM), (NN), (KK)}; pg8::StaticOrder S_; S_.init((MM), (NN), F.G, (int)blockIdx.x); \
        pg8::gemm_phase<EPI, pg8::StaticOrder, true, true>(F.lds, g_, S_, (E)); } while (0)

__global__ void __launch_bounds__(NTHR, 2) fwd_kernel(Args args) {
    extern __shared__ __attribute__((aligned(16))) unsigned char lds_raw[];
    Frame F;
    F.lds = (LAS unsigned char*)lds_raw;
    F.wave = __builtin_amdgcn_readfirstlane(TID_ >> 6);
    F.G = gridDim.x; { const int bx = blockIdx.x; F.vcu = (F.G % 8 == 0) ? (bx % 8) * (F.G / 8) + bx / 8 : bx; }
    F.gw = F.vcu * NWAVES + F.wave; F.NGW = F.G * NWAVES;
    F.ws = args.ws; F.ctl = (gu32*)(args.ws + WS_CTL); F.out = args.out;
    volatile LAS unsigned* MISC = (volatile LAS unsigned*)(F.lds + MISC_OFF);
    for (int u = TID_; u < (LDS_BYTES - LDSCTL_OFF) / 4; u += NTHR) ((LAS unsigned*)(F.lds + LDSCTL_OFF))[u] = 0u;
    __syncthreads();
    if (TID_ < 22) *(LAS unsigned long long*)(F.lds + PTR_OFF + 8 * TID_) = (unsigned long long)args.in[TID_];
    __syncthreads();
    XcdBarrier bar = xcd_barrier_post((unsigned*)(F.ctl + CW_BAR), MISC + 8);
#define GRID_BAR() xcd_barrier(bar)

#define WSL ws_launder(F.ws)
#define XB ((bf16*)(WSL + WS_XB))
#define HB ((bf16*)(WSL + R_H))
#define cosT ((const float*)(WSL + TAB_COS))
#define sinT ((const float*)(WSL + TAB_SIN))
#define ZLO ((bf16*)(F.out + szero()))
#define ZLAST ((bf16*)(WSL + R_QM))
#define CQ ((bf16*)(WSL + R_CQ))
#define CKV ((bf16*)(WSL + R_CKV))
#define ZB ((bf16*)(WSL + R_Z))
#define QKV ((bf16*)(WSL + R_QKV))
#define KPE ((bf16*)(WSL + R_KPE))
#define QM ((bf16*)(WSL + R_QM))
#define KVM ((bf16*)(WSL + R_KVM))
#define OA ((bf16*)(WSL + R_OA))
#define OC ((bf16*)(WSL + R_OC))
#define GATE ((bf16*)(WSL + R_GATE))
#define MG ((bf16*)(WSL + R_MERGED))
#define KVX ((bf16*)(WSL + WS_KVX))
#define QX ((bf16*)(WSL + R_QX))
#define OX ((bf16*)(WSL + R_OX))
#define LSE ((float*)(WSL + WS_LSE))
#define WP(off) ((bf16*)(WSL + (off)))
#define ssq_q ((float*)(WSL + CTL_SSQ) + (size_t)(l * 2 + 0) * M)
#define ssq_kv ((float*)(WSL + CTL_SSQ) + (size_t)(l * 2 + 1) * M)
#define STATS(site) ((float*)(WSL + CTL_STATS) + (size_t)(site) * M * 2)
#define SNP(off) ((const float*)(WSL + CTL_SNT) + (size_t)l * 2 * SNT_N + (off))
#define LNG(site) (INP(2) + (size_t)(site) * D)
#define LNB(site) (INP(3) + (size_t)(site) * D)
#define LNFOLD(site, off) LnFold{STATS(site), SNP(off), SNP(off) + SNT_N}
#define NOLN LnFold{nullptr, nullptr, nullptr}

    for (int l = 0; l < DEPTH; ++l) {
        p0_prologue(F, l);
        GRID_BAR();
        for (int f = 0; f < 2; ++f) {
            if (f == 1) {
                { EpiWin E{CQ, CKV, ZB, QKV, KPE, ssq_q, ssq_kv, cosT, sinT, LNFOLD(l * 4 + 0, SNT_WIN)}; GEMM_CALL(EpiWin, E, XB, D, WP(W_IN), M, NWIN, D); }
                if ((int)blockIdx.x >= F.G / 2) { EpiBf<0> E{KVX, 1024, nullptr, nullptr, nullptr, NOLN}; pg8::Gemm g_{WP(WS_MEMB), WP(W_XKV), D, BATCH * MEM, 1024, D}; pg8::StaticOrder S_; S_.init(BATCH * MEM, 1024, F.G / 2, (int)blockIdx.x - F.G / 2);
                    pg8::gemm_phase<EpiBf<0>, pg8::StaticOrder, true, true>(F.lds, g_, S_, E); }
                GRID_BAR();
                { EpiBf<2> E{QM, QW, ssq_q, cosT, sinT, NOLN}; GEMM_CALL(EpiBf<2>, E, CQ, 512, WP(W_UQ), M, QW, 512); }
                { EpiBf<1> E{KVM, KVW, ssq_kv, nullptr, nullptr, NOLN}; GEMM_CALL(EpiBf<1>, E, CKV, 512, WP(W_UKV), M, KVW, 512); }
                for (int u = blockIdx.x; u < BATCH * 16; u += F.G)
                    sgu_unit(F, ZB, INP(12) + l * 512, INP(13) + l * 512, WP(TAB_SGUW), INP(15) + l * 512, u);
                for (int u0 = blockIdx.x; u0 < 3 * BATCH * 16 * 4; u0 += 2 * F.G) {
                    const int u = u0 + (F.wave >> 2) * F.G;
                    const int hh = u & 3, blk = (u >> 2) & 15, b = (u >> 6) & 15, g = u >> 10;
                    const int dil = g == 0 ? 1 : (g == 1 ? 4 : 16), nb = 16 / dil;
                    const int r = blk / nb, n = blk - r * nb;
                    LAS float* bl = (LAS float*)(F.lds + AT_BIAS);
                    { const int t_ = vlaunder(TID_); if (t_ < BIAS_STRIDE) bl[t_] = ((const float*)(WSL + TAB_BIAS))[(g * 4 + hh) * BIAS_STRIDE + t_]; }
                    DilSrc src{QKV, LSE + (size_t)g * M * 4 + hh, (size_t)b * SEQ, dil, r, n, (4 * g + hh) * 128};
                    DilMsk msk{bl, 0.08838834764831845f * LOG2E};
                    attn_unit<128, 2, 4>(F, src, msk, n == 0 ? 2 : 0, 4);
                }
                GRID_BAR();
                for (int u = blockIdx.x; u < BATCH * 8 * 8; u += F.G) {
                    const int c = u % F.G, i = u / F.G;
                    int bh, qb;
                    if (F.G == 256) { bh = 2 * (c >> 2) + (i & 1); qb = (i >> 1) ? 7 - (c & 3) : (c & 3); } else { bh = u >> 3; qb = u & 7; }
                    const int b = bh >> 3, h = bh & 7;
                    MlaSrc src{QM, KVM, KPE, OA, (size_t)b * SEQ, h, qb * 256};
                    MlaMsk msk{qb * 256, 0.07216878364870322f * LOG2E};
                    attn_unit<192, 2, 8>(F, src, msk, 0, (qb + 1) * 4);
                }
                dil_combine(F, QKV, LSE, OC);
                GRID_BAR();
                { EpiGate8 E{(unsigned char*)GATE, LNFOLD(l * 4 + 0, SNT_GATE)}; GEMM_CALL(EpiGate8, E, XB, D, WP(W_GATE), M, NGATE, D); }
                GRID_BAR();
                { EpiMerge E{(const unsigned char*)GATE, MG}; pg8::Gemm g_{nullptr, WP(W_PA), D, M, D, D}; pg8::ASeg3 AS_{OA, ZB, OC, 1024, 512, 16, 24};
                  pg8::StaticOrder S_; S_.init(M, D, F.G, (int)blockIdx.x); pg8::gemm_phase_seg<EpiMerge, pg8::StaticOrder, true, pg8::ASeg3>(F.lds, g_, AS_, S_, E); }
                GRID_BAR();
                { EpiResidLn E{nullptr, XB, ZLO, ZLO, STATS(l * 4 + 0), LNG(l * 4 + 0), LNB(l * 4 + 0), STATS(l * 4 + 1), ALPHA, 1.0f}; GEMM_CALL(EpiResidLn, E, MG, D, WP(W_OUT), M, D, D); }
                GRID_BAR();
                { EpiBf<0> E{QX, 512, nullptr, nullptr, nullptr, LNFOLD(l * 4 + 1, SNT_XQ)}; GEMM_CALL(EpiBf<0>, E, XB, D, WP(W_XQ), M, 512, D); }
                GRID_BAR();
                for (int u = blockIdx.x; u < BATCH * 4 * 8; u += F.G) {
                    const int qb = u & 7, h = (u >> 3) & 3, b = u >> 5;
                    XaSrc src{QX, KVX, OX, (size_t)b * SEQ, (size_t)b * MEM, h, qb * 256};
                    XaMsk msk{0.08838834764831845f * LOG2E};
                    attn_unit<128, 2, 8>(F, src, msk, 0, 4);
                }
                GRID_BAR();
                { EpiResidLn E{nullptr, XB, ZLO, ZLO, STATS(l * 4 + 1), LNG(l * 4 + 1), LNB(l * 4 + 1), STATS(l * 4 + 2), ALPHA, 1.0f}; GEMM_CALL(EpiResidLn, E, OX, 512, WP(W_XO), M, D, 512); }
                GRID_BAR();
            }
            const int site_in = f ? l * 4 + 2 : l * 4 - 1, site_out = f ? l * 4 + 3 : l * 4;
            const bool raw_in = (l == 0 && f == 0);
            { EpiSwiglu E{HB, raw_in ? NOLN : LNFOLD(site_in, f ? SNT_FFN1 : SNT_FFN0)}; GEMM_CALL(EpiSwiglu, E, XB, D, WP(f ? W_GU1 : W_GU0), M, 2 * FF, D); }
            GRID_BAR();
            { EpiResidLn E{raw_in ? INP(0) : nullptr, XB, ZLO, (l == DEPTH - 1 && f == 1) ? ZLAST : ZLO, STATS(raw_in ? 0 : site_in), LNG(raw_in ? 0 : site_in), LNB(raw_in ? 0 : site_in), STATS(site_out), ALPHA, 0.5f};
                GEMM_CALL(EpiResidLn, E, HB, FF_LD, WP(f ? W_D1 : W_D0), M, D, FF); }
            GRID_BAR();
        }
    }
    ln_final(F, XB, ZLAST, F.out + szero(), INP(2) + (size_t)7 * D, INP(3) + (size_t)7 * D);

}

extern "C" void kernel_launch(void* const* d_in, const int* in_sizes, int n_in, void* d_out, int out_size, void* d_ws, size_t ws_size, hipStream_t stream) {
    static int grid = 0;
    if (grid == 0) {
        if (n_in != 22 || in_sizes[0] != M * D || out_size != M * D || ws_size < WS_NEED) {
            fprintf(stderr, "kernel_launch: unexpected problem: n_in %d in0 %d out %d ws %zu (need %zu); nothing launched\n", n_in, n_in > 0 ? in_sizes[0] : -1, out_size, ws_size, (size_t)WS_NEED); grid = -1; return; }
        int dev = 0, cus = 0, per_cu = 0;
        if (hipGetDevice(&dev) != hipSuccess || hipDeviceGetAttribute(&cus, hipDeviceAttributeMultiprocessorCount, dev) != hipSuccess) { grid = -1; return; }
        if (hipFuncSetAttribute((const void*)fwd_kernel, hipFuncAttributeMaxDynamicSharedMemorySize, LDS_BYTES) != hipSuccess) { fprintf(stderr, "kernel_launch: hipFuncSetAttribute failed\n"); grid = -1; return; }
        if (hipOccupancyMaxActiveBlocksPerMultiprocessor(&per_cu, (const void*)fwd_kernel, NTHR, LDS_BYTES) != hipSuccess || per_cu < 1)
            fprintf(stderr, "kernel_launch: note: occupancy query reports %d workgroups per CU\n", per_cu);
        (void)hipGetLastError();
        if (cus != 256) { fprintf(stderr, "kernel_launch: built for a 256-CU device (unit deals and the paired dilated-attention units assume 256 workgroups), found %d CUs; nothing launched\n", cus); grid = -1; return; }
        grid = cus;
    }
    if (grid < 0) return;
    if (hipMemsetAsync((char*)d_ws + WS_CTL, 0, CTL_ZERO_BYTES, stream) != hipSuccess) return;
    Args a{};
    for (int i = 0; i < 22; ++i) a.in[i] = (const float*)d_in[i];
    a.out = (float*)d_out; a.ws = (unsigned char*)d_ws;
    hipLaunchKernelGGL(fwd_kernel, dim3(grid), dim3(NTHR), LDS_BYTES, stream, a);
    const hipError_t le = hipPeekAtLastError();
    if (le != hipSuccess) fprintf(stderr, "kernel_launch: launch failed: %s\n", hipGetErrorName(le));
}
```

```cpp
#include <hip/hip_runtime.h>
#include <cstdio>
#include <cstdint>

namespace pg8 {
#define PG8_LAS __attribute__((address_space(3)))
typedef unsigned short bf16_t;
typedef short bf16x8 __attribute__((ext_vector_type(8)));
typedef float f32x4 __attribute__((ext_vector_type(4)));
typedef float f32x2 __attribute__((ext_vector_type(2)));
typedef unsigned u32x4 __attribute__((ext_vector_type(4)));
typedef unsigned u32x2 __attribute__((ext_vector_type(2)));
constexpr int BM = 256, BK = 64, HALF = 128, HTB = HALF * BK * 2  , STAGE_BYTES = 8 * HTB, NXCD = 8, WGM = 8;

__host__ __device__ __forceinline__ int lds_byte(int r, int c) { const int st = (r >> 4) * 2 + (c >> 5), rr = r & 15, cc = c & 31, ob = rr * 64 + cc * 2; return st * 1024 + (ob ^ (((ob >> 9) & 1) << 5)); }
__host__ __device__ __forceinline__ void stage_rc(int b, int& R, int& C) { const int st = b / 1024, sb = b % 1024, swz = sb ^ (((sb >> 9) & 1) << 5); R = (st >> 1) * 16 + swz / 64; C = (st & 1) * 32 + (swz % 64) / 2; }
__host__ __device__ __forceinline__ int perm32(int rho) { const int n = rho >> 4, i = rho & 15; return 8 * (i >> 2) + 4 * n + (i & 3); }

struct Unit { int pm, pn; };
struct Gemm { const bf16_t* A; const bf16_t* Bt; int lda, M, N, K; };

struct ASeg3 {
    const bf16_t* A0; const bf16_t* A1; const bf16_t* A2; int lda0, lda1, t1, t2;
    __device__ __forceinline__ const char* base(int pm, int tile) const {
        return tile < t1 ? (const char*)A0 + (size_t)pm * 512 * lda0 + (size_t)tile * 128
             : tile < t2 ? (const char*)A1 + (size_t)pm * 512 * lda0 + (size_t)(tile - t1) * 128
                         : (const char*)A2 + (size_t)pm * 512 * lda1 + (size_t)(tile - t2) * 128; }
    __device__ __forceinline__ size_t hstep(int tile) const { return (size_t)256 * (tile < t2 ? lda0 : lda1); }
    __device__ __forceinline__ bool sel(int tile) const { return tile >= t2; }
};
struct StaticOrder {
    int nM, nN, nwg, G, c, wgm;
    __host__ __device__ void init(int M, int N, int G_, int c_) { nM = M / BM; nN = N / BM; nwg = nM * nN; G = G_; c = c_; wgm = (nN == 8) ? 4 : WGM; }
    __host__ __device__ bool next(int i, Unit& u) const {
        const long L = (long)i * G + c; if (L >= nwg) return false;
        int wgid = (int)L; { const int q = nwg / NXCD, r = nwg % NXCD, xcd = wgid % NXCD, off = wgid / NXCD; wgid = (xcd < r ? xcd * (q + 1) : r * (q + 1) + (xcd - r) * q) + off; }
        const int nig = wgm * nN, gid = wgid / nig, fm = gid * wgm, gsz = (nM - fm) < wgm ? (nM - fm) : wgm;
        u.pm = fm + ((wgid % nig) % gsz); u.pn = (wgid % nig) / gsz; return true;
    }
    __device__ __forceinline__ void a_ready(const Unit&) const {}
    __device__ __forceinline__ void done(const Unit&) const {}
};

struct GateOrder {
    StaticOrder base;
    __device__ bool next(int i, Unit& u) const { Unit t; if (!base.next(i / 3, t)) return false; u.pm = t.pm; u.pn = t.pn + 8 * (i % 3); return true; }
    __device__ __forceinline__ void a_ready(const Unit&) const {}
    __device__ __forceinline__ void done(const Unit&) const {}
};
struct RevOrder {
    StaticOrder base; int nr;
    __device__ void init(int M, int N, int G_, int c_) { base.init(M, N, G_, c_); nr = (base.nwg + G_ - 1) / G_; if ((nr - 1) * G_ + c_ >= base.nwg) --nr; }
    __device__ bool next(int i, Unit& u) const { if (i >= nr) return false; return base.next(nr - 1 - i, u); }
    __device__ __forceinline__ void a_ready(const Unit&) const {}
    __device__ __forceinline__ void done(const Unit&) const {}
};
struct ProbeOrder : StaticOrder {
    PG8_LAS unsigned long long* st;
    __device__ __forceinline__ void done(const Unit&) const { if (threadIdx.x == 0) { const unsigned long long k = st[0]; if (k < 30) st[1 + k] = __builtin_amdgcn_s_memrealtime(); st[0] = k + 1; } }
};
__device__ __forceinline__ unsigned cvt_pk_bf16(float lo, float hi) { unsigned r; asm volatile("v_cvt_pk_bf16_f32 %0, %1, %2" : "=v"(r) : "v"(lo), "v"(hi)); return r; }
__device__ __forceinline__ f32x2 gelu_pk(f32x2 v) {
    const f32x2 av = __builtin_elementwise_abs(v), d = av * 0.2316418882f + 1.0f;
    f32x2 t; t.x = __builtin_amdgcn_rcpf(d.x); t.y = __builtin_amdgcn_rcpf(d.y);
    f32x2 q = t * 0.5307027145f + (-0.7265760135f); q = q * t + 0.7107068705f; q = q * t + (-0.142248368f); q = q * t + 0.127414796f; q = q * t;
    const f32x2 s = (v * v) * (-0.72134752044f);
    f32x2 e; e.x = __builtin_amdgcn_exp2f(s.x); e.y = __builtin_amdgcn_exp2f(s.y);
    const f32x2 m = v * (q * e), r = v - m;
    f32x2 o; o.x = v.x < 0.f ? m.x : r.x; o.y = v.y < 0.f ? m.y : r.y; return o;
}
template <class Epi, class Sched, bool ALIGN_EPI = false, bool SP2 = false>
__device__ __forceinline__ void gemm_phase(PG8_LAS unsigned char* lds, const Gemm g, const Sched& S, const Epi& E) {
    int tid_ = threadIdx.x; asm volatile("" : "+v"(tid_));
    const int tid = tid_, wid = __builtin_amdgcn_readfirstlane(tid >> 6), lane = tid & 63, wr = wid >> 2, wc = wid & 3, fr = lane & 15, fq = lane >> 4;
    const int K = g.K, nt = K / BK;
    unsigned voffA[2], voffB[2];
#pragma unroll
    for (int i = 0; i < 2; ++i) { int R, C; stage_rc(tid * 16 + i * 8192, R, C); const int Rb = Epi::PERM ? ((R & ~31) + perm32(R & 31)) : R;
        voffA[i] = (unsigned)(R * g.lda + C) * 2u; voffB[i] = (unsigned)(Rb * K + C) * 2u; }
    const size_t kstep = (size_t)(BK * 2);
    const size_t hstepB = (size_t)HALF * K * 2, hstepA = (size_t)HALF * g.lda * 2;
    const size_t tstepA = 2 * hstepA, tstepB = 2 * hstepB;
    const unsigned ldsw = (unsigned)wid * 1024u;
    const int aoff = lds_byte(wr * 64 + fr, fq * 8), boff = lds_byte(wc * 32 + fr, fq * 8);
#define PG8_SA(b, h) (((b) * 2 + (h)) * HTB)
#define PG8_SB(b, h) ((4 + (b) * 2 + (h)) * HTB)
#define PG8_STAGE(bufoff, gbase, voff) do { _Pragma("unroll") for (int _i = 0; _i < 2; ++_i) \
        __builtin_amdgcn_global_load_lds((const unsigned*)((const char*)(gbase) + (voff)[_i]), (PG8_LAS unsigned*)(lds + (bufoff) + ldsw + _i * 8192), 16, 0, 0); } while (0)
#define PG8_LDA(dst, b, h) do { _Pragma("unroll") for (int m = 0; m < 4; ++m) _Pragma("unroll") for (int k = 0; k < 2; ++k) dst[m][k] = *(const PG8_LAS bf16x8*)(lds + PG8_SA(b, h) + aoff + m * 2048 + k * 1024); } while (0)
#define PG8_LDB(dst, b, h) do { _Pragma("unroll") for (int n = 0; n < 2; ++n) _Pragma("unroll") for (int k = 0; k < 2; ++k) dst[n][k] = *(const PG8_LAS bf16x8*)(lds + PG8_SB(b, h) + boff + n * 2048 + k * 1024); } while (0)
#define PG8_MMA(ai, bj, At, Bt) do { __builtin_amdgcn_s_setprio(1); _Pragma("unroll") for (int m = 0; m < 4; ++m) _Pragma("unroll") for (int n = 0; n < 2; ++n) _Pragma("unroll") for (int k = 0; k < 2; ++k) \
        acc[ai][bj][m][n] = __builtin_amdgcn_mfma_f32_16x16x32_bf16(Bt[n][k], At[m][k], acc[ai][bj][m][n], 0, 0, 0); __builtin_amdgcn_s_setprio(0); } while (0)
#define PG8_WAIT_V(n) asm volatile("s_waitcnt vmcnt(" #n ")" ::: "memory")
#define PG8_WAIT_L(n) asm volatile("s_waitcnt lgkmcnt(" #n ")" ::: "memory")
#define PG8_BAR __builtin_amdgcn_s_barrier()
#define PG8_SCHED __builtin_amdgcn_sched_barrier(0)
    Unit cur, nxt; int ui = 0;
    if (!S.next(0, cur)) return;
    f32x4 acc[2][2][4][2];
#pragma unroll
    for (int a = 0; a < 2; ++a)
#pragma unroll
        for (int b = 0; b < 2; ++b)
#pragma unroll
            for (int m = 0; m < 4; ++m)
#pragma unroll
                for (int n = 0; n < 2; ++n) acc[a][b][m][n] = (f32x4){0.f, 0.f, 0.f, 0.f};
    bf16x8 At[4][2], B0[2][2], B1[2][2];
    const char* cA = (const char*)g.A + (size_t)cur.pm * tstepA; const char* cB = (const char*)g.Bt + (size_t)cur.pn * tstepB;
    S.a_ready(cur);
    if constexpr (SP2) {
        PG8_STAGE(PG8_SB(0, 0), cB, voffB); PG8_STAGE(PG8_SB(0, 1), cB + hstepB, voffB); PG8_STAGE(PG8_SA(0, 0), cA, voffA); PG8_STAGE(PG8_SA(0, 1), cA + hstepA, voffA);
        if (wr == 1) PG8_BAR;
        PG8_WAIT_V(2); PG8_BAR;
        PG8_STAGE(PG8_SB(1, 0), cB + kstep, voffB); PG8_STAGE(PG8_SA(1, 0), cA + kstep, voffA); PG8_STAGE(PG8_SB(1, 1), cB + hstepB + kstep, voffB);
        PG8_WAIT_V(6); PG8_BAR;
    } else {
        PG8_STAGE(PG8_SB(0, 0), cB, voffB); PG8_STAGE(PG8_SA(0, 0), cA, voffA); PG8_STAGE(PG8_SB(0, 1), cB + hstepB, voffB); PG8_STAGE(PG8_SA(0, 1), cA + hstepA, voffA);
        if (wr == 1) PG8_BAR;
        PG8_WAIT_V(4); PG8_BAR;
        PG8_STAGE(PG8_SB(1, 0), cB + kstep, voffB); PG8_STAGE(PG8_SA(1, 0), cA + kstep, voffA); PG8_STAGE(PG8_SB(1, 1), cB + hstepB + kstep, voffB);
        PG8_WAIT_V(6); PG8_BAR;
    }
    for (;;) {
        const bool has_next = S.next(ui + 1, nxt);
        const char* nA = has_next ? (const char*)g.A + (size_t)nxt.pm * tstepA : cA; const char* nB = has_next ? (const char*)g.Bt + (size_t)nxt.pn * tstepB : cB;
        for (int t = 0; t < nt; t += 2) {
            const bool last = (t == nt - 2);
            const char* a1 = cA + (size_t)(t + 1) * kstep;
            const char* a2 = last ? nA : cA + (size_t)(t + 2) * kstep; const char* b2 = last ? nB : cB + (size_t)(t + 2) * kstep;
            const char* a3 = a2 + kstep; const char* b3 = b2 + kstep;
            if (last && has_next) S.a_ready(nxt);
            if constexpr (SP2) {
            PG8_LDB(B0, 0, 0); PG8_LDB(B1, 0, 1); PG8_SCHED; PG8_LDA(At, 0, 0); PG8_STAGE(PG8_SA(1, 1), a1 + hstepA, voffA);
            PG8_WAIT_V(8); PG8_WAIT_L(0); PG8_BAR; PG8_MMA(0, 0, At, B0); PG8_MMA(0, 1, At, B1); PG8_BAR; PG8_SCHED;
            PG8_LDA(At, 0, 1); PG8_STAGE(PG8_SB(0, 0), b2, voffB); PG8_STAGE(PG8_SB(0, 1), b2 + hstepB, voffB); PG8_STAGE(PG8_SA(0, 0), a2, voffA);
            PG8_WAIT_V(8); PG8_WAIT_L(0); PG8_BAR; PG8_MMA(1, 0, At, B0); PG8_MMA(1, 1, At, B1); PG8_BAR; PG8_SCHED;
            PG8_LDB(B0, 1, 0); PG8_LDB(B1, 1, 1); PG8_SCHED; PG8_LDA(At, 1, 0); PG8_STAGE(PG8_SA(0, 1), a2 + hstepA, voffA);
            PG8_WAIT_V(8); PG8_WAIT_L(0); PG8_BAR; PG8_MMA(0, 0, At, B0); PG8_MMA(0, 1, At, B1); PG8_BAR; PG8_SCHED;
            PG8_LDA(At, 1, 1); PG8_STAGE(PG8_SB(1, 0), b3, voffB); PG8_STAGE(PG8_SB(1, 1), b3 + hstepB, voffB); PG8_STAGE(PG8_SA(1, 0), a3, voffA);
            PG8_WAIT_V(8); PG8_WAIT_L(0); PG8_BAR; PG8_MMA(1, 0, At, B0); PG8_MMA(1, 1, At, B1); PG8_BAR; PG8_SCHED;
            } else {
            PG8_LDB(B0, 0, 0); PG8_SCHED; PG8_LDA(At, 0, 0); PG8_STAGE(PG8_SA(1, 1), a1 + hstepA, voffA);
            PG8_WAIT_L(8); PG8_BAR; PG8_WAIT_L(0); PG8_MMA(0, 0, At, B0); PG8_BAR; PG8_SCHED;
            PG8_LDB(B1, 0, 1); PG8_STAGE(PG8_SB(0, 0), b2, voffB);
            PG8_BAR; PG8_WAIT_L(0); PG8_MMA(0, 1, At, B1); PG8_BAR;
            PG8_LDA(At, 0, 1); PG8_STAGE(PG8_SA(0, 0), a2, voffA);
            PG8_BAR; PG8_WAIT_L(0); PG8_MMA(1, 0, At, B0); PG8_BAR; PG8_SCHED;
            PG8_STAGE(PG8_SB(0, 1), b2 + hstepB, voffB);
            PG8_WAIT_V(6); PG8_BAR; PG8_MMA(1, 1, At, B1); PG8_BAR;
            PG8_LDB(B0, 1, 0); PG8_SCHED; PG8_LDA(At, 1, 0); PG8_STAGE(PG8_SA(0, 1), a2 + hstepA, voffA);
            PG8_WAIT_L(8); PG8_BAR; PG8_WAIT_L(0); PG8_MMA(0, 0, At, B0); PG8_BAR; PG8_SCHED;
            PG8_LDB(B1, 1, 1); PG8_STAGE(PG8_SB(1, 0), b3, voffB);
            PG8_BAR; PG8_WAIT_L(0); PG8_MMA(0, 1, At, B1); PG8_BAR;
            PG8_LDA(At, 1, 1); PG8_STAGE(PG8_SA(1, 0), a3, voffA);
            PG8_BAR; PG8_WAIT_L(0); PG8_MMA(1, 0, At, B0); PG8_BAR; PG8_SCHED;
            PG8_STAGE(PG8_SB(1, 1), b3 + hstepB, voffB);
            PG8_WAIT_V(6); PG8_BAR; PG8_MMA(1, 1, At, B1); PG8_BAR;
            }
        }
        if constexpr (ALIGN_EPI) { if (wr == 0) PG8_BAR; }
        if constexpr (!Epi::AFTER_DRAIN) { E(acc, cur, wr, wc, fr, fq); S.done(cur); }
        if (!has_next) break;
#pragma unroll
        for (int a = 0; a < 2; ++a)
#pragma unroll
            for (int b = 0; b < 2; ++b)
#pragma unroll
                for (int m = 0; m < 4; ++m)
#pragma unroll
                    for (int n = 0; n < 2; ++n) acc[a][b][m][n] = (f32x4){0.f, 0.f, 0.f, 0.f};
        cur = nxt; cA = nA; cB = nB; ++ui;
        if constexpr (ALIGN_EPI) { if (wr == 1) PG8_BAR; }
    }
    PG8_WAIT_V(0);
    if constexpr (!ALIGN_EPI) { if (wr == 0) PG8_BAR; }
    PG8_BAR;
    if constexpr (Epi::AFTER_DRAIN) { E.fused(acc, cur, wr, wc, fr, fq, lds, wid, lane); S.done(cur); }
#undef PG8_SA
#undef PG8_SB
#undef PG8_STAGE
#undef PG8_LDA
#undef PG8_LDB
#undef PG8_MMA
#undef PG8_WAIT_V
#undef PG8_WAIT_L
#undef PG8_BAR
#undef PG8_SCHED
}
template <class Epi, class Sched, bool ALIGN_EPI, class ASrc>
__device__ __forceinline__ void gemm_phase_seg(PG8_LAS unsigned char* lds, const Gemm g, const ASrc AS, const Sched& S, const Epi& E) {
    constexpr bool SP2 = true;
    int tid_ = threadIdx.x; asm volatile("" : "+v"(tid_));
    const int tid = tid_, wid = __builtin_amdgcn_readfirstlane(tid >> 6), lane = tid & 63, wr = wid >> 2, wc = wid & 3, fr = lane & 15, fq = lane >> 4;
    const int K = g.K, nt = K / BK;
    unsigned voffA[2], voffA2[2], voffB[2];
#pragma unroll
    for (int i = 0; i < 2; ++i) { int R, C; stage_rc(tid * 16 + i * 8192, R, C); const int Rb = Epi::PERM ? ((R & ~31) + perm32(R & 31)) : R;
        voffA[i] = (unsigned)(R * AS.lda0 + C) * 2u; voffA2[i] = (unsigned)(R * AS.lda1 + C) * 2u; voffB[i] = (unsigned)(Rb * K + C) * 2u; }
    const size_t kstep = (size_t)(BK * 2);
    const size_t hstepB = (size_t)HALF * K * 2, tstepB = 2 * hstepB;
    const unsigned ldsw = (unsigned)wid * 1024u;
    const int aoff = lds_byte(wr * 64 + fr, fq * 8), boff = lds_byte(wc * 32 + fr, fq * 8);
#define PG8_SA(b, h) (((b) * 2 + (h)) * HTB)
#define PG8_SB(b, h) ((4 + (b) * 2 + (h)) * HTB)
#define PG8_STAGE(bufoff, gbase, voff) do { _Pragma("unroll") for (int _i = 0; _i < 2; ++_i) \
        __builtin_amdgcn_global_load_lds((const unsigned*)((const char*)(gbase) + (voff)[_i]), (PG8_LAS unsigned*)(lds + (bufoff) + ldsw + _i * 8192), 16, 0, 0); } while (0)
#define PG8_LDA(dst, b, h) do { _Pragma("unroll") for (int m = 0; m < 4; ++m) _Pragma("unroll") for (int k = 0; k < 2; ++k) dst[m][k] = *(const PG8_LAS bf16x8*)(lds + PG8_SA(b, h) + aoff + m * 2048 + k * 1024); } while (0)
#define PG8_LDB(dst, b, h) do { _Pragma("unroll") for (int n = 0; n < 2; ++n) _Pragma("unroll") for (int k = 0; k < 2; ++k) dst[n][k] = *(const PG8_LAS bf16x8*)(lds + PG8_SB(b, h) + boff + n * 2048 + k * 1024); } while (0)
#define PG8_MMA(ai, bj, At, Bt) do { __builtin_amdgcn_s_setprio(1); _Pragma("unroll") for (int m = 0; m < 4; ++m) _Pragma("unroll") for (int n = 0; n < 2; ++n) _Pragma("unroll") for (int k = 0; k < 2; ++k) \
        acc[ai][bj][m][n] = __builtin_amdgcn_mfma_f32_16x16x32_bf16(Bt[n][k], At[m][k], acc[ai][bj][m][n], 0, 0, 0); __builtin_amdgcn_s_setprio(0); } while (0)
#define PG8_WAIT_V(n) asm volatile("s_waitcnt vmcnt(" #n ")" ::: "memory")
#define PG8_WAIT_L(n) asm volatile("s_waitcnt lgkmcnt(" #n ")" ::: "memory")
#define PG8_BAR __builtin_amdgcn_s_barrier()
#define PG8_SCHED __builtin_amdgcn_sched_barrier(0)
    Unit cur, nxt; int ui = 0;
    if (!S.next(0, cur)) return;
    f32x4 acc[2][2][4][2];
#pragma unroll
    for (int a = 0; a < 2; ++a)
#pragma unroll
        for (int b = 0; b < 2; ++b)
#pragma unroll
            for (int m = 0; m < 4; ++m)
#pragma unroll
                for (int n = 0; n < 2; ++n) acc[a][b][m][n] = (f32x4){0.f, 0.f, 0.f, 0.f};
    bf16x8 At[4][2], B0[2][2], B1[2][2];
    const char* cB = (const char*)g.Bt + (size_t)cur.pn * tstepB;
    S.a_ready(cur);
    if constexpr (SP2) {
        PG8_STAGE(PG8_SB(0, 0), cB, voffB); PG8_STAGE(PG8_SB(0, 1), cB + hstepB, voffB); PG8_STAGE(PG8_SA(0, 0), AS.base(cur.pm, 0), voffA); PG8_STAGE(PG8_SA(0, 1), AS.base(cur.pm, 0) + AS.hstep(0), voffA);
        if (wr == 1) PG8_BAR;
        PG8_WAIT_V(2); PG8_BAR;
        PG8_STAGE(PG8_SB(1, 0), cB + kstep, voffB); PG8_STAGE(PG8_SA(1, 0), AS.base(cur.pm, 1), voffA); PG8_STAGE(PG8_SB(1, 1), cB + hstepB + kstep, voffB);
        PG8_WAIT_V(6); PG8_BAR;
    }
    for (;;) {
        const bool has_next = S.next(ui + 1, nxt);
        const int npm = has_next ? nxt.pm : cur.pm; const char* nB = has_next ? (const char*)g.Bt + (size_t)nxt.pn * tstepB : cB;
        for (int t = 0; t < nt; t += 2) {
            const bool last = (t == nt - 2);
            if (t == AS.t1) E.mid(acc, cur, 0, wr, wc, fr, fq);
            if (t == AS.t2) E.mid(acc, cur, 1, wr, wc, fr, fq);
            const char* a1 = AS.base(cur.pm, t + 1); const size_t h1 = AS.hstep(t + 1); const bool s1 = AS.sel(t + 1);
            const char* a2 = last ? AS.base(npm, 0) : AS.base(cur.pm, t + 2); const char* b2 = last ? nB : cB + (size_t)(t + 2) * kstep;
            const char* a3 = last ? AS.base(npm, 1) : AS.base(cur.pm, t + 3); const char* b3 = b2 + kstep;
            const size_t h2 = last ? AS.hstep(0) : AS.hstep(t + 2); const bool s2 = last ? false : AS.sel(t + 2);
            const unsigned v1a[2] = {s1 ? voffA2[0] : voffA[0], s1 ? voffA2[1] : voffA[1]}, v2a[2] = {s2 ? voffA2[0] : voffA[0], s2 ? voffA2[1] : voffA[1]};
            if (last && has_next) S.a_ready(nxt);
            if constexpr (SP2) {
            PG8_LDB(B0, 0, 0); PG8_LDB(B1, 0, 1); PG8_SCHED; PG8_LDA(At, 0, 0); PG8_STAGE(PG8_SA(1, 1), a1 + h1, v1a);
            PG8_WAIT_V(8); PG8_WAIT_L(0); PG8_BAR; PG8_MMA(0, 0, At, B0); PG8_MMA(0, 1, At, B1); PG8_BAR; PG8_SCHED;
            PG8_LDA(At, 0, 1); PG8_STAGE(PG8_SB(0, 0), b2, voffB); PG8_STAGE(PG8_SB(0, 1), b2 + hstepB, voffB); PG8_STAGE(PG8_SA(0, 0), a2, v2a);
            PG8_WAIT_V(8); PG8_WAIT_L(0); PG8_BAR; PG8_MMA(1, 0, At, B0); PG8_MMA(1, 1, At, B1); PG8_BAR; PG8_SCHED;
            PG8_LDB(B0, 1, 0); PG8_LDB(B1, 1, 1); PG8_SCHED; PG8_LDA(At, 1, 0); PG8_STAGE(PG8_SA(0, 1), a2 + h2, v2a);
            PG8_WAIT_V(8); PG8_WAIT_L(0); PG8_BAR; PG8_MMA(0, 0, At, B0); PG8_MMA(0, 1, At, B1); PG8_BAR; PG8_SCHED;
            PG8_LDA(At, 1, 1); PG8_STAGE(PG8_SB(1, 0), b3, voffB); PG8_STAGE(PG8_SB(1, 1), b3 + hstepB, voffB); PG8_STAGE(PG8_SA(1, 0), a3, v2a);
            PG8_WAIT_V(8); PG8_WAIT_L(0); PG8_BAR; PG8_MMA(1, 0, At, B0); PG8_MMA(1, 1, At, B1); PG8_BAR; PG8_SCHED;
            }
        }
        if constexpr (ALIGN_EPI) { if (wr == 0) PG8_BAR; }
        if constexpr (!Epi::AFTER_DRAIN) { E(acc, cur, wr, wc, fr, fq); S.done(cur); }
        if (!has_next) break;
#pragma unroll
        for (int a = 0; a < 2; ++a)
#pragma unroll
            for (int b = 0; b < 2; ++b)
#pragma unroll
                for (int m = 0; m < 4; ++m)
#pragma unroll
                    for (int n = 0; n < 2; ++n) acc[a][b][m][n] = (f32x4){0.f, 0.f, 0.f, 0.f};
        cur = nxt; cB = nB; ++ui;
        if constexpr (ALIGN_EPI) { if (wr == 1) PG8_BAR; }
    }
    PG8_WAIT_V(0);
    if constexpr (!ALIGN_EPI) { if (wr == 0) PG8_BAR; }
    PG8_BAR;
    if constexpr (Epi::AFTER_DRAIN) { E.fused(acc, cur, wr, wc, fr, fq, lds, wid, lane); S.done(cur); }
#undef PG8_SA
#undef PG8_SB
#undef PG8_STAGE
#undef PG8_LDA
#undef PG8_LDB
#undef PG8_MMA
#undef PG8_WAIT_V
#undef PG8_WAIT_L
#undef PG8_BAR
#undef PG8_SCHED
}
}

constexpr int NWAVES = 8, NTHR = NWAVES * 64;
constexpr int D = 2048, BATCH = 16, SEQ = 2048, M = BATCH * SEQ, FF = 5632, MEM = 256, DEPTH = 2;
constexpr int N_IN_SRC = 12864, NWIN = 6912  , NWIN_SRC = 6720, NGATE = 6144;
constexpr int QKVW = 4608, ZW = 1024, QW = 1536, KVW = 2048;
#ifndef H_NT
#define H_NT 0
#endif
#ifndef FF_PAD
#define FF_PAD 0
#endif
constexpr int FF_LD = FF + FF_PAD;
constexpr float LN_EPS = 1e-5f, RMS_EPS = 1e-6f, ALPHA = 1.41421356237309515f, LOG2E = 1.4426950408889634f, LN2 = 0.6931471805599453f;
constexpr float NEGBIG = -1e30f;

constexpr size_t MiB = 1u << 20;
constexpr size_t WS_CTL = 0, CTL_ZERO_BYTES = 4 * MiB;
constexpr size_t CTL_SSQ = 256 * 1024;
constexpr size_t CTL_STATS = 1 * MiB;
constexpr size_t CTL_SNT = 3 * MiB;
constexpr int SNT_FFN0 = 0, SNT_FFN1 = 11264, SNT_WIN = 22528, SNT_GATE = 29440, SNT_XQ = 35584, SNT_N = 36096;
constexpr size_t WS_TAB = 4 * MiB;
constexpr size_t TAB_COS = WS_TAB, TAB_SIN = WS_TAB + 256 * 1024, TAB_BIAS = WS_TAB + 512 * 1024, TAB_SGUW = WS_TAB + 640 * 1024;
constexpr int BIAS_STRIDE = 132;
constexpr size_t WS_W = 5 * MiB;
constexpr size_t W_GU0 = WS_W, W_D0 = W_GU0 + 44 * MiB, W_GU1 = W_D0 + 22 * MiB, W_D1 = W_GU1 + 44 * MiB, W_IN = W_D1 + 22 * MiB, W_GATE = W_IN + 27 * MiB,
                 W_UQ = W_GATE + 24 * MiB, W_UKV = W_UQ + 2 * MiB, W_PA = W_UKV + 2 * MiB, W_PB = W_PA + 4 * MiB, W_PC = W_PB + 2 * MiB, W_OUT = W_PC + 2 * MiB,
                 W_XQ = W_OUT + 8 * MiB, W_XKV = W_XQ + 2 * MiB, W_XO = W_XKV + 4 * MiB, W_END = W_XO + 2 * MiB;
static_assert(W_END <= 218 * MiB, "weights");
constexpr size_t WS_XB = 218 * MiB;
constexpr size_t WS_MEMB = 346 * MiB;
constexpr size_t WS_KVX = 362 * MiB;
constexpr size_t WS_LSE = 370 * MiB;
constexpr size_t WS_R = 372 * MiB;
constexpr size_t R_H = WS_R;
constexpr size_t R_KPE = WS_R, R_CQ = WS_R + 4 * MiB, R_CKV = WS_R + 36 * MiB, R_OA = R_CQ  , R_Z = WS_R + 68 * MiB, R_QKV = WS_R + 132 * MiB,
                 R_QM = WS_R + 420 * MiB, R_KVM = WS_R + 516 * MiB, R_OC = WS_R + 644 * MiB, R_END = WS_R + 676 * MiB;
constexpr size_t R_GATE = R_QKV, R_MERGED = R_KVM;
constexpr size_t R_QX = R_QM, R_OX = R_QM + 32 * MiB;
constexpr size_t GATE_PLANE = (size_t)M * D;
constexpr size_t R_GATE2 = R_END, WS_NEED = R_END + GATE_PLANE;
static_assert((size_t)M * FF_LD * 2 <= 420 * MiB && R_GATE + (size_t)M * NGATE * 2 == R_KVM && R_QM + 96 * MiB == R_KVM && R_MERGED + 128 * MiB <= R_OC, "overlays");

constexpr int CW_PCNT = 16384;
constexpr int CW_BAR = 4096;

constexpr int LDS_BYTES = 147456;
constexpr int LDSCTL_OFF = 143360, MISC_OFF = LDSCTL_OFF;

#define GAS __attribute__((address_space(1)))
#define LAS __attribute__((address_space(3)))
typedef unsigned short bf16;
typedef pg8::f32x4 f32x4;
typedef pg8::f32x2 f32x2;
typedef pg8::u32x4 u32x4;
typedef pg8::u32x2 u32x2;
typedef pg8::bf16x8 bf16x8;
typedef short s16x4 __attribute__((ext_vector_type(4)));
typedef GAS unsigned gu32;
#define LDS_WAIT() asm volatile("s_waitcnt lgkmcnt(0)" ::: "memory")
#define VM_WAIT() asm volatile("s_waitcnt vmcnt(0)" ::: "memory")
__device__ __forceinline__ float bf2f(unsigned short b) { return __uint_as_float(((unsigned)b) << 16); }
__device__ __forceinline__ float bflo(unsigned w) { return __uint_as_float(w << 16); }
__device__ __forceinline__ float bfhi(unsigned w) { return __uint_as_float(w & 0xffff0000u); }
typedef float f32x2v_t __attribute__((ext_vector_type(2)));
typedef __bf16 bf16x2v_t __attribute__((ext_vector_type(2)));
__device__ __forceinline__ unsigned pk2(float lo, float hi) { const f32x2v_t v = {lo, hi}; const bf16x2v_t b = __builtin_convertvector(v, bf16x2v_t); return __builtin_bit_cast(unsigned, b); }
__device__ __forceinline__ float fsigmoid(float x) { return __builtin_amdgcn_rcpf(1.0f + __builtin_amdgcn_exp2f(-LOG2E * x)); }
__device__ __forceinline__ int lane_id_local() { int z = 0; asm volatile("" : "+v"(z)); return __builtin_amdgcn_mbcnt_hi(-1, __builtin_amdgcn_mbcnt_lo(-1, z)); }
__device__ __forceinline__ float shx(float v, int m) { return __builtin_bit_cast(float, __builtin_amdgcn_ds_bpermute((lane_id_local() ^ m) << 2, __builtin_bit_cast(int, v))); }
__device__ __forceinline__ float shx_l(float v, int m, int lane) { return __builtin_bit_cast(float, __builtin_amdgcn_ds_bpermute((lane ^ m) << 2, __builtin_bit_cast(int, v))); }
__device__ __forceinline__ float xmax_16_32(float v) {
    const auto r = __builtin_amdgcn_permlane16_swap(__float_as_uint(v), __float_as_uint(v), false, false); const unsigned r0 = r[0], r1 = r[1];
    v = fmaxf(__uint_as_float(r0), __uint_as_float(r1));
    const auto q = __builtin_amdgcn_permlane32_swap(__float_as_uint(v), __float_as_uint(v), false, false); const unsigned q0 = q[0], q1 = q[1];
    return fmaxf(__uint_as_float(q0), __uint_as_float(q1));
}
__device__ __forceinline__ float xsum_16_32(float v) {
    const auto r = __builtin_amdgcn_permlane16_swap(__float_as_uint(v), __float_as_uint(v), false, false); const unsigned r0 = r[0], r1 = r[1];
    v = __uint_as_float(r0) + __uint_as_float(r1);
    const auto q = __builtin_amdgcn_permlane32_swap(__float_as_uint(v), __float_as_uint(v), false, false); const unsigned q0 = q[0], q1 = q[1];
    return __uint_as_float(q0) + __uint_as_float(q1);
}
__device__ __forceinline__ float wave_sum(float v) {
#pragma unroll
    for (int o = 1; o < 64; o <<= 1) v += shx(v, o);
    return v;
}
__device__ __forceinline__ float wave_max(float v) {
#pragma unroll
    for (int o = 1; o < 64; o <<= 1) v = fmaxf(v, shx(v, o));
    return v;
}

#define XB_TMO      128
#define XB_XCNT(j)  (256  + 64 * (j))
#define XB_XSUB(j)  (1280 + 64 * (j))
#define XB_XGEN(j)  (2304 + 64 * (j))
#define XB_TOP      3328
#define XB_TOPGEN   3392
#define XCD_BAR_WORDS 3456
#define XB_SPIN_CAP (1u << 20)

__device__ __forceinline__ unsigned xb_ld(unsigned* p)              { return __hip_atomic_load(p, __ATOMIC_RELAXED, __HIP_MEMORY_SCOPE_AGENT); }
__device__ __forceinline__ unsigned xb_add(unsigned* p, unsigned v) { return __hip_atomic_fetch_add(p, v, __ATOMIC_RELAXED, __HIP_MEMORY_SCOPE_AGENT); }
__device__ __forceinline__ unsigned xb_xcc_id() { return (unsigned)__builtin_amdgcn_s_getreg((3 << 11) | 20) & 0xFu; }
#define XB_SPIN(cond, bar) do { unsigned _sp = 0; while (cond) { __builtin_amdgcn_s_sleep(1); \
    if ((++_sp & 255u) == 0u) { if (xb_ld(&(bar)[XB_TMO])) break; if (_sp > XB_SPIN_CAP) { atomicAdd(&(bar)[XB_TMO], 1u); break; } } } } while (0)

struct XcdBarrier { unsigned* bar; unsigned x; volatile LAS unsigned* st; };

__device__ __forceinline__ XcdBarrier xcd_barrier_post(unsigned* bar, volatile LAS unsigned* st) {
    XcdBarrier b; b.bar = bar; b.x = xb_xcc_id(); b.st = st;
    if (threadIdx.x == 0) (void)xb_add(&bar[XB_XCNT(b.x)], 1u);
    return b;
}
__device__ __forceinline__ void xcd_barrier_complete(unsigned* bar, unsigned x, unsigned& nloc, unsigned& nx) {
    const unsigned G = gridDim.x * gridDim.y * gridDim.z;
    unsigned sum, cnt, mine, sp = 0u;
    for (;;) {
        sum = 0u; cnt = 0u; mine = 0u;
#pragma unroll
        for (unsigned j = 0; j < 16; ++j) { const unsigned c = xb_ld(&bar[XB_XCNT(j)]); sum += c; cnt += (c > 0u) ? 1u : 0u; mine = (j == x) ? c : mine; }
        if (sum == G) break;
        __builtin_amdgcn_s_sleep(1);
        if ((++sp & 255u) == 0u) { if (xb_ld(&bar[XB_TMO])) break; if (sp > XB_SPIN_CAP) { atomicAdd(&bar[XB_TMO], 1u); break; } }
    }
    nloc = mine > 0u ? mine : 1u; nx = cnt > 0u ? cnt : 1u;
}
__device__ __forceinline__ void xcd_barrier(const XcdBarrier& b) {
    asm volatile("s_waitcnt vmcnt(0)" ::: "memory");
    __syncthreads();
    if (threadIdx.x == 0) {
        unsigned* bar = b.bar; { size_t z_ = 0; asm volatile("" : "+s"(z_)); bar += z_; }
        __builtin_amdgcn_s_waitcnt(0);
        unsigned nloc = b.st[0], nx = b.st[1];
        if (nloc == 0u) { xcd_barrier_complete(bar, b.x, nloc, nx); b.st[0] = nloc; b.st[1] = nx; }
        const unsigned old = xb_add(&bar[XB_XSUB(b.x)], 1u);
        const unsigned gen = old / nloc;
        if (old + 1u == (gen + 1u) * nloc) {
            __builtin_amdgcn_fence(__ATOMIC_RELEASE, "agent");
            asm volatile("s_waitcnt vmcnt(0)" ::: "memory");
            const unsigned og = xb_add(&bar[XB_TOP], 1u);
            const unsigned tg = og / nx;
            if (og + 1u == (tg + 1u) * nx) xb_add(&bar[XB_TOPGEN], 1u);
            else XB_SPIN(xb_ld(&bar[XB_TOPGEN]) == tg, bar);
            __builtin_amdgcn_fence(__ATOMIC_ACQUIRE, "agent");
            xb_add(&bar[XB_XGEN(b.x)], 1u);
            asm volatile("s_waitcnt vmcnt(0)" ::: "memory");
        } else {
            XB_SPIN(xb_ld(&bar[XB_XGEN(b.x)]) == gen, bar);
            __builtin_amdgcn_fence(__ATOMIC_ACQUIRE, "agent");
            asm volatile("s_waitcnt vmcnt(0)" ::: "memory");
        }
    }
    __syncthreads();
}

__device__ __forceinline__ u32x4 ld16_sc1_nowait(const void* p) { u32x4 v; asm volatile("global_load_dwordx4 %0, %1, off sc0 sc1" : "=v"(v) : "v"(p) : "memory"); return v; }
__device__ __forceinline__ u32x4 ld16_sc1(const void* p) { u32x4 v; asm volatile("global_load_dwordx4 %0, %1, off sc0 sc1\n\ts_waitcnt vmcnt(0)" : "=v"(v) : "v"(p) : "memory"); return v; }
using pg8::Unit;
struct LnFold {
    const float* stats; const float* sn; const float* tn;
    __device__ __forceinline__ void row(int r, float& mu, float& rs) const {
        if (!stats) { mu = 0.f; rs = 1.f; return; }
        const f32x2 st = *(const f32x2*)(stats + 2 * (size_t)r); const float m_ = st.x * (1.0f / D); rs = __builtin_amdgcn_rsqf(st.y * (1.0f / D) - m_ * m_ + LN_EPS); mu = -m_ * rs;
    }
    __device__ __forceinline__ void cols(int c, float (&s)[8], float (&t)[8]) const {
        if (!stats) {
#pragma unroll
            for (int j = 0; j < 8; ++j) { s[j] = 0.f; t[j] = 0.f; }
            return; }
        const f32x4 s0 = *(const f32x4*)(sn + c), s1 = *(const f32x4*)(sn + c + 4), t0 = *(const f32x4*)(tn + c), t1 = *(const f32x4*)(tn + c + 4);
        s[0] = s0.x; s[1] = s0.y; s[2] = s0.z; s[3] = s0.w; s[4] = s1.x; s[5] = s1.y; s[6] = s1.z; s[7] = s1.w;
        t[0] = t0.x; t[1] = t0.y; t[2] = t0.z; t[3] = t0.w; t[4] = t1.x; t[5] = t1.y; t[6] = t1.z; t[7] = t1.w;
    }
};
struct EpiSwiglu {
    static constexpr bool PERM = true, AFTER_DRAIN = false;
    bf16* H; LnFold ln;
    __device__ __forceinline__ void operator()(const f32x4 (&acc)[2][2][4][2], const Unit& u, int wr, int wc, int fr, int fq) const {
        const int row0 = u.pm * 256 + wr * 64 + fr, col0 = u.pn * 128 + wc * 32 + 8 * fq, wrow = u.pn * 256 + wc * 32 + 8 * fq;
        float sg[8], tg[8], su[8], tu[8];
        ln.cols(wrow, sg, tg); ln.cols(wrow + 128, su, tu);
#pragma unroll
        for (int ai = 0; ai < 2; ++ai)
#pragma unroll
            for (int m = 0; m < 4; ++m) {
                const int row = row0 + ai * 128 + m * 16;
                float mu, rs; ln.row(row, mu, rs);
                float h[8];
#pragma unroll
                for (int n = 0; n < 2; ++n)
#pragma unroll
                    for (int j = 0; j < 4; ++j) { const float g = __builtin_fmaf(rs, acc[ai][0][m][n][j], __builtin_fmaf(mu, sg[4 * n + j], tg[4 * n + j])), up = __builtin_fmaf(rs, acc[ai][1][m][n][j], __builtin_fmaf(mu, su[4 * n + j], tu[4 * n + j]));
                        h[4 * n + j] = g * fsigmoid(g) * up; }
                u32x4 w; w.x = pk2(h[0], h[1]); w.y = pk2(h[2], h[3]); w.z = pk2(h[4], h[5]); w.w = pk2(h[6], h[7]);
                if (H_NT) __builtin_nontemporal_store(w, (u32x4*)(H + (size_t)row * FF_LD + col0)); else *(u32x4*)(H + (size_t)row * FF_LD + col0) = w;
            }
    }
};
struct EpiResidLn {
    static constexpr bool PERM = true, AFTER_DRAIN = false;
    const float* xin;
    bf16* ZB; const bf16* zl_in; bf16* zl_out; const float* stats_prev; const float* g_prev; const float* b_prev; float* stats_out; float alpha, scale;
    __device__ __forceinline__ void operator()(const f32x4 (&acc)[2][2][4][2], const Unit& u, int wr, int wc, int fr, int fq) const {
        const int row0 = u.pm * 256 + wr * 64 + fr;
        float gg[2][8], bb[2][8];
#pragma unroll
        for (int bj = 0; bj < 2; ++bj) { const int col = u.pn * 256 + bj * 128 + wc * 32 + 8 * fq;
            if (xin) {
#pragma unroll
                for (int j = 0; j < 8; ++j) { gg[bj][j] = 1.f; bb[bj][j] = 0.f; }
            } else { const f32x4 g0 = *(const f32x4*)(g_prev + col), g1 = *(const f32x4*)(g_prev + col + 4), b0 = *(const f32x4*)(b_prev + col), b1 = *(const f32x4*)(b_prev + col + 4);
                gg[bj][0] = g0.x; gg[bj][1] = g0.y; gg[bj][2] = g0.z; gg[bj][3] = g0.w; gg[bj][4] = g1.x; gg[bj][5] = g1.y; gg[bj][6] = g1.z; gg[bj][7] = g1.w;
                bb[bj][0] = b0.x; bb[bj][1] = b0.y; bb[bj][2] = b0.z; bb[bj][3] = b0.w; bb[bj][4] = b1.x; bb[bj][5] = b1.y; bb[bj][6] = b1.z; bb[bj][7] = b1.w; } }
#pragma unroll
        for (int ap = 0; ap < 4; ++ap) {
            const int ai = ap >> 1;
            f32x4 pv[2][2][2]; f32x2 st[2];
#pragma unroll
            for (int mm = 0; mm < 2; ++mm) {
                const int m = 2 * (ap & 1) + mm, row = row0 + ai * 128 + m * 16;
                st[mm] = xin ? (f32x2){0.f, 0.f} : *(const f32x2*)(stats_prev + 2 * (size_t)row);
#pragma unroll
                for (int bj = 0; bj < 2; ++bj) { const size_t off = (size_t)row * D + u.pn * 256 + bj * 128 + wc * 32 + 8 * fq;
                    if (xin) { pv[mm][bj][0] = *(const f32x4*)(xin + off); pv[mm][bj][1] = *(const f32x4*)(xin + off + 4); }
                    else { const u32x4 h = *(const u32x4*)(ZB + off), l = *(const u32x4*)(zl_in + off);
                        pv[mm][bj][0] = (f32x4){bflo(h.x) + bflo(l.x), bfhi(h.x) + bfhi(l.x), bflo(h.y) + bflo(l.y), bfhi(h.y) + bfhi(l.y)};
                        pv[mm][bj][1] = (f32x4){bflo(h.z) + bflo(l.z), bfhi(h.z) + bfhi(l.z), bflo(h.w) + bflo(l.w), bfhi(h.w) + bfhi(l.w)}; } }
            }
#pragma unroll
            for (int mm = 0; mm < 2; ++mm) {
                const int m = 2 * (ap & 1) + mm, row = row0 + ai * 128 + m * 16;
                float mu = 0.f, rs = 1.f;
                if (!xin) { mu = st[mm].x * (1.0f / D); rs = __builtin_amdgcn_rsqf(st[mm].y * (1.0f / D) - mu * mu + LN_EPS); }
                float s1 = 0.f, s2 = 0.f;
#pragma unroll
                for (int bj = 0; bj < 2; ++bj) {
                    const size_t off = (size_t)row * D + u.pn * 256 + bj * 128 + wc * 32 + 8 * fq;
                    float z[8], zr[8];
#pragma unroll
                    for (int j = 0; j < 8; ++j) { const float xp = (pv[mm][bj][j >> 2][j & 3] - mu) * rs * gg[bj][j] + bb[bj][j]; z[j] = alpha * xp + scale * acc[ai][bj][m][j >> 2][j & 3]; s1 += z[j]; s2 += z[j] * z[j]; }
                    u32x4 o; o.x = pk2(z[0], z[1]); o.y = pk2(z[2], z[3]); o.z = pk2(z[4], z[5]); o.w = pk2(z[6], z[7]);
                    zr[0] = z[0] - bflo(o.x); zr[1] = z[1] - bfhi(o.x); zr[2] = z[2] - bflo(o.y); zr[3] = z[3] - bfhi(o.y); zr[4] = z[4] - bflo(o.z); zr[5] = z[5] - bfhi(o.z); zr[6] = z[6] - bflo(o.w); zr[7] = z[7] - bfhi(o.w);
                    u32x4 ol; ol.x = pk2(zr[0], zr[1]); ol.y = pk2(zr[2], zr[3]); ol.z = pk2(zr[4], zr[5]); ol.w = pk2(zr[6], zr[7]);
                    *(u32x4*)(ZB + off) = o; *(u32x4*)(zl_out + off) = ol;
                }
                s1 = xsum_16_32(s1); s2 = xsum_16_32(s2);
                if (fq < 2) unsafeAtomicAdd(stats_out + 2 * (size_t)row + fq, fq ? s2 : s1);
            }
            asm volatile("" ::: "memory");
        }
    }
};
struct EpiResidLnFinal {
    static constexpr bool PERM = true, AFTER_DRAIN = false;
    const bf16* ZB; const bf16* zl_in; const float* stats_prev; const float* g_prev; const float* b_prev; float* stats_out; unsigned* pcnt; const float* g_fin; const float* b_fin; float* out; float alpha, scale;
    __device__ __forceinline__ void operator()(const f32x4 (&acc_)[2][2][4][2], const Unit& u, int wr, int wc, int fr_, int fq_) const {
        f32x4 (&acc)[2][2][4][2] = const_cast<f32x4 (&)[2][2][4][2]>(acc_);
        int fr = fr_, fq = fq_; asm volatile("" : "+v"(fr), "+v"(fq));
        int row0 = u.pm * 256 + wr * 64 + fr;
        {
            float gg[2][8], bb[2][8];
#pragma unroll
            for (int bj = 0; bj < 2; ++bj) { const int col = u.pn * 256 + bj * 128 + wc * 32 + 8 * fq;
                const f32x4 g0 = *(const f32x4*)(g_prev + col), g1 = *(const f32x4*)(g_prev + col + 4), b0 = *(const f32x4*)(b_prev + col), b1 = *(const f32x4*)(b_prev + col + 4);
                gg[bj][0] = g0.x; gg[bj][1] = g0.y; gg[bj][2] = g0.z; gg[bj][3] = g0.w; gg[bj][4] = g1.x; gg[bj][5] = g1.y; gg[bj][6] = g1.z; gg[bj][7] = g1.w;
                bb[bj][0] = b0.x; bb[bj][1] = b0.y; bb[bj][2] = b0.z; bb[bj][3] = b0.w; bb[bj][4] = b1.x; bb[bj][5] = b1.y; bb[bj][6] = b1.z; bb[bj][7] = b1.w; }
#pragma unroll
            for (int ap = 0; ap < 4; ++ap) {
                const int ai = ap >> 1;
                f32x4 pv[2][2][2]; f32x2 st[2];
#pragma unroll
                for (int mm = 0; mm < 2; ++mm) {
                    const int m = 2 * (ap & 1) + mm, row = row0 + ai * 128 + m * 16;
                    st[mm] = *(const f32x2*)(stats_prev + 2 * (size_t)row);
#pragma unroll
                    for (int bj = 0; bj < 2; ++bj) { const size_t off = (size_t)row * D + u.pn * 256 + bj * 128 + wc * 32 + 8 * fq;
                        const u32x4 h = *(const u32x4*)(ZB + off), l = *(const u32x4*)(zl_in + off);
                        pv[mm][bj][0] = (f32x4){bflo(h.x) + bflo(l.x), bfhi(h.x) + bfhi(l.x), bflo(h.y) + bflo(l.y), bfhi(h.y) + bfhi(l.y)};
                        pv[mm][bj][1] = (f32x4){bflo(h.z) + bflo(l.z), bfhi(h.z) + bfhi(l.z), bflo(h.w) + bflo(l.w), bfhi(h.w) + bfhi(l.w)}; }
                }
#pragma unroll
                for (int mm = 0; mm < 2; ++mm) {
                    const int m = 2 * (ap & 1) + mm, row = row0 + ai * 128 + m * 16;
                    const float mu = st[mm].x * (1.0f / D), rs = __builtin_amdgcn_rsqf(st[mm].y * (1.0f / D) - mu * mu + LN_EPS);
                    float s1 = 0.f, s2 = 0.f;
#pragma unroll
                    for (int bj = 0; bj < 2; ++bj)
#pragma unroll
                        for (int j = 0; j < 8; ++j) { const float xp = (pv[mm][bj][j >> 2][j & 3] - mu) * rs * gg[bj][j] + bb[bj][j]; const float z = alpha * xp + scale * acc[ai][bj][m][j >> 2][j & 3];
                            acc[ai][bj][m][j >> 2][j & 3] = z; s1 += z; s2 += z * z; }
                    s1 = xsum_16_32(s1); s2 = xsum_16_32(s2);
                    if (fq < 2) unsafeAtomicAdd(stats_out + 2 * (size_t)row + fq, fq ? s2 : s1);
                }
                asm volatile("" ::: "memory");
            }
        }
        asm volatile("s_waitcnt vmcnt(0)" ::: "memory");
        __syncthreads();
        if (threadIdx.x == 0) {
            unsigned* pc = pcnt + 16 * u.pm;
            (void)xb_add(pc, 1u);
            unsigned sp = 0u;
            while (xb_ld(pc) < (unsigned)(D / 256) && ++sp < (1u << 22)) __builtin_amdgcn_s_sleep(1);
            __builtin_amdgcn_fence(__ATOMIC_ACQUIRE, "agent");
        }
        __syncthreads();
        asm volatile("" : "+v"(fr), "+v"(fq)); row0 = u.pm * 256 + wr * 64 + fr;
        {
            float gf[2][8], bf_[2][8];
#pragma unroll
            for (int bj = 0; bj < 2; ++bj) { const int col = u.pn * 256 + bj * 128 + wc * 32 + 8 * fq;
                const f32x4 g0 = *(const f32x4*)(g_fin + col), g1 = *(const f32x4*)(g_fin + col + 4), b0 = *(const f32x4*)(b_fin + col), b1 = *(const f32x4*)(b_fin + col + 4);
                gf[bj][0] = g0.x; gf[bj][1] = g0.y; gf[bj][2] = g0.z; gf[bj][3] = g0.w; gf[bj][4] = g1.x; gf[bj][5] = g1.y; gf[bj][6] = g1.z; gf[bj][7] = g1.w;
                bf_[bj][0] = b0.x; bf_[bj][1] = b0.y; bf_[bj][2] = b0.z; bf_[bj][3] = b0.w; bf_[bj][4] = b1.x; bf_[bj][5] = b1.y; bf_[bj][6] = b1.z; bf_[bj][7] = b1.w; }
            float mu8[2][4], rs8[2][4];
#pragma unroll
            for (int ai = 0; ai < 2; ++ai)
#pragma unroll
                for (int m = 0; m < 4; ++m) { float* sp_ = stats_out + 2 * (size_t)(row0 + ai * 128 + m * 16);
                    mu8[ai][m] = __hip_atomic_load(sp_, __ATOMIC_RELAXED, __HIP_MEMORY_SCOPE_AGENT); rs8[ai][m] = __hip_atomic_load(sp_ + 1, __ATOMIC_RELAXED, __HIP_MEMORY_SCOPE_AGENT); }
#pragma unroll
            for (int ai = 0; ai < 2; ++ai)
#pragma unroll
                for (int m = 0; m < 4; ++m) { const float mean = mu8[ai][m] * (1.0f / D); rs8[ai][m] = __builtin_amdgcn_rsqf(rs8[ai][m] * (1.0f / D) - mean * mean + LN_EPS); mu8[ai][m] = mean; }
#pragma unroll
            for (int ai = 0; ai < 2; ++ai)
#pragma unroll
                for (int m = 0; m < 4; ++m) {
                    const int row = row0 + ai * 128 + m * 16;
#pragma unroll
                    for (int bj = 0; bj < 2; ++bj) { float* op = out + (size_t)row * D + u.pn * 256 + bj * 128 + wc * 32 + 8 * fq;
                        f32x4 o0, o1;
#pragma unroll
                        for (int j = 0; j < 4; ++j) { o0[j] = (acc[ai][bj][m][0][j] - mu8[ai][m]) * rs8[ai][m] * gf[bj][j] + bf_[bj][j]; o1[j] = (acc[ai][bj][m][1][j] - mu8[ai][m]) * rs8[ai][m] * gf[bj][4 + j] + bf_[bj][4 + j]; }
                        *(f32x4*)op = o0; *(f32x4*)(op + 4) = o1; }
                }
        }
    }
};
template <int MODE  > struct EpiBf {
    static constexpr bool PERM = true, AFTER_DRAIN = false;
    bf16* O; int ldc; const float* ssq; const float* cosT; const float* sinT; LnFold ln;
    __device__ __forceinline__ void operator()(const f32x4 (&acc)[2][2][4][2], const Unit& u, int wr, int wc, int fr, int fq) const {
        const int row0 = u.pm * 256 + wr * 64 + fr;
        float sc[2][8], tc[2][8];
#pragma unroll
        for (int bj = 0; bj < 2; ++bj) ln.cols(u.pn * 256 + bj * 128 + wc * 32 + 8 * fq, sc[bj], tc[bj]);
#pragma unroll
        for (int ai = 0; ai < 2; ++ai)
#pragma unroll
            for (int m = 0; m < 4; ++m) {
                const int row = row0 + ai * 128 + m * 16;
                float rs = 1.f;
                if (MODE == 1 || MODE == 2) rs = __builtin_amdgcn_rsqf(ssq[row] * (1.0f / 512.0f) + RMS_EPS);
                float mu, lr; ln.row(row, mu, lr);
#pragma unroll
                for (int bj = 0; bj < 2; ++bj) {
                    const int col0 = u.pn * 256 + bj * 128 + wc * 32 + 8 * fq;
                    float v[8];
#pragma unroll
                    for (int n = 0; n < 2; ++n)
#pragma unroll
                        for (int j = 0; j < 4; ++j) v[4 * n + j] = __builtin_fmaf(lr, acc[ai][bj][m][n][j], __builtin_fmaf(mu, sc[bj][4 * n + j], tc[bj][4 * n + j])) * rs;
                    if (MODE == 2) {
                        const int hd = col0 / 192, w = col0 - hd * 192;
                        if (w >= 128) {
                            const int pos = row & (SEQ - 1), jj0 = (w - 128) >> 1;
                            const f32x4 c = *(const f32x4*)(cosT + pos * 32 + jj0), s = *(const f32x4*)(sinT + pos * 32 + jj0);
#pragma unroll
                            for (int p = 0; p < 4; ++p) { const float a = v[2 * p], b = v[2 * p + 1]; v[2 * p] = a * c[p] - b * s[p]; v[2 * p + 1] = a * s[p] + b * c[p]; }
                        }
                    }
                    u32x4 o; o.x = pk2(v[0], v[1]); o.y = pk2(v[2], v[3]); o.z = pk2(v[4], v[5]); o.w = pk2(v[6], v[7]);
                    *(u32x4*)(O + (size_t)row * ldc + col0) = o;
                }
            }
    }
};
struct EpiWin {
    static constexpr bool PERM = true, AFTER_DRAIN = false;
    bf16 *CQ, *CKV, *Z, *QKV, *KPE; float* ssq_q; float* ssq_kv; const float* cosT; const float* sinT; LnFold ln;
    __device__ __forceinline__ void operator()(const f32x4 (&acc)[2][2][4][2], const Unit& u, int wr, int wc, int fr, int fq) const {
        const int row0 = u.pm * 256 + wr * 64 + fr, pn = u.pn;
        bf16* base; int ldc, ct; int kind;
        float* ssq = nullptr;
        if (pn < 2) { base = CQ; ldc = 512; ct = pn; kind = 1; ssq = ssq_q; }
        else if (pn < 4) { base = CKV; ldc = 512; ct = pn - 2; kind = 1; ssq = ssq_kv; }
        else if (pn < 8) { base = Z; ldc = ZW; ct = pn - 4; kind = 2; }
        else if (pn < 26) { base = QKV; ldc = QKVW; ct = pn - 8; kind = 0; }
        else { base = KPE; ldc = 64; ct = 0; kind = 3; }
        float sc[2][8], tc[2][8];
#pragma unroll
        for (int bj = 0; bj < 2; ++bj) ln.cols(pn * 256 + bj * 128 + wc * 32 + 8 * fq, sc[bj], tc[bj]);
#pragma unroll
        for (int ai = 0; ai < 2; ++ai)
#pragma unroll
            for (int m = 0; m < 4; ++m) {
                const int row = row0 + ai * 128 + m * 16;
                float mu, lr; ln.row(row, mu, lr);
                float sq = 0.f;
#pragma unroll
                for (int bj = 0; bj < 2; ++bj) {
                    const int cl = bj * 128 + wc * 32 + 8 * fq;
                    float v[8];
#pragma unroll
                    for (int n = 0; n < 2; ++n)
#pragma unroll
                        for (int j = 0; j < 4; ++j) v[4 * n + j] = __builtin_fmaf(lr, acc[ai][bj][m][n][j], __builtin_fmaf(mu, sc[bj][4 * n + j], tc[bj][4 * n + j]));
                    if (kind == 1) {
#pragma unroll
                        for (int j = 0; j < 8; ++j) sq += v[j] * v[j];
                    }
                    if (kind == 2) {
#pragma unroll
                        for (int p = 0; p < 4; ++p) { const f32x2 g = pg8::gelu_pk((f32x2){v[2 * p], v[2 * p + 1]}); v[2 * p] = g.x; v[2 * p + 1] = g.y; }
                    }
                    if (kind == 3) {
                        if (cl < 64) {
                            const int pos = row & (SEQ - 1), jj0 = cl >> 1;
                            const f32x4 c = *(const f32x4*)(cosT + pos * 32 + jj0), s = *(const f32x4*)(sinT + pos * 32 + jj0);
#pragma unroll
                            for (int p = 0; p < 4; ++p) { const float a = v[2 * p], b = v[2 * p + 1]; v[2 * p] = a * c[p] - b * s[p]; v[2 * p + 1] = a * s[p] + b * c[p]; }
                        }
                    }
                    if (kind != 3 || cl < 64) {
                        u32x4 o; o.x = pk2(v[0], v[1]); o.y = pk2(v[2], v[3]); o.z = pk2(v[4], v[5]); o.w = pk2(v[6], v[7]);
                        *(u32x4*)(base + (size_t)row * ldc + ct * 256 + cl) = o;
                    }
                }
                if (kind == 1) {
                    sq = xsum_16_32(sq);
                    if (fq == 0) unsafeAtomicAdd(ssq + row, sq);
                }
            }
    }
};
struct EpiGate8 {
    static constexpr bool PERM = true, AFTER_DRAIN = false;
    unsigned char* G01; unsigned char* G2; LnFold ln;
    __device__ __forceinline__ void operator()(const f32x4 (&acc)[2][2][4][2], const Unit& u, int wr, int wc, int fr, int fq) const {
        const int row0 = u.pm * 256 + wr * 64 + fr, pl = u.pn >> 3, pc = (u.pn & 7) * 256;
        unsigned char* O = pl < 2 ? G01 + (size_t)pl * GATE_PLANE : G2;
        float sc[2][8], tc[2][8];
#pragma unroll
        for (int bj = 0; bj < 2; ++bj) ln.cols(u.pn * 256 + bj * 128 + wc * 32 + 8 * fq, sc[bj], tc[bj]);
#pragma unroll
        for (int ai = 0; ai < 2; ++ai)
#pragma unroll
            for (int m = 0; m < 4; ++m) {
                const int row = row0 + ai * 128 + m * 16;
                float mu, lr; ln.row(row, mu, lr);
#pragma unroll
                for (int bj = 0; bj < 2; ++bj) {
                    const int col0 = pc + bj * 128 + wc * 32 + 8 * fq;
                    unsigned b[8];
#pragma unroll
                    for (int n = 0; n < 2; ++n)
#pragma unroll
                        for (int j = 0; j < 4; ++j) b[4 * n + j] = (unsigned)(fsigmoid(__builtin_fmaf(lr, acc[ai][bj][m][n][j], __builtin_fmaf(mu, sc[bj][4 * n + j], tc[bj][4 * n + j]))) * 255.0f + 0.5f);
                    *(u32x2*)(O + (size_t)row * D + col0) = (u32x2){b[0] | (b[1] << 8) | (b[2] << 16) | (b[3] << 24), b[4] | (b[5] << 8) | (b[6] << 16) | (b[7] << 24)};
                }
            }
    }
};
struct EpiWinGate {
    static constexpr bool PERM = true, AFTER_DRAIN = false;
    EpiWin w; EpiGate8 g;
    __device__ __forceinline__ void operator()(const f32x4 (&acc)[2][2][4][2], const Unit& u, int wr, int wc, int fr, int fq) const {
        if (u.pn < NWIN / 256) w(acc, u, wr, wc, fr, fq); else { Unit v; v.pm = u.pm; v.pn = u.pn - NWIN / 256; g(acc, v, wr, wc, fr, fq); }
    }
};
struct EpiGate8Raw {
    static constexpr bool PERM = true, AFTER_DRAIN = false;
    unsigned char* O;
    __device__ __forceinline__ void operator()(const f32x4 (&acc)[2][2][4][2], const Unit& u, int wr, int wc, int fr, int fq) const {
        const int row0 = u.pm * 256 + wr * 64 + fr;
#pragma unroll
        for (int ai = 0; ai < 2; ++ai)
#pragma unroll
            for (int m = 0; m < 4; ++m)
#pragma unroll
                for (int bj = 0; bj < 2; ++bj) {
                    const f32x4 a = acc[ai][bj][m][0], b = acc[ai][bj][m][1];
                    *(u32x2*)(O + (size_t)(row0 + ai * 128 + m * 16) * NGATE + u.pn * 256 + bj * 128 + wc * 32 + 8 * fq) = (u32x2){pk2(a.x + a.y, a.z + a.w), pk2(b.x + b.y, b.z + b.w)};
                }
    }
};
struct EpiMerge {
    static constexpr bool PERM = true, AFTER_DRAIN = false;
    const unsigned char* G01; const unsigned char* G2; bf16* MG;
    template <int WHICH> __device__ __forceinline__ void scale(f32x4 (&acc)[2][2][4][2], const Unit& u, int wr, int wc, int fr_, int fq_) const {
        int fr = fr_, fq = fq_; asm volatile("" : "+v"(fr), "+v"(fq));
        const int row0 = u.pm * 256 + wr * 64 + fr;
#pragma unroll
        for (int ai = 0; ai < 2; ++ai) {
            u32x2 gn[4][2], gd[4][2];
#pragma unroll
            for (int m = 0; m < 4; ++m)
#pragma unroll
                for (int bj = 0; bj < 2; ++bj) {
                    const size_t go = (size_t)(row0 + ai * 128 + m * 16) * D + u.pn * 256 + bj * 128 + wc * 32 + 8 * fq;
                    gn[m][bj] = *(const u32x2*)((WHICH == 0 ? G01 : WHICH == 1 ? G01 + GATE_PLANE : G2) + go);
                    if (WHICH < 2) gd[m][bj] = *(const u32x2*)((WHICH == 0 ? G01 + GATE_PLANE : G2) + go); else gd[m][bj] = (u32x2){0u, 0u};
                }
#pragma unroll
            for (int m = 0; m < 4; ++m)
#pragma unroll
                for (int bj = 0; bj < 2; ++bj)
#pragma unroll
                    for (int j = 0; j < 8; ++j) {
                        const unsigned nb = ((j < 4 ? gn[m][bj].x : gn[m][bj].y) >> (8 * (j & 3))) & 255u, db = ((j < 4 ? gd[m][bj].x : gd[m][bj].y) >> (8 * (j & 3))) & 255u;
                        const float num = (float)(WHICH == 0 ? nb : (nb > 1u ? nb : 1u));
                        const float s = WHICH < 2 ? num * __builtin_amdgcn_rcpf((float)(db > 1u ? db : 1u)) : num * (1.0f / 255.0f);
                        acc[ai][bj][m][j >> 2][j & 3] *= s;
                    }
        }
    }
    __device__ __forceinline__ void mid(f32x4 (&acc)[2][2][4][2], const Unit& u, int which, int wr, int wc, int fr, int fq) const {
        if (which == 0) scale<0>(acc, u, wr, wc, fr, fq); else scale<1>(acc, u, wr, wc, fr, fq);
    }
    __device__ __forceinline__ void operator()(f32x4 (&acc)[2][2][4][2], const Unit& u, int wr, int wc, int fr, int fq) const {
        scale<2>(acc, u, wr, wc, fr, fq);
        const int row0 = u.pm * 256 + wr * 64 + fr;
#pragma unroll
        for (int ai = 0; ai < 2; ++ai)
#pragma unroll
            for (int m = 0; m < 4; ++m)
#pragma unroll
                for (int bj = 0; bj < 2; ++bj) {
                    const f32x4 a = acc[ai][bj][m][0], b = acc[ai][bj][m][1];
                    u32x4 o; o.x = pk2(a.x, a.y); o.y = pk2(a.z, a.w); o.z = pk2(b.x, b.y); o.w = pk2(b.z, b.w);
                    *(u32x4*)(MG + (size_t)(row0 + ai * 128 + m * 16) * D + u.pn * 256 + bj * 128 + wc * 32 + 8 * fq) = o;
                }
    }
};

struct Frame {
    LAS unsigned char* lds;
    gu32* ctl;
    unsigned char* ws;
    int wave, vcu, G, gw, NGW;
    float* out;
};
constexpr int PTR_OFF = LDSCTL_OFF + 256;
__device__ __forceinline__ const float* inptr(const Frame& F, int i) {
    int z = 0; asm volatile("" : "+v"(z));
    const volatile LAS unsigned* p = (const volatile LAS unsigned*)(F.lds + PTR_OFF + 8 * i + z);
    const unsigned lo = __builtin_amdgcn_readfirstlane(p[0]), hi = __builtin_amdgcn_readfirstlane(p[1]);
    return (const float*)(((unsigned long long)hi << 32) | lo);
}
#define INP(i) inptr(F, (i))
__device__ __forceinline__ int tid_opaque() { int t = (int)threadIdx.x; asm volatile("" : "+v"(t)); return t; }
#define TID_ tid_opaque()
#define LANE_ (tid_opaque() & 63)
template <class T> __device__ __forceinline__ T* wsp(const Frame& F, size_t off) { return (T*)(F.ws + off); }
__device__ __forceinline__ size_t szero() { size_t z = 0; asm volatile("" : "+s"(z)); return z; }
__device__ __forceinline__ unsigned char* ws_launder(unsigned char* p) { return p + szero(); }
__device__ __forceinline__ int vlaunder(int v) { asm volatile("" : "+v"(v)); return v; }

__device__ __forceinline__ int rowmap(int mode, int n) {
    switch (mode) {
        case 1: return 256 * (n >> 7) + (n & 127);
        case 2: return 256 * (n >> 7) + 128 + (n & 127);
        case 3: {
            if (n < 1024) return n;
            if (n < 1088) { const int j = n - 1024; return 6656 + 2 * (j & 31) + (j >> 5); }
            return n - 64; }
        case 4: { const int hd = n / 192, w = n - hd * 192; if (w < 128) return n; const int j = w - 128; return hd * 192 + 128 + 2 * (j & 31) + (j >> 5); }
        default: return n;
    }
}
struct TrJob { const float* src; const float* ks; const float* lnb; float* sn; int ldw, K, nblk, mode, r; size_t dstoff; bool hit; };
__device__ __forceinline__ void tr_load(const TrJob& j, f32x4 (&v)[16], int lane) {
    const int k0 = 64 * (j.r / j.nblk), n0 = 64 * (j.r % j.nblk);
#pragma unroll
    for (int i = 0; i < 16; ++i) { const int kk = 4 * i + (lane >> 4); v[i] = __builtin_nontemporal_load((const f32x4*)(j.src + (size_t)(k0 + kk) * j.ldw + n0 + 4 * (lane & 15))); }
}
__device__ __forceinline__ void tr_store(const TrJob& j, const f32x4 (&v)[16], unsigned char* ws, LAS float* scr, LAS float* tmp, int lane) {
    const int k0 = 64 * (j.r / j.nblk), n0 = 64 * (j.r % j.nblk);
    bf16* WT = (bf16*)(ws + j.dstoff);
    f32x4 ts = (f32x4){0.f, 0.f, 0.f, 0.f};
#pragma unroll
    for (int i = 0; i < 16; ++i) { const int kk = 4 * i + (lane >> 4); f32x4 x = v[i];
        if (j.lnb) ts += x * j.lnb[k0 + kk];
        if (j.ks) x = x * j.ks[k0 + kk];
        LAS float* d = scr + kk * 65 + 4 * (lane & 15); d[0] = x.x; d[1] = x.y; d[2] = x.z; d[3] = x.w; }
    if (j.lnb) {
#pragma unroll
        for (int e = 0; e < 4; ++e) { float t = ts[e]; t += shx(t, 16); t += shx(t, 32); ts[e] = t; }
        if ((lane >> 4) == 0) {
#pragma unroll
            for (int e = 0; e < 4; ++e) tmp[4 * (lane & 15) + e] = ts[e];
        }
    }
    LDS_WAIT(); asm volatile("" ::: "memory");
    const int c8 = lane & 7;
#pragma unroll
    for (int jj = 0; jj < 8; ++jj) { const int n = (lane >> 3) + 8 * jj; const LAS float* s = scr + (8 * c8) * 65 + n;
        u32x4 o; o.x = pk2(s[0 * 65], s[1 * 65]); o.y = pk2(s[2 * 65], s[3 * 65]); o.z = pk2(s[4 * 65], s[5 * 65]); o.w = pk2(s[6 * 65], s[7 * 65]);
        const int drow = rowmap(j.mode, n0 + n);
        *(GAS u32x4*)(WT + (size_t)drow * j.K + k0 + 8 * c8) = o;
        if (j.lnb) { float sv = ((bflo(o.x) + bfhi(o.x)) + (bflo(o.y) + bfhi(o.y))) + ((bflo(o.z) + bfhi(o.z)) + (bflo(o.w) + bfhi(o.w)));
            sv += shx(sv, 1); sv += shx(sv, 2); sv += shx(sv, 4);
            if (c8 == 0) tmp[64 + n] = sv; } }
    LDS_WAIT(); asm volatile("" ::: "memory");
    if (j.lnb) {
        const int drow = rowmap(j.mode, n0 + lane);
        unsafeAtomicAdd(j.sn + SNT_N + drow, tmp[lane]); unsafeAtomicAdd(j.sn + drow, tmp[64 + lane]);
        LDS_WAIT(); asm volatile("" ::: "memory");
    }
}
__device__ __forceinline__ void cvt_rows(const Frame& F, const float* src, bf16* dst, size_t n) {
    for (size_t i = ((size_t)F.gw * 64 + LANE_) * 8; i < n; i += (size_t)F.NGW * 64 * 8) {
        const f32x4 a = __builtin_nontemporal_load((const f32x4*)(src + i)), b = __builtin_nontemporal_load((const f32x4*)(src + i + 4));
        u32x4 o; o.x = pk2(a.x, a.y); o.y = pk2(a.z, a.w); o.z = pk2(b.x, b.y); o.w = pk2(b.z, b.w);
        *(u32x4*)(dst + i) = o; }
}
__device__ __forceinline__ int t5_bucket(int dist) {
    if (dist < 16) return dist;
    const float df = (float)dist;
    int large = 16 + (int)(logf(df / 16.0f) / logf(128.0f) * 16.0f);
    return large < 31 ? large : 31;
}
__device__ __forceinline__ void p0_prologue(const Frame& F_, int l) {
    Frame F = F_;  F.ws = F_.ws + szero();
    LAS float* scr = (LAS float*)(F.lds + F.wave * 16640);
    LAS float* tmp = (LAS float*)(F.lds + 8 * 16640 + F.wave * 512);
#define TRJOB(SRC, LDW, KK, NN, DSTOFF, MODE, KS, LNB, SNOFF) if (!j.hit) { const int items = ((KK) / 64) * ((NN) / 64); if (r < items) { j.hit = true; j.src = (SRC); j.ldw = (LDW); j.K = (KK); j.nblk = (NN) / 64; \
        j.dstoff = (DSTOFF); j.mode = (MODE); j.ks = (KS); j.lnb = (LNB); j.sn = snt + (SNOFF); j.r = r; } else r -= items; }
    const float* wg = INP(4) + (size_t)l * 2 * D * FF; const float* wu = INP(5) + (size_t)l * 2 * D * FF; const float* wd = INP(6) + (size_t)l * 2 * FF * D;
    const float* win = INP(7) + (size_t)l * D * N_IN_SRC;
    const float* wbr = INP(17) + (size_t)l * D * D;
    const float* lng = INP(2); const float* lnb = INP(3);
    const float* g_f0 = l ? lng + (size_t)((l - 1) * 4 + 3) * D : nullptr; const float* b_f0 = l ? lnb + (size_t)((l - 1) * 4 + 3) * D : nullptr;
    const float* g_m = lng + (size_t)(l * 4 + 0) * D; const float* b_m = lnb + (size_t)(l * 4 + 0) * D;
    const float* g_x = lng + (size_t)(l * 4 + 1) * D; const float* b_x = lnb + (size_t)(l * 4 + 1) * D;
    const float* g_f1 = lng + (size_t)(l * 4 + 2) * D; const float* b_f1 = lnb + (size_t)(l * 4 + 2) * D;
    float* snt = (float*)(F.ws + CTL_SNT) + (size_t)l * 2 * SNT_N;
    constexpr int ITEMS = 6 * (D / 64) * (FF / 64) + (D / 64) * (N_IN_SRC / 64) + (512 / 64) * ((QW + KVW) / 64) + 2 * (D / 64) * (D / 64) + (D / 64) * ((512 + 1024) / 64) + (512 / 64) * (D / 64);
    auto select = [&](int it) -> TrJob {
        TrJob j; j.hit = false; j.src = nullptr; j.ks = nullptr; j.lnb = nullptr; j.sn = nullptr; j.ldw = 0; j.K = 0; j.nblk = 1; j.mode = 0; j.r = 0; j.dstoff = 0;
        if (it >= ITEMS) return j;
        int r = it;
        TRJOB(wg, FF, D, FF, W_GU0, 1, g_f0, b_f0, SNT_FFN0)
        TRJOB(wu, FF, D, FF, W_GU0, 2, g_f0, b_f0, SNT_FFN0)
        TRJOB(wd, D, FF, D, W_D0, 0, nullptr, nullptr, 0)
        TRJOB(wg + (size_t)D * FF, FF, D, FF, W_GU1, 1, g_f1, b_f1, SNT_FFN1)
        TRJOB(wu + (size_t)D * FF, FF, D, FF, W_GU1, 2, g_f1, b_f1, SNT_FFN1)
        TRJOB(wd + (size_t)FF * D, D, FF, D, W_D1, 0, nullptr, nullptr, 0)
        TRJOB(win, N_IN_SRC, D, NWIN_SRC, W_IN, 3, g_m, b_m, SNT_WIN)
        TRJOB(win + NWIN_SRC, N_IN_SRC, D, NGATE, W_GATE, 0, g_m, b_m, SNT_GATE)
        TRJOB(INP(10) + (size_t)l * 512 * QW, QW, 512, QW, W_UQ, 4, INP(8) + l * 512, nullptr, 0)
        TRJOB(INP(11) + (size_t)l * 512 * KVW, KVW, 512, KVW, W_UKV, 0, INP(9) + l * 512, nullptr, 0)
        TRJOB(wbr, D, D, D, W_PA, 0, nullptr, nullptr, 0)
        TRJOB(INP(18) + (size_t)l * D * D, D, D, D, W_OUT, 0, nullptr, nullptr, 0)
        TRJOB(INP(19) + (size_t)l * D * 512, 512, D, 512, W_XQ, 0, g_x, b_x, SNT_XQ)
        TRJOB(INP(20) + (size_t)l * D * 1024, 1024, D, 1024, W_XKV, 0, nullptr, nullptr, 0)
        TRJOB(INP(21) + (size_t)l * 512 * D, D, 512, D, W_XO, 0, nullptr, nullptr, 0)
        return j;
    };
    {
        f32x4 va[16], vb[16];
        int it = F.gw; TrJob ja = select(it); if (ja.hit) tr_load(ja, va, LANE_);
        while (ja.hit) {
            TrJob jb = select(it + F.NGW); if (jb.hit) tr_load(jb, vb, LANE_);
            tr_store(ja, va, F.ws, scr, tmp, LANE_);
            if (!jb.hit) break;
            it += 2 * F.NGW; ja = select(it); if (ja.hit) tr_load(ja, va, LANE_);
            tr_store(jb, vb, F.ws, scr, tmp, LANE_);
        }
    }
#undef TRJOB
    { bf16* pad = wsp<bf16>(F, W_IN) + (size_t)NWIN_SRC * D; const size_t n = (size_t)(NWIN - NWIN_SRC) * D;
      const unsigned z_ = (unsigned)vlaunder(0);
      for (size_t i = ((size_t)F.gw * 64 + LANE_) * 8; i < n; i += (size_t)F.NGW * 64 * 8) *(u32x4*)(pad + i) = (u32x4){z_, z_, z_, z_}; }
    { const float* ws_ = INP(14) + (size_t)l * 4 * 128 * 128; bf16* o = wsp<bf16>(F, TAB_SGUW);
      for (int i = F.gw * 64 + LANE_; i < 4 * 128 * 128; i += F.NGW * 64) { const int t = (i >> 7) & 127, s = i & 127; o[i] = (bf16)(pk2(s <= t ? ws_[i] : 0.f, 0.f) & 0xffffu); } }
    if (l == 0) {
        cvt_rows(F, INP(0), wsp<bf16>(F, WS_XB), (size_t)M * D);
        cvt_rows(F, INP(1), wsp<bf16>(F, WS_MEMB), (size_t)BATCH * MEM * D);
        float* cosT = wsp<float>(F, TAB_COS); float* sinT = wsp<float>(F, TAB_SIN);
        for (int i = F.gw * 64 + LANE_; i < SEQ * 32; i += F.NGW * 64) { const int pos = i >> 5, j = i & 31;
            const float inv = powf(10000.0f, -(float)(2 * j) / 64.0f); const float ang = (float)pos * inv; cosT[i] = cosf(ang); sinT[i] = sinf(ang); }
        float* bt = wsp<float>(F, TAB_BIAS); const float* rel = INP(16);
        for (int i = F.gw * 64 + LANE_; i < 12 * BIAS_STRIDE; i += F.NGW * 64) { const int gh = i / BIAS_STRIDE, j = i - gh * BIAS_STRIDE; const int g = gh >> 2;
            const int dil = g == 0 ? 1 : (g == 1 ? 4 : 16);
            bt[i] = j <= 128 ? rel[t5_bucket(j * dil) * 12 + gh] * LOG2E : 0.f; }
    }
}

__device__ __forceinline__ void ln_final(const Frame& F, const bf16* ZH, const bf16* ZLo, float* out, const float* g, const float* b) {
    const int lane_ = vlaunder(LANE_);
    for (int m = F.gw; m < M; m += F.NGW) {
        const GAS u32x4* hr = (const GAS u32x4*)(ZH + (size_t)m * D) + lane_; const GAS u32x4* lr = (const GAS u32x4*)(ZLo + (size_t)m * D) + lane_;
        float v[4][8]; float s = 0.f;
#pragma unroll
        for (int j = 0; j < 4; ++j) { const u32x4 h = hr[64 * j], l = lr[64 * j];
            v[j][0] = bflo(h.x) + bflo(l.x); v[j][1] = bfhi(h.x) + bfhi(l.x); v[j][2] = bflo(h.y) + bflo(l.y); v[j][3] = bfhi(h.y) + bfhi(l.y);
            v[j][4] = bflo(h.z) + bflo(l.z); v[j][5] = bfhi(h.z) + bfhi(l.z); v[j][6] = bflo(h.w) + bflo(l.w); v[j][7] = bfhi(h.w) + bfhi(l.w);
#pragma unroll
            for (int e = 0; e < 8; ++e) s += v[j][e]; }
        const float mean = wave_sum(s) * (1.f / D); float s2 = 0.f;
#pragma unroll
        for (int j = 0; j < 4; ++j)
#pragma unroll
            for (int e = 0; e < 8; ++e) { v[j][e] -= mean; s2 += v[j][e] * v[j][e]; }
        const float rstd = 1.f / sqrtf(wave_sum(s2) * (1.f / D) + LN_EPS);
        GAS f32x4* orow = (GAS f32x4*)(out + (size_t)m * D);
#pragma unroll
        for (int j = 0; j < 4; ++j) { const int c = 8 * (lane_ + 64 * j);
            const f32x4 g0 = *(const f32x4*)(g + c), g1 = *(const f32x4*)(g + c + 4), b0 = *(const f32x4*)(b + c), b1 = *(const f32x4*)(b + c + 4);
            orow[2 * (lane_ + 64 * j)] = (f32x4){v[j][0] * rstd * g0.x + b0.x, v[j][1] * rstd * g0.y + b0.y, v[j][2] * rstd * g0.z + b0.z, v[j][3] * rstd * g0.w + b0.w};
            orow[2 * (lane_ + 64 * j) + 1] = (f32x4){v[j][4] * rstd * g1.x + b1.x, v[j][5] * rstd * g1.y + b1.y, v[j][6] * rstd * g1.z + b1.z, v[j][7] * rstd * g1.w + b1.w}; }
    }
}

constexpr int AT_KN = 0, AT_KR = 16384, AT_V = 24576, AT_BUF = 43008, AT_BIAS = 4 * (16384 + 18432);
constexpr int VPITCH = 288;
template <int DK, int QT, int NWV, class Src, class Msk, bool PIPE = false>
__device__ __forceinline__ void attn_unit(const Frame& F, const Src& src, const Msk& msk, int kt0, int kt1) {
    constexpr int KS = DK / 32, NKC = DK == 192 ? 3 : 2, NT = 64 * NWV, NI = 1024 / NT, BUFB = (NWV == 8) ? AT_BUF : (AT_KR + 18432), OFF_V = (NWV == 8) ? AT_V : AT_KR;
    static_assert(NWV == 8 || DK == 128, "the half-workgroup form has no rope buffer");
    const int tid_ = vlaunder(TID_), lane = tid_ & 63, tid = tid_ & (NT - 1), w = F.wave & (NWV - 1), q16 = lane & 15, kq = lane >> 4;
    LAS unsigned char* lds = F.lds + (F.wave / NWV) * (2 * BUFB);
    bf16x8 qf[QT][KS];
#pragma unroll
    for (int qt = 0; qt < QT; ++qt) { const bf16* qr = src.qrow(w * 16 * QT + 16 * qt + q16);
#pragma unroll
        for (int ks = 0; ks < KS; ++ks) qf[qt][ks] = *(const bf16x8*)(qr + 32 * ks + 8 * kq); }
    f32x4 o[QT][8];
    float mrun[QT], lrun[QT];
    float z0 = 0.f; asm volatile("" : "+v"(z0));
#pragma unroll
    for (int qt = 0; qt < QT; ++qt) { mrun[qt] = NEGBIG; lrun[qt] = z0;
#pragma unroll
        for (int dt = 0; dt < 8; ++dt) o[qt][dt] = (f32x4){z0, z0, z0, z0}; }
    u32x4 kr[NI + (DK == 192 ? 1 : 0)], vr[NI];
#define AT_LOAD(kt) do { const int kb = 64 * (kt); \
        _Pragma("unroll") for (int i = 0; i < NI; ++i) { const int it = tid + NT * i, row = it >> 4, ch = it & 15; kr[i] = *(const u32x4*)src.kptr(kb + row, ch); vr[i] = *(const u32x4*)src.vptr(kb + row, ch); } \
        if (DK == 192) { const int row = tid >> 3, ch = tid & 7; kr[NI] = *(const u32x4*)src.kptr(kb + row, 16 + ch); } } while (0)
#define AT_STORE(buf) do { LAS unsigned char* bb = lds + (buf) * BUFB; \
        _Pragma("unroll") for (int i = 0; i < NI; ++i) { const int it = tid + NT * i, row = it >> 4, ch = it & 15; \
            *(LAS u32x4*)(bb + AT_KN + row * 256 + ((ch ^ (row & 15)) << 4)) = kr[i]; *(LAS u32x4*)(bb + OFF_V + row * VPITCH + (ch << 4)) = vr[i]; } \
        if (DK == 192) { const int row = tid >> 3, ch = tid & 7; *(LAS u32x4*)(bb + AT_KR + row * 128 + ((ch ^ ((row >> 1) & 7)) << 4)) = kr[NI]; } } while (0)
    if constexpr (PIPE) {
    static_assert(NWV == 8, "pipelined form: one unit per workgroup");
#define AT_LOADK(kt) do { const int kb = 64 * (kt); \
        _Pragma("unroll") for (int i = 0; i < NI; ++i) { const int it = tid + NT * i, row = it >> 4, ch = it & 15; kr[i] = *(const u32x4*)src.kptr(kb + row, ch); } \
        if (DK == 192) { const int row = tid >> 3, ch = tid & 7; kr[NI] = *(const u32x4*)src.kptr(kb + row, 16 + ch); } } while (0)
#define AT_LOADV(kt) do { const int kb = 64 * (kt); \
        _Pragma("unroll") for (int i = 0; i < NI; ++i) { const int it = tid + NT * i, row = it >> 4, ch = it & 15; vr[i] = *(const u32x4*)src.vptr(kb + row, ch); } } while (0)
#define AT_KBUF(slot) (lds + ((slot) < 2 ? (slot) * BUFB : 2 * BUFB))
#define AT_STOREK(slot) do { LAS unsigned char* bb = AT_KBUF(slot); \
        _Pragma("unroll") for (int i = 0; i < NI; ++i) { const int it = tid + NT * i, row = it >> 4, ch = it & 15; *(LAS u32x4*)(bb + AT_KN + row * 256 + ((ch ^ (row & 15)) << 4)) = kr[i]; } \
        if (DK == 192) { const int row = tid >> 3, ch = tid & 7; *(LAS u32x4*)(bb + AT_KR + row * 128 + ((ch ^ ((row >> 1) & 7)) << 4)) = kr[NI]; } } while (0)
#define AT_STOREV(buf) do { LAS unsigned char* bb = lds + (buf) * BUFB; \
        _Pragma("unroll") for (int i = 0; i < NI; ++i) { const int it = tid + NT * i, row = it >> 4, ch = it & 15; *(LAS u32x4*)(bb + OFF_V + row * VPITCH + (ch << 4)) = vr[i]; } } while (0)
#define AT_QKH(S_, slot, h) do { const LAS unsigned char* bb = AT_KBUF(slot); \
        _Pragma("unroll") for (int qt = 0; qt < QT; ++qt) _Pragma("unroll") for (int s2 = 0; s2 < 2; ++s2) S_[qt][s2] = (f32x4){0.f, 0.f, 0.f, 0.f}; \
        _Pragma("unroll") for (int s2 = 0; s2 < 2; ++s2) { const int row = 16 * (2 * (h) + s2) + q16; \
            _Pragma("unroll") for (int ks = 0; ks < KS; ++ks) { bf16x8 kf; \
                if (ks < 4) kf = *(const LAS bf16x8*)(bb + AT_KN + row * 256 + (((4 * ks + kq) ^ q16) << 4)); \
                else        kf = *(const LAS bf16x8*)(bb + AT_KR + row * 128 + (((4 * (ks - 4) + kq) ^ (q16 >> 1)) << 4)); \
                _Pragma("unroll") for (int qt = 0; qt < QT; ++qt) S_[qt][s2] = __builtin_amdgcn_mfma_f32_16x16x32_bf16(kf, qf[qt][ks], S_[qt][s2], 0, 0, 0); } } } while (0)
#define AT_SMPV(S_, kt, h, vbuf) do { bf16x8 pf[QT]; \
        _Pragma("unroll") for (int qt = 0; qt < QT; ++qt) { const int ql = w * 16 * QT + 16 * qt + q16; float mx = NEGBIG; \
            _Pragma("unroll") for (int s2 = 0; s2 < 2; ++s2) _Pragma("unroll") for (int j = 0; j < 4; ++j) { const float v = msk.apply(S_[qt][s2][j], ql, 64 * (kt) + 32 * (h) + 16 * s2 + 4 * kq + j); S_[qt][s2][j] = v; mx = fmaxf(mx, v); } \
            mx = xmax_16_32(mx); \
            const float mnew = fmaxf(mrun[qt], mx), alpha = __builtin_amdgcn_exp2f(mrun[qt] - mnew); mrun[qt] = mnew; float rs = 0.f; \
            _Pragma("unroll") for (int s2 = 0; s2 < 2; ++s2) _Pragma("unroll") for (int j = 0; j < 4; ++j) { const float p = __builtin_amdgcn_exp2f(S_[qt][s2][j] - mnew); S_[qt][s2][j] = p; rs += p; } \
            lrun[qt] = lrun[qt] * alpha + rs; \
            _Pragma("unroll") for (int dt = 0; dt < 8; ++dt) o[qt][dt] *= alpha; \
            u32x4 pw; pw.x = pk2(S_[qt][0][0], S_[qt][0][1]); pw.y = pk2(S_[qt][0][2], S_[qt][0][3]); pw.z = pk2(S_[qt][1][0], S_[qt][1][1]); pw.w = pk2(S_[qt][1][2], S_[qt][1][3]); \
            pf[qt] = __builtin_bit_cast(bf16x8, pw); } \
        const LAS unsigned char* vb = lds + (vbuf) * BUFB + OFF_V + (4 * kq + (q16 >> 2)) * VPITCH + (q16 & 3) * 8; \
        _Pragma("unroll") for (int dt = 0; dt < 8; ++dt) { \
            const s16x4 lo = __builtin_bit_cast(s16x4, __builtin_amdgcn_ds_read_tr16_b64_v4i16((LAS s16x4*)(vb + (32 * (h)) * VPITCH + dt * 32))); \
            const s16x4 hi = __builtin_bit_cast(s16x4, __builtin_amdgcn_ds_read_tr16_b64_v4i16((LAS s16x4*)(vb + (32 * (h) + 16) * VPITCH + dt * 32))); \
            const bf16x8 vf = __builtin_shufflevector(lo, hi, 0, 1, 2, 3, 4, 5, 6, 7); \
            _Pragma("unroll") for (int qt = 0; qt < QT; ++qt) o[qt][dt] = __builtin_amdgcn_mfma_f32_16x16x32_bf16(vf, pf[qt], o[qt][dt], 0, 0, 0); } } while (0)
    f32x4 sa[QT][2], sb[QT][2];
    AT_LOADK(kt0); AT_LOADV(kt0); AT_STOREK(0); AT_STOREV(0);
    if (kt0 + 1 < kt1) { AT_LOADK(kt0 + 1); AT_STOREK(1); }
    __syncthreads();
    if (msk.active(w, kt0)) AT_QKH(sa, 0, 0);
    int k0 = 0, k1 = 1, k2 = 2;
    for (int kt = kt0; kt < kt1; ++kt) {
        const int buf = (kt - kt0) & 1;
        if (kt + 2 < kt1) AT_LOADK(kt + 2);
        if (kt + 1 < kt1) AT_LOADV(kt + 1);
        const bool act = msk.active(w, kt), actn = (kt + 1 < kt1) && msk.active(w, kt + 1);
        if (act) { AT_QKH(sb, k0, 1); AT_SMPV(sa, kt, 0, buf); }
        if (actn) AT_QKH(sa, k1, 0);
        if (act) AT_SMPV(sb, kt, 1, buf);
        if (kt + 2 < kt1) AT_STOREK(k2);
        if (kt + 1 < kt1) AT_STOREV(buf ^ 1);
        __syncthreads();
        { const int t_ = k0; k0 = k1; k1 = k2; k2 = t_; }
    }
#undef AT_LOADK
#undef AT_LOADV
#undef AT_KBUF
#undef AT_STOREK
#undef AT_STOREV
#undef AT_QKH
#undef AT_SMPV
    } else {
    AT_LOAD(kt0); AT_STORE(0);
    __syncthreads();
    for (int kt = kt0; kt < kt1; ++kt) {
        const int buf = (kt - kt0) & 1;
        if (kt + 1 < kt1) AT_LOAD(kt + 1);
        if (msk.active(w, kt)) {
            const LAS unsigned char* bb = lds + buf * BUFB;
            f32x4 s[QT][4];
#pragma unroll
            for (int qt = 0; qt < QT; ++qt)
#pragma unroll
                for (int sub = 0; sub < 4; ++sub) s[qt][sub] = (f32x4){0.f, 0.f, 0.f, 0.f};
            {
                constexpr int KR = 5, NSTEP = 4 * KS;
                bf16x8 kfr[KR];
#define AT_KS_(idx) ((idx) >> 2)
#define AT_SUB_(idx) ((idx) & 3)
#define AT_KF(idx) (AT_KS_(idx) < 4 ? *(const LAS bf16x8*)(bb + AT_KN + (16 * AT_SUB_(idx) + q16) * 256 + (((4 * AT_KS_(idx) + kq) ^ q16) << 4)) \
                                     : *(const LAS bf16x8*)(bb + AT_KR + (16 * AT_SUB_(idx) + q16) * 128 + (((4 * (AT_KS_(idx) - 4) + kq) ^ (q16 >> 1)) << 4)))
#pragma unroll
                for (int i = 0; i < KR - 1; ++i) kfr[i] = AT_KF(i);
#pragma unroll
                for (int idx = 0; idx < NSTEP; ++idx) {
                    if (idx + KR - 1 < NSTEP) kfr[(idx + KR - 1) % KR] = AT_KF(idx + KR - 1);
#pragma unroll
                    for (int qt = 0; qt < QT; ++qt) s[qt][AT_SUB_(idx)] = __builtin_amdgcn_mfma_f32_16x16x32_bf16(kfr[idx % KR], qf[qt][AT_KS_(idx)], s[qt][AT_SUB_(idx)], 0, 0, 0);
                }
#undef AT_KF
#undef AT_KS_
#undef AT_SUB_
            }
            bf16x8 pf[QT][2];
#pragma unroll
            for (int qt = 0; qt < QT; ++qt) {
                const int ql = w * 16 * QT + 16 * qt + q16;
                float mx = NEGBIG;
#pragma unroll
                for (int sub = 0; sub < 4; ++sub)
#pragma unroll
                    for (int j = 0; j < 4; ++j) { const float v = msk.apply(s[qt][sub][j], ql, 64 * kt + 16 * sub + 4 * kq + j); s[qt][sub][j] = v; mx = fmaxf(mx, v); }
                mx = xmax_16_32(mx);
                const float mnew = fmaxf(mrun[qt], mx), alpha = __builtin_amdgcn_exp2f(mrun[qt] - mnew);
                mrun[qt] = mnew;
                float rs = 0.f;
#pragma unroll
                for (int sub = 0; sub < 4; ++sub)
#pragma unroll
                    for (int j = 0; j < 4; ++j) { const float p = __builtin_amdgcn_exp2f(s[qt][sub][j] - mnew); s[qt][sub][j] = p; rs += p; }
                lrun[qt] = lrun[qt] * alpha + rs;
#pragma unroll
                for (int dt = 0; dt < 8; ++dt) o[qt][dt] *= alpha;
#pragma unroll
                for (int c = 0; c < 2; ++c) {
                    u32x4 pw; pw.x = pk2(s[qt][2 * c][0], s[qt][2 * c][1]); pw.y = pk2(s[qt][2 * c][2], s[qt][2 * c][3]);
                    pw.z = pk2(s[qt][2 * c + 1][0], s[qt][2 * c + 1][1]); pw.w = pk2(s[qt][2 * c + 1][2], s[qt][2 * c + 1][3]);
                    pf[qt][c] = __builtin_bit_cast(bf16x8, pw);
                }
            }
            const LAS unsigned char* vb = bb + OFF_V + (4 * kq + (q16 >> 2)) * VPITCH + (q16 & 3) * 8;
            {
                constexpr int VR = 4;
                s16x4 vlo[VR], vhi[VR];
#define AT_VLO(st) __builtin_bit_cast(s16x4, __builtin_amdgcn_ds_read_tr16_b64_v4i16((LAS s16x4*)(vb + (32 * ((st) >> 3)) * VPITCH + ((st) & 7) * 32)))
#define AT_VHI(st) __builtin_bit_cast(s16x4, __builtin_amdgcn_ds_read_tr16_b64_v4i16((LAS s16x4*)(vb + (32 * ((st) >> 3) + 16) * VPITCH + ((st) & 7) * 32)))
#pragma unroll
                for (int i = 0; i < VR - 1; ++i) { vlo[i] = AT_VLO(i); vhi[i] = AT_VHI(i); }
#pragma unroll
                for (int st = 0; st < 16; ++st) {
                    if (st + VR - 1 < 16) { vlo[(st + VR - 1) % VR] = AT_VLO(st + VR - 1); vhi[(st + VR - 1) % VR] = AT_VHI(st + VR - 1); }
                    const bf16x8 vf = __builtin_shufflevector(vlo[st % VR], vhi[st % VR], 0, 1, 2, 3, 4, 5, 6, 7);
#pragma unroll
                    for (int qt = 0; qt < QT; ++qt) o[qt][st & 7] = __builtin_amdgcn_mfma_f32_16x16x32_bf16(vf, pf[qt][st >> 3], o[qt][st & 7], 0, 0, 0);
                }
#undef AT_VLO
#undef AT_VHI
            }
        }
        if (kt + 1 < kt1) AT_STORE(buf ^ 1);
        __syncthreads();
    }
    }
#undef AT_LOAD
#undef AT_STORE
#pragma unroll
    for (int qt = 0; qt < QT; ++qt) {
        float l = xsum_16_32(lrun[qt]);
        const float inv = 1.0f / l;
        const int ql = w * 16 * QT + 16 * qt + q16;
        bf16* orow = src.orow(ql);
#pragma unroll
        for (int dt = 0; dt < 8; ++dt) { const f32x4 v = o[qt][dt] * inv; *(u32x2*)(orow + 16 * dt + 4 * kq) = (u32x2){pk2(v.x, v.y), pk2(v.z, v.w)}; }
        if (kq == 0) src.put_lse(ql, (mrun[qt] + __builtin_amdgcn_logf(l)) * LN2);
    }
}

struct MlaSrc {
    const bf16* Q; const bf16* KV; const bf16* KPE; bf16* O; size_t rb; int h, q0;
    __device__ __forceinline__ const bf16* qrow(int r) const { return Q + (rb + q0 + r) * QW + h * 192; }
    __device__ __forceinline__ const bf16* kptr(int key, int ch) const { return ch < 16 ? KV + (rb + key) * KVW + h * 256 + ch * 8 : KPE + (rb + key) * 64 + (ch - 16) * 8; }
    __device__ __forceinline__ const bf16* vptr(int key, int ch) const { return KV + (rb + key) * KVW + h * 256 + 128 + ch * 8; }
    __device__ __forceinline__ bf16* orow(int r) const { return O + (rb + q0 + r) * 1024 + h * 128; }
    __device__ __forceinline__ void put_lse(int, float) const {}
};
struct MlaMsk {
    int q0; float c;
    __device__ __forceinline__ bool active(int w, int kt) const { return 64 * kt <= q0 + 32 * w + 31; }
    __device__ __forceinline__ float apply(float s, int ql, int key) const { return key <= q0 + ql ? s * c : NEGBIG; }
};
struct XaSrc {
    const bf16* Q; const bf16* KVX; bf16* O; size_t rb, kb; int h, q0;
    __device__ __forceinline__ const bf16* qrow(int r) const { return Q + (rb + q0 + r) * 512 + h * 128; }
    __device__ __forceinline__ const bf16* kptr(int key, int ch) const { return KVX + (kb + key) * 1024 + h * 128 + ch * 8; }
    __device__ __forceinline__ const bf16* vptr(int key, int ch) const { return KVX + (kb + key) * 1024 + 512 + h * 128 + ch * 8; }
    __device__ __forceinline__ bf16* orow(int r) const { return O + (rb + q0 + r) * 512 + h * 128; }
    __device__ __forceinline__ void put_lse(int, float) const {}
};
struct XaMsk {
    float c;
    __device__ __forceinline__ bool active(int, int) const { return true; }
    __device__ __forceinline__ float apply(float s, int, int) const { return s * c; }
};
struct DilSrc {
    bf16* QKV; float* LSE; size_t rb; int dil, r, n, col;
    __device__ __forceinline__ size_t row(int sub) const { return rb + (size_t)sub * dil + r; }
    __device__ __forceinline__ const bf16* qrow(int q) const { return QKV + row(128 * n + q) * QKVW + col; }
    __device__ __forceinline__ const bf16* kptr(int k, int ch) const { return QKV + row(128 * (n - 1) + k) * QKVW + 1536 + col + ch * 8; }
    __device__ __forceinline__ const bf16* vptr(int k, int ch) const { return QKV + row(128 * (n - 1) + k) * QKVW + 3072 + col + ch * 8; }
    __device__ __forceinline__ bf16* orow(int q) const { return QKV + row(128 * n + q) * QKVW + col; }
    __device__ __forceinline__ void put_lse(int q, float v) const { LSE[row(128 * n + q) * 4] = v; }
};
struct DilMsk {
    const LAS float* bias; float c;
    __device__ __forceinline__ bool active(int w, int kt) const { return 64 * kt + 63 >= 32 * w && 64 * kt <= 32 * w + 31 + 128; }
    __device__ __forceinline__ float apply(float s, int ql, int k) const { const int j = ql + 128 - k; const int jc = j < 0 ? 0 : (j > 128 ? 128 : j); const float bv = bias[jc]; return (j >= 0 && j <= 128) ? s * c + bv : NEGBIG; }
};

constexpr int SG_PITCH = 1056;
__device__ __forceinline__ void sgu_unit(const Frame& F, bf16* Z, const float* lng, const float* lnb, const bf16* SW, const float* bs, int unit) {
    const int lane = vlaunder(LANE_), w = F.wave, q16 = lane & 15, kq = lane >> 4;
    const size_t m0 = (size_t)unit * 128;
    LAS unsigned char* lds = F.lds;
    float gg[8], bb[8];
    { const f32x4 g0 = *(const f32x4*)(lng + 8 * lane), g1 = *(const f32x4*)(lng + 8 * lane + 4), b0 = *(const f32x4*)(lnb + 8 * lane), b1 = *(const f32x4*)(lnb + 8 * lane + 4);
      gg[0] = g0.x; gg[1] = g0.y; gg[2] = g0.z; gg[3] = g0.w; gg[4] = g1.x; gg[5] = g1.y; gg[6] = g1.z; gg[7] = g1.w;
      bb[0] = b0.x; bb[1] = b0.y; bb[2] = b0.z; bb[3] = b0.w; bb[4] = b1.x; bb[5] = b1.y; bb[6] = b1.z; bb[7] = b1.w; }
#pragma unroll 1
    for (int hb = 0; hb < 2; ++hb) {
        u32x4 raw[8]; float s[8], q[8];
#pragma unroll
        for (int i = 0; i < 8; ++i) raw[i] = *(const u32x4*)(Z + (m0 + 16 * w + 8 * hb + i) * ZW + 512 + 8 * lane);
#pragma unroll
        for (int i = 0; i < 8; ++i) s[i] = ((bflo(raw[i].x) + bfhi(raw[i].x)) + (bflo(raw[i].y) + bfhi(raw[i].y))) + ((bflo(raw[i].z) + bfhi(raw[i].z)) + (bflo(raw[i].w) + bfhi(raw[i].w)));
#pragma unroll
        for (int o = 1; o < 64; o <<= 1) {
#pragma unroll
            for (int i = 0; i < 8; ++i) s[i] += shx_l(s[i], o, lane); }
#pragma unroll
        for (int i = 0; i < 8; ++i) { const float mean = s[i] * (1.f / 512.f); s[i] = mean;
            const float v[8] = {bflo(raw[i].x) - mean, bfhi(raw[i].x) - mean, bflo(raw[i].y) - mean, bfhi(raw[i].y) - mean, bflo(raw[i].z) - mean, bfhi(raw[i].z) - mean, bflo(raw[i].w) - mean, bfhi(raw[i].w) - mean};
            float a2 = 0.f;
#pragma unroll
            for (int j = 0; j < 8; ++j) a2 += v[j] * v[j];
            q[i] = a2; }
#pragma unroll
        for (int o = 1; o < 64; o <<= 1) {
#pragma unroll
            for (int i = 0; i < 8; ++i) q[i] += shx_l(q[i], o, lane); }
#pragma unroll
        for (int i = 0; i < 8; ++i) { const float mean = s[i], rstd = 1.f / sqrtf(q[i] * (1.f / 512.f) + LN_EPS);
            float v[8] = {bflo(raw[i].x), bfhi(raw[i].x), bflo(raw[i].y), bfhi(raw[i].y), bflo(raw[i].z), bfhi(raw[i].z), bflo(raw[i].w), bfhi(raw[i].w)};
#pragma unroll
            for (int j = 0; j < 8; ++j) v[j] = (v[j] - mean) * rstd * gg[j] + bb[j];
            u32x4 o; o.x = pk2(v[0], v[1]); o.y = pk2(v[2], v[3]); o.z = pk2(v[4], v[5]); o.w = pk2(v[6], v[7]);
            *(LAS u32x4*)(lds + (16 * w + 8 * hb + i) * SG_PITCH + lane * 16) = o; }
    }
    __syncthreads();
    const int g = w >> 1, th = w & 1;
    bf16x8 wf[4][4];
#pragma unroll
    for (int tt = 0; tt < 4; ++tt) { const bf16* wr_ = SW + (size_t)g * 128 * 128 + (size_t)(16 * (4 * th + tt) + q16) * 128;
#pragma unroll
        for (int ks = 0; ks < 4; ++ks) { const u32x2 a = *(const u32x2*)(wr_ + 32 * ks + 4 * kq), b = *(const u32x2*)(wr_ + 32 * ks + 16 + 4 * kq);
            wf[tt][ks] = __builtin_bit_cast(bf16x8, (u32x4){a.x, a.y, b.x, b.y}); } }
    const LAS unsigned char* vb = lds + (4 * kq + (q16 >> 2)) * SG_PITCH + g * 256 + (q16 & 3) * 8;
    float bias4[4];
#pragma unroll
    for (int tt = 0; tt < 4; ++tt) bias4[tt] = bs[g * 128 + 16 * (4 * th + tt) + q16];
    u32x2 uu[4], un[4];
#pragma unroll
    for (int tt = 0; tt < 4; ++tt) uu[tt] = *(const u32x2*)(Z + (m0 + 16 * (4 * th + tt) + q16) * ZW + g * 128 + 4 * kq);
#pragma unroll 1
    for (int dt = 0; dt < 8; ++dt) {
        f32x4 acc[4];
#pragma unroll
        for (int tt = 0; tt < 4; ++tt) acc[tt] = (f32x4){0.f, 0.f, 0.f, 0.f};
        if (dt < 7) {
#pragma unroll
            for (int tt = 0; tt < 4; ++tt) un[tt] = *(const u32x2*)(Z + (m0 + 16 * (4 * th + tt) + q16) * ZW + g * 128 + 16 * (dt + 1) + 4 * kq);
        }
#pragma unroll
        for (int ks = 0; ks < 4; ++ks) {
            const s16x4 lo = __builtin_bit_cast(s16x4, __builtin_amdgcn_ds_read_tr16_b64_v4i16((LAS s16x4*)(vb + (32 * ks) * SG_PITCH + dt * 32)));
            const s16x4 hi = __builtin_bit_cast(s16x4, __builtin_amdgcn_ds_read_tr16_b64_v4i16((LAS s16x4*)(vb + (32 * ks + 16) * SG_PITCH + dt * 32)));
            const bf16x8 af = __builtin_shufflevector(lo, hi, 0, 1, 2, 3, 4, 5, 6, 7);
#pragma unroll
            for (int tt = 0; tt < 4; ++tt) acc[tt] = __builtin_amdgcn_mfma_f32_16x16x32_bf16(af, wf[tt][ks], acc[tt], 0, 0, 0);
        }
#pragma unroll
        for (int tt = 0; tt < 4; ++tt) {
            const int t = 16 * (4 * th + tt) + q16;
            const float bias = bias4[tt];
            bf16* up = Z + (m0 + t) * ZW + g * 128 + 16 * dt + 4 * kq;
            const float o0 = bflo(uu[tt].x) * (acc[tt].x + bias), o1 = bfhi(uu[tt].x) * (acc[tt].y + bias), o2 = bflo(uu[tt].y) * (acc[tt].z + bias), o3 = bfhi(uu[tt].y) * (acc[tt].w + bias);
            *(u32x2*)up = (u32x2){pk2(o0, o1), pk2(o2, o3)};
        }
#pragma unroll
        for (int tt = 0; tt < 4; ++tt) uu[tt] = un[tt];
    }
    __syncthreads();
}

__device__ __forceinline__ void dil_combine(const Frame& F, const bf16* QKV, const float* LSE, bf16* OC) {
    const int lane = vlaunder(LANE_), hh = lane >> 4;
    for (int m = F.gw; m < M; m += F.NGW) {
        const float l0 = LSE[((size_t)0 * M + m) * 4 + hh], l1 = LSE[((size_t)1 * M + m) * 4 + hh], l2 = LSE[((size_t)2 * M + m) * 4 + hh];
        const float mx = fmaxf(l0, fmaxf(l1, l2));
        float w0 = __expf(l0 - mx), w1 = __expf(l1 - mx), w2 = __expf(l2 - mx);
        const float inv = 1.0f / (w0 + w1 + w2); w0 *= inv; w1 *= inv; w2 *= inv;
        const bf16* qr = QKV + (size_t)m * QKVW + hh * 128 + (lane & 15) * 8;
        const u32x4 a = *(const u32x4*)qr, b = *(const u32x4*)(qr + 512), c = *(const u32x4*)(qr + 1024);
        u32x4 o;
        o.x = pk2(w0 * bflo(a.x) + w1 * bflo(b.x) + w2 * bflo(c.x), w0 * bfhi(a.x) + w1 * bfhi(b.x) + w2 * bfhi(c.x));
        o.y = pk2(w0 * bflo(a.y) + w1 * bflo(b.y) + w2 * bflo(c.y), w0 * bfhi(a.y) + w1 * bfhi(b.y) + w2 * bfhi(c.y));
        o.z = pk2(w0 * bflo(a.z) + w1 * bflo(b.z) + w2 * bflo(c.z), w0 * bfhi(a.z) + w1 * bfhi(b.z) + w2 * bfhi(c.z));
        o.w = pk2(w0 * bflo(a.w) + w1 * bflo(b.w) + w2 * bflo(c.w), w0 * bfhi(a.w) + w1 * bfhi(b.w) + w2 * bfhi(c.w));
        *(u32x4*)(OC + (size_t)m * 512 + hh * 128 + (lane & 15) * 8) = o;
    }
}

struct Args { const float* in[22]; float* out; unsigned char* ws; };
#define GEMM_CALL(EPI, E, Aptr, LDA, Bptr, MM, NN, KK) do { pg8::Gemm g_{(Aptr), (Bptr), (LDA), (MM), (NN), (KK)}; pg8::StaticOrder S_; S_.init((MM), (NN), F.G, (int)blockIdx.x); \
        pg8::gemm_phase<EPI, pg8::StaticOrder, true, true>(F.lds, g_, S_, (E)); } while (0)

#define GEMM_CALL_REV(EPI, E, Aptr, LDA, Bptr, MM, NN, KK) do { pg8::Gemm g_{(Aptr), (Bptr), (LDA), (MM), (NN), (KK)}; pg8::RevOrder S_; S_.init((MM), (NN), F.G, (int)blockIdx.x); \
        pg8::gemm_phase<EPI, pg8::RevOrder, true, true>(F.lds, g_, S_, (E)); } while (0)

__global__ void __launch_bounds__(NTHR, 2) fwd_kernel(Args args) {
    extern __shared__ __attribute__((aligned(16))) unsigned char lds_raw[];
    Frame F;
    F.lds = (LAS unsigned char*)lds_raw;
    F.wave = __builtin_amdgcn_readfirstlane(TID_ >> 6);
    F.G = gridDim.x; { const int bx = blockIdx.x; F.vcu = (F.G % 8 == 0) ? (bx % 8) * (F.G / 8) + bx / 8 : bx; }
    F.gw = F.vcu * NWAVES + F.wave; F.NGW = F.G * NWAVES;
    F.ws = args.ws; F.ctl = (gu32*)(args.ws + WS_CTL); F.out = args.out;
    volatile LAS unsigned* MISC = (volatile LAS unsigned*)(F.lds + MISC_OFF);
    for (int u = TID_; u < (LDS_BYTES - LDSCTL_OFF) / 4; u += NTHR) ((LAS unsigned*)(F.lds + LDSCTL_OFF))[u] = 0u;
    __syncthreads();
    if (TID_ < 22) *(LAS unsigned long long*)(F.lds + PTR_OFF + 8 * TID_) = (unsigned long long)args.in[TID_];
    __syncthreads();
    XcdBarrier bar = xcd_barrier_post((unsigned*)(F.ctl + CW_BAR), MISC + 8);
#define GRID_BAR() xcd_barrier(bar)
#ifndef TP
#define TP 0
#endif
#define TPW ((LAS unsigned long long*)(F.lds + LDSCTL_OFF + 768))
#define PB(id) do { if (TP == (id) && TID_ == 0) TPW[0] = __builtin_amdgcn_s_memrealtime(); } while (0)
#define PE(id) do { if (TP == (id) && TID_ == 0) TPW[1] += __builtin_amdgcn_s_memrealtime() - TPW[0]; } while (0)

#define WSL ws_launder(F.ws)
#define XB ((bf16*)(WSL + WS_XB))
#define HB ((bf16*)(WSL + R_H))
#define cosT ((const float*)(WSL + TAB_COS))
#define sinT ((const float*)(WSL + TAB_SIN))
#define ZLO ((bf16*)(F.out + szero()))
#define ZL2 ((bf16*)(WSL + R_KVM))
#define ZLAST ((bf16*)(WSL + R_QM))
#define CQ ((bf16*)(WSL + R_CQ))
#define CKV ((bf16*)(WSL + R_CKV))
#define ZB ((bf16*)(WSL + R_Z))
#define QKV ((bf16*)(WSL + R_QKV))
#define KPE ((bf16*)(WSL + R_KPE))
#define QM ((bf16*)(WSL + R_QM))
#define KVM ((bf16*)(WSL + R_KVM))
#define OA ((bf16*)(WSL + R_OA))
#define OC ((bf16*)(WSL + R_OC))
#define GATE01 ((unsigned char*)(F.out + szero()) + 2 * GATE_PLANE)
#define GATE2 ((unsigned char*)(WSL + R_GATE2))
#define MG ((bf16*)(WSL + R_MERGED))
#define KVX ((bf16*)(WSL + WS_KVX))
#define QX ((bf16*)(WSL + R_QX))
#define OX ((bf16*)(WSL + R_OX))
#define LSE ((float*)(WSL + WS_LSE))
#define WP(off) ((bf16*)(WSL + (off)))
#define ssq_q ((float*)(WSL + CTL_SSQ) + (size_t)(l * 2 + 0) * M)
#define ssq_kv ((float*)(WSL + CTL_SSQ) + (size_t)(l * 2 + 1) * M)
#define STATS(site) ((float*)(WSL + CTL_STATS) + (size_t)(site) * M * 2)
#define SNP(off) ((const float*)(WSL + CTL_SNT) + (size_t)l * 2 * SNT_N + (off))
#define LNG(site) (INP(2) + (size_t)(site) * D)
#define LNB(site) (INP(3) + (size_t)(site) * D)
#define LNFOLD(site, off) LnFold{STATS(site), SNP(off), SNP(off) + SNT_N}
#define NOLN LnFold{nullptr, nullptr, nullptr}

    for (int l = 0; l < DEPTH; ++l) {
        PB(10); p0_prologue(F, l);
        GRID_BAR(); PE(10);
        for (int f = 0; f < 2; ++f) {
            if (f == 1) {
                PB(6); { EpiWinGate E{EpiWin{CQ, CKV, ZB, QKV, KPE, ssq_q, ssq_kv, cosT, sinT, LNFOLD(l * 4 + 0, SNT_WIN)}, EpiGate8{GATE01, GATE2, LNFOLD(l * 4 + 0, SNT_GATE)}};
                  GEMM_CALL(EpiWinGate, E, XB, D, WP(W_IN), M, NWIN + NGATE, D); }
                if ((int)blockIdx.x >= F.G / 2) { EpiBf<0> E{KVX, 1024, nullptr, nullptr, nullptr, NOLN}; pg8::Gemm g_{WP(WS_MEMB), WP(W_XKV), D, BATCH * MEM, 1024, D}; pg8::StaticOrder S_; S_.init(BATCH * MEM, 1024, F.G / 2, (int)blockIdx.x - F.G / 2);
                    pg8::gemm_phase<EpiBf<0>, pg8::StaticOrder, true, true>(F.lds, g_, S_, E); }
                GRID_BAR(); PE(6);
                PB(4); { EpiBf<2> E{QM, QW, ssq_q, cosT, sinT, NOLN}; GEMM_CALL(EpiBf<2>, E, CQ, 512, WP(W_UQ), M, QW, 512); }
                { EpiBf<1> E{KVM, KVW, ssq_kv, nullptr, nullptr, NOLN}; GEMM_CALL(EpiBf<1>, E, CKV, 512, WP(W_UKV), M, KVW, 512); }
                PB(25); for (int u = blockIdx.x; u < BATCH * 16; u += F.G)
                    sgu_unit(F, ZB, INP(12) + l * 512, INP(13) + l * 512, WP(TAB_SGUW), INP(15) + l * 512, u); PE(25);
                for (int u0 = blockIdx.x; u0 < 3 * BATCH * 16 * 4; u0 += 2 * F.G) {
                    const int u = u0 + (F.wave >> 2) * F.G;
                    const int hh = u & 3, blk = (u >> 2) & 15, b = (u >> 6) & 15, g = u >> 10;
                    const int dil = g == 0 ? 1 : (g == 1 ? 4 : 16), nb = 16 / dil;
                    const int r = blk / nb, n = blk - r * nb;
                    LAS float* bl = (LAS float*)(F.lds + AT_BIAS);
                    { const int t_ = vlaunder(TID_); if (t_ < BIAS_STRIDE) bl[t_] = ((const float*)(WSL + TAB_BIAS))[(g * 4 + hh) * BIAS_STRIDE + t_]; }
                    DilSrc src{QKV, LSE + (size_t)g * M * 4 + hh, (size_t)b * SEQ, dil, r, n, (4 * g + hh) * 128};
                    DilMsk msk{bl, 0.08838834764831845f * LOG2E};
                    attn_unit<128, 2, 4>(F, src, msk, n == 0 ? 2 : 0, 4);
                }
                GRID_BAR(); PE(4);
                PB(5); PB(18); for (int u = blockIdx.x; u < BATCH * 8 * 8; u += F.G) {
                    const int c = (F.G == 256) ? F.vcu : u % F.G, i = u / F.G;
                    int bh, qb;
                    if (F.G == 256) { bh = 2 * (c >> 2) + (i & 1); qb = (i >> 1) ? 7 - (c & 3) : (c & 3); } else { bh = u >> 3; qb = u & 7; }
                    const int b = bh >> 3, h = bh & 7;
                    MlaSrc src{QM, KVM, KPE, OA, (size_t)b * SEQ, h, qb * 256};
                    MlaMsk msk{qb * 256, 0.07216878364870322f * LOG2E};
                    attn_unit<192, 2, 8>(F, src, msk, 0, (qb + 1) * 4);
                }
                PE(18); PB(19); dil_combine(F, QKV, LSE, OC); PE(19);
                GRID_BAR(); PE(5);
                PB(2); { EpiMerge E{GATE01, GATE2, MG}; pg8::Gemm g_{nullptr, WP(W_PA), D, M, D, D}; pg8::ASeg3 AS_{OA, ZB, OC, 1024, 512, 16, 24};
                  pg8::StaticOrder S_; S_.init(M, D, F.G, (int)blockIdx.x); pg8::gemm_phase_seg<EpiMerge, pg8::StaticOrder, true, pg8::ASeg3>(F.lds, g_, AS_, S_, E); }
                GRID_BAR(); PE(2);
                PB(3); { EpiResidLn E{nullptr, XB, ZLO, ZLO, STATS(l * 4 + 0), LNG(l * 4 + 0), LNB(l * 4 + 0), STATS(l * 4 + 1), ALPHA, 1.0f}; GEMM_CALL(EpiResidLn, E, MG, D, WP(W_OUT), M, D, D); }
                GRID_BAR(); PE(3);
                { EpiBf<0> E{QX, 512, nullptr, nullptr, nullptr, LNFOLD(l * 4 + 1, SNT_XQ)}; GEMM_CALL(EpiBf<0>, E, XB, D, WP(W_XQ), M, 512, D); }
                GRID_BAR();
                for (int u = F.vcu; u < BATCH * 4 * 8; u += F.G) {
                    const int qb = u & 7, h = (u >> 3) & 3, b = u >> 5;
                    XaSrc src{QX, KVX, OX, (size_t)b * SEQ, (size_t)b * MEM, h, qb * 256};
                    XaMsk msk{0.08838834764831845f * LOG2E};
                    attn_unit<128, 2, 8>(F, src, msk, 0, 4);
                }
                GRID_BAR();
                { EpiResidLn E{nullptr, XB, ZLO, (l == DEPTH - 1) ? ZL2 : ZLO, STATS(l * 4 + 1), LNG(l * 4 + 1), LNB(l * 4 + 1), STATS(l * 4 + 2), ALPHA, 1.0f}; GEMM_CALL(EpiResidLn, E, OX, 512, WP(W_XO), M, D, 512); }
                GRID_BAR();
            }
            const int site_in = f ? l * 4 + 2 : l * 4 - 1, site_out = f ? l * 4 + 3 : l * 4;
            const bool raw_in = (l == 0 && f == 0);
            if (TP == 12 || TP == 13) {
                PG8_LAS unsigned long long* st_ = (PG8_LAS unsigned long long*)(F.lds + LDSCTL_OFF + 1024); if (TID_ == 0) st_[0] = (unsigned long long)(unsigned)vlaunder(0); __syncthreads();
                { EpiSwiglu E{HB, raw_in ? NOLN : LNFOLD(site_in, f ? SNT_FFN1 : SNT_FFN0)}; pg8::Gemm g_{XB, WP(f ? W_GU1 : W_GU0), D, M, 2 * FF, D}; pg8::ProbeOrder S_; S_.init(M, 2 * FF, F.G, (int)blockIdx.x); S_.st = st_;
                  pg8::gemm_phase<EpiSwiglu, pg8::ProbeOrder, true, true>(F.lds, g_, S_, E); }
                if (TID_ == 0) TPW[1] += (TP == 12) ? st_[1 + 6] - st_[1 + 0] : st_[1 + 20] - st_[1 + 14];
            } else {
            PB(7); { EpiSwiglu E{HB, raw_in ? NOLN : LNFOLD(site_in, f ? SNT_FFN1 : SNT_FFN0)}; GEMM_CALL(EpiSwiglu, E, XB, D, WP(f ? W_GU1 : W_GU0), M, 2 * FF, D); } }
            GRID_BAR(); PE(7);
            if (TP == 14 || TP == 15) {
                PG8_LAS unsigned long long* st_ = (PG8_LAS unsigned long long*)(F.lds + LDSCTL_OFF + 1024); if (TID_ == 0) st_[0] = (unsigned long long)(unsigned)vlaunder(0); __syncthreads();
                { EpiResidLn E{raw_in ? INP(0) : nullptr, XB, ZLO, (l == DEPTH - 1 && f == 1) ? ZLAST : ZLO, STATS(raw_in ? 0 : site_in), LNG(raw_in ? 0 : site_in), LNB(raw_in ? 0 : site_in), STATS(site_out), ALPHA, 0.5f};
                  pg8::Gemm g_{HB, WP(f ? W_D1 : W_D0), FF_LD, M, D, FF}; pg8::ProbeOrder S_; S_.init(M, D, F.G, (int)blockIdx.x); S_.st = st_;
                  pg8::gemm_phase<EpiResidLn, pg8::ProbeOrder, true, true>(F.lds, g_, S_, E); }
                if (TID_ == 0) TPW[1] += (TP == 14) ? st_[1 + 2] - st_[1 + 0] : st_[1 + 3] - st_[1 + 2];
            } else {
            const bool lastseam = (l == DEPTH - 1 && f == 1);
            if (lastseam && F.G == 256) {
                EpiResidLnFinal E{XB, ZL2, STATS(site_in), LNG(site_in), LNB(site_in), STATS(site_out), (unsigned*)(F.ctl + CW_PCNT), INP(2) + (size_t)7 * D, INP(3) + (size_t)7 * D, F.out + szero(), ALPHA, 0.5f};
                pg8::Gemm g_{HB, WP(W_D1), FF_LD, M, D, FF}; pg8::RevOrder S_; S_.init(M, D, F.G, (int)blockIdx.x); pg8::gemm_phase<EpiResidLnFinal, pg8::RevOrder, true, true>(F.lds, g_, S_, E);
            } else {
            PB(8); { EpiResidLn E{raw_in ? INP(0) : nullptr, XB, lastseam ? ZL2 : ZLO, lastseam ? ZLAST : ZLO, STATS(raw_in ? 0 : site_in), LNG(raw_in ? 0 : site_in), LNB(raw_in ? 0 : site_in), STATS(site_out), ALPHA, 0.5f};
                pg8::Gemm g_{HB, WP(f ? W_D1 : W_D0), FF_LD, M, D, FF}; pg8::RevOrder S_; S_.init(M, D, F.G, (int)blockIdx.x); pg8::gemm_phase<EpiResidLn, pg8::RevOrder, true, true>(F.lds, g_, S_, E); }
            GRID_BAR(); PE(8); } }
            if (TP == 16 || TP == 17) {
                PG8_LAS unsigned long long* st_ = (PG8_LAS unsigned long long*)(F.lds + LDSCTL_OFF + 1024); if (TID_ == 0) st_[0] = (unsigned long long)(unsigned)vlaunder(0); __syncthreads();
                for (int pass_ = 0; pass_ < 2; ++pass_) {
                    EpiBf<0> E{(bf16*)(F.ws + R_KVM + 32 * MiB + szero()), D, nullptr, nullptr, nullptr, NOLN}; pg8::Gemm g_{HB, WP(f ? W_D1 : W_D0), FF_LD, 16384, D, FF}; pg8::ProbeOrder S_; S_.init(16384, D, F.G, (int)blockIdx.x); S_.st = st_;
                    pg8::gemm_phase<EpiBf<0>, pg8::ProbeOrder, true, true>(F.lds, g_, S_, E); GRID_BAR();
                }
                if (TID_ == 0) TPW[1] += (TP == 16) ? st_[1 + 1] - st_[1 + 0] : st_[1 + 3] - st_[1 + 2];
            }
        }
    }
    if (F.G != 256) ln_final(F, XB, ZLAST, F.out + szero(), INP(2) + (size_t)7 * D, INP(3) + (size_t)7 * D);
    if (TP > 0 && blockIdx.x == 0 && TID_ == 0) { const unsigned long long t0 = __builtin_amdgcn_s_memrealtime(); const unsigned long long w_ = 4ull * TPW[1]; while (__builtin_amdgcn_s_memrealtime() - t0 < w_) __builtin_amdgcn_s_sleep(8); }

}

extern "C" void kernel_launch(void* const* d_in, const int* in_sizes, int n_in, void* d_out, int out_size, void* d_ws, size_t ws_size, hipStream_t stream) {
    static int grid = 0;
    if (grid == 0) {
        if (n_in != 22 || in_sizes[0] != M * D || out_size != M * D || ws_size < WS_NEED) {
            fprintf(stderr, "kernel_launch: unexpected problem: n_in %d in0 %d out %d ws %zu (need %zu); nothing launched\n", n_in, n_in > 0 ? in_sizes[0] : -1, out_size, ws_size, (size_t)WS_NEED); grid = -1; return; }
        int dev = 0, cus = 0, per_cu = 0;
        if (hipGetDevice(&dev) != hipSuccess || hipDeviceGetAttribute(&cus, hipDeviceAttributeMultiprocessorCount, dev) != hipSuccess) { grid = -1; return; }
        if (hipFuncSetAttribute((const void*)fwd_kernel, hipFuncAttributeMaxDynamicSharedMemorySize, LDS_BYTES) != hipSuccess) { fprintf(stderr, "kernel_launch: hipFuncSetAttribute failed\n"); grid = -1; return; }
        if (hipOccupancyMaxActiveBlocksPerMultiprocessor(&per_cu, (const void*)fwd_kernel, NTHR, LDS_BYTES) != hipSuccess || per_cu < 1)
            fprintf(stderr, "kernel_launch: note: occupancy query reports %d workgroups per CU\n", per_cu);
        (void)hipGetLastError();
        if (cus != 256) { fprintf(stderr, "kernel_launch: built for a 256-CU device (unit deals and the paired dilated-attention units assume 256 workgroups), found %d CUs; nothing launched\n", cus); grid = -1; return; }
        grid = cus;
    }
    if (grid < 0) return;
    if (hipMemsetAsync((char*)d_ws + WS_CTL, 0, CTL_ZERO_BYTES, stream) != hipSuccess) return;
    Args a{};
    for (int i = 0; i < 22; ++i) a.in[i] = (const float*)d_in[i];
    a.out = (float*)d_out; a.ws = (unsigned char*)d_ws;
    hipLaunchKernelGGL(fwd_kernel, dim3(grid), dim3(NTHR), LDS_BYTES, stream, a);
    const hipError_t le = hipPeekAtLastError();
    if (le != hipSuccess) fprintf(stderr, "kernel_launch: launch failed: %s\n", hipGetErrorName(le));
}
```

```cpp
#include <hip/hip_runtime.h>
#include <cstdio>
#include <cstdint>

namespace pg8 {
#define PG8_LAS __attribute__((address_space(3)))
typedef unsigned short bf16_t;
typedef short bf16x8 __attribute__((ext_vector_type(8)));
typedef float f32x4 __attribute__((ext_vector_type(4)));
typedef float f32x2 __attribute__((ext_vector_type(2)));
typedef unsigned u32x4 __attribute__((ext_vector_type(4)));
typedef unsigned u32x2 __attribute__((ext_vector_type(2)));
constexpr int BM = 256, BK = 64, HALF = 128, HTB = HALF * BK * 2  , STAGE_BYTES = 8 * HTB, NXCD = 8, WGM = 8;

__host__ __device__ __forceinline__ int lds_byte(int r, int c) { const int st = (r >> 4) * 2 + (c >> 5), rr = r & 15, cc = c & 31, ob = rr * 64 + cc * 2; return st * 1024 + (ob ^ (((ob >> 9) & 1) << 5)); }
__host__ __device__ __forceinline__ void stage_rc(int b, int& R, int& C) { const int st = b / 1024, sb = b % 1024, swz = sb ^ (((sb >> 9) & 1) << 5); R = (st >> 1) * 16 + swz / 64; C = (st & 1) * 32 + (swz % 64) / 2; }
__host__ __device__ __forceinline__ int perm32(int rho) { const int n = rho >> 4, i = rho & 15; return 8 * (i >> 2) + 4 * n + (i & 3); }

struct Unit { int pm, pn; };
struct Gemm { const bf16_t* A; const bf16_t* Bt; int lda, M, N, K; };

struct ASeg3 {
    const bf16_t* A0; const bf16_t* A1; const bf16_t* A2; int lda0, lda1, t1, t2;
    __device__ __forceinline__ const char* base(int pm, int tile) const {
        return tile < t1 ? (const char*)A0 + (size_t)pm * 512 * lda0 + (size_t)tile * 128
             : tile < t2 ? (const char*)A1 + (size_t)pm * 512 * lda0 + (size_t)(tile - t1) * 128
                         : (const char*)A2 + (size_t)pm * 512 * lda1 + (size_t)(tile - t2) * 128; }
    __device__ __forceinline__ size_t hstep(int tile) const { return (size_t)256 * (tile < t2 ? lda0 : lda1); }
    __device__ __forceinline__ bool sel(int tile) const { return tile >= t2; }
};
struct StaticOrder {
    int nM, nN, nwg, G, c, wgm;
    __host__ __device__ void init(int M, int N, int G_, int c_) { nM = M / BM; nN = N / BM; nwg = nM * nN; G = G_; c = c_; wgm = (nN == 8) ? 4 : WGM; }
    __host__ __device__ bool next(int i, Unit& u) const {
        const long L = (long)i * G + c; if (L >= nwg) return false;
        int wgid = (int)L; { const int q = nwg / NXCD, r = nwg % NXCD, xcd = wgid % NXCD, off = wgid / NXCD; wgid = (xcd < r ? xcd * (q + 1) : r * (q + 1) + (xcd - r) * q) + off; }
        const int nig = wgm * nN, gid = wgid / nig, fm = gid * wgm, gsz = (nM - fm) < wgm ? (nM - fm) : wgm;
        u.pm = fm + ((wgid % nig) % gsz); u.pn = (wgid % nig) / gsz; return true;
    }
    __device__ __forceinline__ void a_ready(const Unit&) const {}
    __device__ __forceinline__ void done(const Unit&) const {}
};

struct GateOrder {
    StaticOrder base;
    __device__ bool next(int i, Unit& u) const { Unit t; if (!base.next(i / 3, t)) return false; u.pm = t.pm; u.pn = t.pn + 8 * (i % 3); return true; }
    __device__ __forceinline__ void a_ready(const Unit&) const {}
    __device__ __forceinline__ void done(const Unit&) const {}
};
struct RevOrder {
    StaticOrder base; int nr;
    __device__ void init(int M, int N, int G_, int c_) { base.init(M, N, G_, c_); nr = (base.nwg + G_ - 1) / G_; if ((nr - 1) * G_ + c_ >= base.nwg) --nr; }
    __device__ bool next(int i, Unit& u) const { if (i >= nr) return false; return base.next(nr - 1 - i, u); }
    __device__ __forceinline__ void a_ready(const Unit&) const {}
    __device__ __forceinline__ void done(const Unit&) const {}
};
struct ProbeOrder : StaticOrder {
    PG8_LAS unsigned long long* st;
    __device__ __forceinline__ void done(const Unit&) const { if (threadIdx.x == 0) { const unsigned long long k = st[0]; if (k < 30) st[1 + k] = __builtin_amdgcn_s_memrealtime(); st[0] = k + 1; } }
};
__device__ __forceinline__ unsigned cvt_pk_bf16(float lo, float hi) { unsigned r; asm volatile("v_cvt_pk_bf16_f32 %0, %1, %2" : "=v"(r) : "v"(lo), "v"(hi)); return r; }
__device__ __forceinline__ f32x2 gelu_pk(f32x2 v) {
    const f32x2 av = __builtin_elementwise_abs(v), d = av * 0.2316418882f + 1.0f;
    f32x2 t; t.x = __builtin_amdgcn_rcpf(d.x); t.y = __builtin_amdgcn_rcpf(d.y);
    f32x2 q = t * 0.5307027145f + (-0.7265760135f); q = q * t + 0.7107068705f; q = q * t + (-0.142248368f); q = q * t + 0.127414796f; q = q * t;
    const f32x2 s = (v * v) * (-0.72134752044f);
    f32x2 e; e.x = __builtin_amdgcn_exp2f(s.x); e.y = __builtin_amdgcn_exp2f(s.y);
    const f32x2 m = v * (q * e), r = v - m;
    f32x2 o; o.x = v.x < 0.f ? m.x : r.x; o.y = v.y < 0.f ? m.y : r.y; return o;
}
template <class Epi, class Sched, bool ALIGN_EPI = false, bool SP2 = false>
__device__ __forceinline__ void gemm_phase(PG8_LAS unsigned char* lds, const Gemm g, const Sched& S, const Epi& E) {
    int tid_ = threadIdx.x; asm volatile("" : "+v"(tid_));
    const int tid = tid_, wid = __builtin_amdgcn_readfirstlane(tid >> 6), lane = tid & 63, wr = wid >> 2, wc = wid & 3, fr = lane & 15, fq = lane >> 4;
    const int K = g.K, nt = K / BK;
    unsigned voffA[2], voffB[2];
#pragma unroll
    for (int i = 0; i < 2; ++i) { int R, C; stage_rc(tid * 16 + i * 8192, R, C); const int Rb = Epi::PERM ? ((R & ~31) + perm32(R & 31)) : R;
        voffA[i] = (unsigned)(R * g.lda + C) * 2u; voffB[i] = (unsigned)(Rb * K + C) * 2u; }
    const size_t kstep = (size_t)(BK * 2);
    const size_t hstepB = (size_t)HALF * K * 2, hstepA = (size_t)HALF * g.lda * 2;
    const size_t tstepA = 2 * hstepA, tstepB = 2 * hstepB;
    const unsigned ldsw = (unsigned)wid * 1024u;
    const int aoff = lds_byte(wr * 64 + fr, fq * 8), boff = lds_byte(wc * 32 + fr, fq * 8);
#define PG8_SA(b, h) (((b) * 2 + (h)) * HTB)
#define PG8_SB(b, h) ((4 + (b) * 2 + (h)) * HTB)
#define PG8_STAGE(bufoff, gbase, voff) do { _Pragma("unroll") for (int _i = 0; _i < 2; ++_i) \
        __builtin_amdgcn_global_load_lds((const unsigned*)((const char*)(gbase) + (voff)[_i]), (PG8_LAS unsigned*)(lds + (bufoff) + ldsw + _i * 8192), 16, 0, 0); } while (0)
#define PG8_LDA(dst, b, h) do { _Pragma("unroll") for (int m = 0; m < 4; ++m) _Pragma("unroll") for (int k = 0; k < 2; ++k) dst[m][k] = *(const PG8_LAS bf16x8*)(lds + PG8_SA(b, h) + aoff + m * 2048 + k * 1024); } while (0)
#define PG8_LDB(dst, b, h) do { _Pragma("unroll") for (int n = 0; n < 2; ++n) _Pragma("unroll") for (int k = 0; k < 2; ++k) dst[n][k] = *(const PG8_LAS bf16x8*)(lds + PG8_SB(b, h) + boff + n * 2048 + k * 1024); } while (0)
#define PG8_MMA(ai, bj, At, Bt) do { __builtin_amdgcn_s_setprio(1); _Pragma("unroll") for (int m = 0; m < 4; ++m) _Pragma("unroll") for (int n = 0; n < 2; ++n) _Pragma("unroll") for (int k = 0; k < 2; ++k) \
        acc[ai][bj][m][n] = __builtin_amdgcn_mfma_f32_16x16x32_bf16(Bt[n][k], At[m][k], acc[ai][bj][m][n], 0, 0, 0); __builtin_amdgcn_s_setprio(0); } while (0)
#define PG8_WAIT_V(n) asm volatile("s_waitcnt vmcnt(" #n ")" ::: "memory")
#define PG8_WAIT_L(n) asm volatile("s_waitcnt lgkmcnt(" #n ")" ::: "memory")
#define PG8_BAR __builtin_amdgcn_s_barrier()
#define PG8_SCHED __builtin_amdgcn_sched_barrier(0)
    Unit cur, nxt; int ui = 0;
    if (!S.next(0, cur)) return;
    f32x4 acc[2][2][4][2];
#pragma unroll
    for (int a = 0; a < 2; ++a)
#pragma unroll
        for (int b = 0; b < 2; ++b)
#pragma unroll
            for (int m = 0; m < 4; ++m)
#pragma unroll
                for (int n = 0; n < 2; ++n) acc[a][b][m][n] = (f32x4){0.f, 0.f, 0.f, 0.f};
    bf16x8 At[4][2], B0[2][2], B1[2][2];
    const char* cA = (const char*)g.A + (size_t)cur.pm * tstepA; const char* cB = (const char*)g.Bt + (size_t)cur.pn * tstepB;
    S.a_ready(cur);
    if constexpr (SP2) {
        PG8_STAGE(PG8_SB(0, 0), cB, voffB); PG8_STAGE(PG8_SB(0, 1), cB + hstepB, voffB); PG8_STAGE(PG8_SA(0, 0), cA, voffA); PG8_STAGE(PG8_SA(0, 1), cA + hstepA, voffA);
        if (wr == 1) PG8_BAR;
        PG8_WAIT_V(2); PG8_BAR;
        PG8_STAGE(PG8_SB(1, 0), cB + kstep, voffB); PG8_STAGE(PG8_SA(1, 0), cA + kstep, voffA); PG8_STAGE(PG8_SB(1, 1), cB + hstepB + kstep, voffB);
        PG8_WAIT_V(6); PG8_BAR;
    } else {
        PG8_STAGE(PG8_SB(0, 0), cB, voffB); PG8_STAGE(PG8_SA(0, 0), cA, voffA); PG8_STAGE(PG8_SB(0, 1), cB + hstepB, voffB); PG8_STAGE(PG8_SA(0, 1), cA + hstepA, voffA);
        if (wr == 1) PG8_BAR;
        PG8_WAIT_V(4); PG8_BAR;
        PG8_STAGE(PG8_SB(1, 0), cB + kstep, voffB); PG8_STAGE(PG8_SA(1, 0), cA + kstep, voffA); PG8_STAGE(PG8_SB(1, 1), cB + hstepB + kstep, voffB);
        PG8_WAIT_V(6); PG8_BAR;
    }
    for (;;) {
        const bool has_next = S.next(ui + 1, nxt);
        const char* nA = has_next ? (const char*)g.A + (size_t)nxt.pm * tstepA : cA; const char* nB = has_next ? (const char*)g.Bt + (size_t)nxt.pn * tstepB : cB;
        for (int t = 0; t < nt; t += 2) {
            const bool last = (t == nt - 2);
            const char* a1 = cA + (size_t)(t + 1) * kstep;
            const char* a2 = last ? nA : cA + (size_t)(t + 2) * kstep; const char* b2 = last ? nB : cB + (size_t)(t + 2) * kstep;
            const char* a3 = a2 + kstep; const char* b3 = b2 + kstep;
            if (last && has_next) S.a_ready(nxt);
            if constexpr (SP2) {
            PG8_LDB(B0, 0, 0); PG8_LDB(B1, 0, 1); PG8_SCHED; PG8_LDA(At, 0, 0); PG8_STAGE(PG8_SA(1, 1), a1 + hstepA, voffA);
            PG8_WAIT_V(8); PG8_WAIT_L(0); PG8_BAR; PG8_MMA(0, 0, At, B0); PG8_MMA(0, 1, At, B1); PG8_BAR; PG8_SCHED;
            PG8_LDA(At, 0, 1); PG8_STAGE(PG8_SB(0, 0), b2, voffB); PG8_STAGE(PG8_SB(0, 1), b2 + hstepB, voffB); PG8_STAGE(PG8_SA(0, 0), a2, voffA);
            PG8_WAIT_V(8); PG8_WAIT_L(0); PG8_BAR; PG8_MMA(1, 0, At, B0); PG8_MMA(1, 1, At, B1); PG8_BAR; PG8_SCHED;
            PG8_LDB(B0, 1, 0); PG8_LDB(B1, 1, 1); PG8_SCHED; PG8_LDA(At, 1, 0); PG8_STAGE(PG8_SA(0, 1), a2 + hstepA, voffA);
            PG8_WAIT_V(8); PG8_WAIT_L(0); PG8_BAR; PG8_MMA(0, 0, At, B0); PG8_MMA(0, 1, At, B1); PG8_BAR; PG8_SCHED;
            PG8_LDA(At, 1, 1); PG8_STAGE(PG8_SB(1, 0), b3, voffB); PG8_STAGE(PG8_SB(1, 1), b3 + hstepB, voffB); PG8_STAGE(PG8_SA(1, 0), a3, voffA);
            PG8_WAIT_V(8); PG8_WAIT_L(0); PG8_BAR; PG8_MMA(1, 0, At, B0); PG8_MMA(1, 1, At, B1); PG8_BAR; PG8_SCHED;
            } else {
            PG8_LDB(B0, 0, 0); PG8_SCHED; PG8_LDA(At, 0, 0); PG8_STAGE(PG8_SA(1, 1), a1 + hstepA, voffA);
            PG8_WAIT_L(8); PG8_BAR; PG8_WAIT_L(0); PG8_MMA(0, 0, At, B0); PG8_BAR; PG8_SCHED;
            PG8_LDB(B1, 0, 1); PG8_STAGE(PG8_SB(0, 0), b2, voffB);
            PG8_BAR; PG8_WAIT_L(0); PG8_MMA(0, 1, At, B1); PG8_BAR;
            PG8_LDA(At, 0, 1); PG8_STAGE(PG8_SA(0, 0), a2, voffA);
            PG8_BAR; PG8_WAIT_L(0); PG8_MMA(1, 0, At, B0); PG8_BAR; PG8_SCHED;
            PG8_STAGE(PG8_SB(0, 1), b2 + hstepB, voffB);
            PG8_WAIT_V(6); PG8_BAR; PG8_MMA(1, 1, At, B1); PG8_BAR;
            PG8_LDB(B0, 1, 0); PG8_SCHED; PG8_LDA(At, 1, 0); PG8_STAGE(PG8_SA(0, 1), a2 + hstepA, voffA);
            PG8_WAIT_L(8); PG8_BAR; PG8_WAIT_L(0); PG8_MMA(0, 0, At, B0); PG8_BAR; PG8_SCHED;
            PG8_LDB(B1, 1, 1); PG8_STAGE(PG8_SB(1, 0), b3, voffB);
            PG8_BAR; PG8_WAIT_L(0); PG8_MMA(0, 1, At, B1); PG8_BAR;
            PG8_LDA(At, 1, 1); PG8_STAGE(PG8_SA(1, 0), a3, voffA);
            PG8_BAR; PG8_WAIT_L(0); PG8_MMA(1, 0, At, B0); PG8_BAR; PG8_SCHED;
            PG8_STAGE(PG8_SB(1, 1), b3 + hstepB, voffB);
            PG8_WAIT_V(6); PG8_BAR; PG8_MMA(1, 1, At, B1); PG8_BAR;
            }
        }
        if constexpr (ALIGN_EPI) { if (wr == 0) PG8_BAR; }
        if constexpr (!Epi::AFTER_DRAIN) { E(acc, cur, wr, wc, fr, fq); S.done(cur); }
        if (!has_next) break;
#pragma unroll
        for (int a = 0; a < 2; ++a)
#pragma unroll
            for (int b = 0; b < 2; ++b)
#pragma unroll
                for (int m = 0; m < 4; ++m)
#pragma unroll
                    for (int n = 0; n < 2; ++n) acc[a][b][m][n] = (f32x4){0.f, 0.f, 0.f, 0.f};
        cur = nxt; cA = nA; cB = nB; ++ui;
        if constexpr (ALIGN_EPI) { if (wr == 1) PG8_BAR; }
    }
    PG8_WAIT_V(0);
    if constexpr (!ALIGN_EPI) { if (wr == 0) PG8_BAR; }
    PG8_BAR;
    if constexpr (Epi::AFTER_DRAIN) { E.fused(acc, cur, wr, wc, fr, fq, lds, wid, lane); S.done(cur); }
#undef PG8_SA
#undef PG8_SB
#undef PG8_STAGE
#undef PG8_LDA
#undef PG8_LDB
#undef PG8_MMA
#undef PG8_WAIT_V
#undef PG8_WAIT_L
#undef PG8_BAR
#undef PG8_SCHED
}
template <class Epi, class Sched, bool ALIGN_EPI, class ASrc>
__device__ __forceinline__ void gemm_phase_seg(PG8_LAS unsigned char* lds, const Gemm g, const ASrc AS, const Sched& S, const Epi& E) {
    constexpr bool SP2 = true;
    int tid_ = threadIdx.x; asm volatile("" : "+v"(tid_));
    const int tid = tid_, wid = __builtin_amdgcn_readfirstlane(tid >> 6), lane = tid & 63, wr = wid >> 2, wc = wid & 3, fr = lane & 15, fq = lane >> 4;
    const int K = g.K, nt = K / BK;
    unsigned voffA[2], voffA2[2], voffB[2];
#pragma unroll
    for (int i = 0; i < 2; ++i) { int R, C; stage_rc(tid * 16 + i * 8192, R, C); const int Rb = Epi::PERM ? ((R & ~31) + perm32(R & 31)) : R;
        voffA[i] = (unsigned)(R * AS.lda0 + C) * 2u; voffA2[i] = (unsigned)(R * AS.lda1 + C) * 2u; voffB[i] = (unsigned)(Rb * K + C) * 2u; }
    const size_t kstep = (size_t)(BK * 2);
    const size_t hstepB = (size_t)HALF * K * 2, tstepB = 2 * hstepB;
    const unsigned ldsw = (unsigned)wid * 1024u;
    const int aoff = lds_byte(wr * 64 + fr, fq * 8), boff = lds_byte(wc * 32 + fr, fq * 8);
#define PG8_SA(b, h) (((b) * 2 + (h)) * HTB)
#define PG8_SB(b, h) ((4 + (b) * 2 + (h)) * HTB)
#define PG8_STAGE(bufoff, gbase, voff) do { _Pragma("unroll") for (int _i = 0; _i < 2; ++_i) \
        __builtin_amdgcn_global_load_lds((const unsigned*)((const char*)(gbase) + (voff)[_i]), (PG8_LAS unsigned*)(lds + (bufoff) + ldsw + _i * 8192), 16, 0, 0); } while (0)
#define PG8_LDA(dst, b, h) do { _Pragma("unroll") for (int m = 0; m < 4; ++m) _Pragma("unroll") for (int k = 0; k < 2; ++k) dst[m][k] = *(const PG8_LAS bf16x8*)(lds + PG8_SA(b, h) + aoff + m * 2048 + k * 1024); } while (0)
#define PG8_LDB(dst, b, h) do { _Pragma("unroll") for (int n = 0; n < 2; ++n) _Pragma("unroll") for (int k = 0; k < 2; ++k) dst[n][k] = *(const PG8_LAS bf16x8*)(lds + PG8_SB(b, h) + boff + n * 2048 + k * 1024); } while (0)
#define PG8_MMA(ai, bj, At, Bt) do { __builtin_amdgcn_s_setprio(1); _Pragma("unroll") for (int m = 0; m < 4; ++m) _Pragma("unroll") for (int n = 0; n < 2; ++n) _Pragma("unroll") for (int k = 0; k < 2; ++k) \
        acc[ai][bj][m][n] = __builtin_amdgcn_mfma_f32_16x16x32_bf16(Bt[n][k], At[m][k], acc[ai][bj][m][n], 0, 0, 0); __builtin_amdgcn_s_setprio(0); } while (0)
#define PG8_WAIT_V(n) asm volatile("s_waitcnt vmcnt(" #n ")" ::: "memory")
#define PG8_WAIT_L(n) asm volatile("s_waitcnt lgkmcnt(" #n ")" ::: "memory")
#define PG8_BAR __builtin_amdgcn_s_barrier()
#define PG8_SCHED __builtin_amdgcn_sched_barrier(0)
    Unit cur, nxt; int ui = 0;
    if (!S.next(0, cur)) return;
    f32x4 acc[2][2][4][2];
#pragma unroll
    for (int a = 0; a < 2; ++a)
#pragma unroll
        for (int b = 0; b < 2; ++b)
#pragma unroll
            for (int m = 0; m < 4; ++m)
#pragma unroll
                for (int n = 0; n < 2; ++n) acc[a][b][m][n] = (f32x4){0.f, 0.f, 0.f, 0.f};
    bf16x8 At[4][2], B0[2][2], B1[2][2];
    const char* cB = (const char*)g.Bt + (size_t)cur.pn * tstepB;
    S.a_ready(cur);
    if constexpr (SP2) {
        PG8_STAGE(PG8_SB(0, 0), cB, voffB); PG8_STAGE(PG8_SB(0, 1), cB + hstepB, voffB); PG8_STAGE(PG8_SA(0, 0), AS.base(cur.pm, 0), voffA); PG8_STAGE(PG8_SA(0, 1), AS.base(cur.pm, 0) + AS.hstep(0), voffA);
        if (wr == 1) PG8_BAR;
        PG8_WAIT_V(2); PG8_BAR;
        PG8_STAGE(PG8_SB(1, 0), cB + kstep, voffB); PG8_STAGE(PG8_SA(1, 0), AS.base(cur.pm, 1), voffA); PG8_STAGE(PG8_SB(1, 1), cB + hstepB + kstep, voffB);
        PG8_WAIT_V(6); PG8_BAR;
    }
    for (;;) {
        const bool has_next = S.next(ui + 1, nxt);
        const int npm = has_next ? nxt.pm : cur.pm; const char* nB = has_next ? (const char*)g.Bt + (size_t)nxt.pn * tstepB : cB;
        for (int t = 0; t < nt; t += 2) {
            const bool last = (t == nt - 2);
            if (t == AS.t1) E.mid(acc, cur, 0, wr, wc, fr, fq);
            if (t == AS.t2) E.mid(acc, cur, 1, wr, wc, fr, fq);
            const char* a1 = AS.base(cur.pm, t + 1); const size_t h1 = AS.hstep(t + 1); const bool s1 = AS.sel(t + 1);
            const char* a2 = last ? AS.base(npm, 0) : AS.base(cur.pm, t + 2); const char* b2 = last ? nB : cB + (size_t)(t + 2) * kstep;
            const char* a3 = last ? AS.base(npm, 1) : AS.base(cur.pm, t + 3); const char* b3 = b2 + kstep;
            const size_t h2 = last ? AS.hstep(0) : AS.hstep(t + 2); const bool s2 = last ? false : AS.sel(t + 2);
            const unsigned v1a[2] = {s1 ? voffA2[0] : voffA[0], s1 ? voffA2[1] : voffA[1]}, v2a[2] = {s2 ? voffA2[0] : voffA[0], s2 ? voffA2[1] : voffA[1]};
            if (last && has_next) S.a_ready(nxt);
            if constexpr (SP2) {
            PG8_LDB(B0, 0, 0); PG8_LDB(B1, 0, 1); PG8_SCHED; PG8_LDA(At, 0, 0); PG8_STAGE(PG8_SA(1, 1), a1 + h1, v1a);
            PG8_WAIT_V(8); PG8_WAIT_L(0); PG8_BAR; PG8_MMA(0, 0, At, B0); PG8_MMA(0, 1, At, B1); PG8_BAR; PG8_SCHED;
            PG8_LDA(At, 0, 1); PG8_STAGE(PG8_SB(0, 0), b2, voffB); PG8_STAGE(PG8_SB(0, 1), b2 + hstepB, voffB); PG8_STAGE(PG8_SA(0, 0), a2, v2a);
            PG8_WAIT_V(8); PG8_WAIT_L(0); PG8_BAR; PG8_MMA(1, 0, At, B0); PG8_MMA(1, 1, At, B1); PG8_BAR; PG8_SCHED;
            PG8_LDB(B0, 1, 0); PG8_LDB(B1, 1, 1); PG8_SCHED; PG8_LDA(At, 1, 0); PG8_STAGE(PG8_SA(0, 1), a2 + h2, v2a);
            PG8_WAIT_V(8); PG8_WAIT_L(0); PG8_BAR; PG8_MMA(0, 0, At, B0); PG8_MMA(0, 1, At, B1); PG8_BAR; PG8_SCHED;
            PG8_LDA(At, 1, 1); PG8_STAGE(PG8_SB(1, 0), b3, voffB); PG8_STAGE(PG8_SB(1, 1), b3 + hstepB, voffB); PG8_STAGE(PG8_SA(1, 0), a3, v2a);
            PG8_WAIT_V(8); PG8_WAIT_L(0); PG8_BAR; PG8_MMA(1, 0, At, B0); PG8_MMA(1, 1, At, B1); PG8_BAR; PG8_SCHED;
            }
        }
        if constexpr (ALIGN_EPI) { if (wr == 0) PG8_BAR; }
        if constexpr (!Epi::AFTER_DRAIN) { E(acc, cur, wr, wc, fr, fq); S.done(cur); }
        if (!has_next) break;
#pragma unroll
        for (int a = 0; a < 2; ++a)
#pragma unroll
            for (int b = 0; b < 2; ++b)
#pragma unroll
                for (int m = 0; m < 4; ++m)
#pragma unroll
                    for (int n = 0; n < 2; ++n) acc[a][b][m][n] = (f32x4){0.f, 0.f, 0.f, 0.f};
        cur = nxt; cB = nB; ++ui;
        if constexpr (ALIGN_EPI) { if (wr == 1) PG8_BAR; }
    }
    PG8_WAIT_V(0);
    if constexpr (!ALIGN_EPI) { if (wr == 0) PG8_BAR; }
    PG8_BAR;
    if constexpr (Epi::AFTER_DRAIN) { E.fused(acc, cur, wr, wc, fr, fq, lds, wid, lane); S.done(cur); }
#undef PG8_SA
#undef PG8_SB
#undef PG8_STAGE
#undef PG8_LDA
#undef PG8_LDB
#undef PG8_MMA
#undef PG8_WAIT_V
#undef PG8_WAIT_L
#undef PG8_BAR
#undef PG8_SCHED
}
}

constexpr int NWAVES = 8, NTHR = NWAVES * 64;
constexpr int D = 2048, BATCH = 16, SEQ = 2048, M = BATCH * SEQ, FF = 5632, MEM = 256, DEPTH = 2;
constexpr int N_IN_SRC = 12864, NWIN = 6912  , NWIN_SRC = 6720, NGATE = 6144;
constexpr int QKVW = 4608, ZW = 1024, QW = 1536, KVW = 2048;
#ifndef H_NT
#define H_NT 0
#endif
#ifndef FF_PAD
#define FF_PAD 0
#endif
constexpr int FF_LD = FF + FF_PAD;
constexpr float LN_EPS = 1e-5f, RMS_EPS = 1e-6f, ALPHA = 1.41421356237309515f, LOG2E = 1.4426950408889634f, LN2 = 0.6931471805599453f;
constexpr float NEGBIG = -1e30f;

constexpr size_t MiB = 1u << 20;
constexpr size_t WS_CTL = 0, CTL_ZERO_BYTES = 4 * MiB;
constexpr size_t CTL_SSQ = 256 * 1024;
constexpr size_t CTL_STATS = 1 * MiB;
constexpr size_t CTL_SNT = 3 * MiB;
constexpr int SNT_FFN0 = 0, SNT_FFN1 = 11264, SNT_WIN = 22528, SNT_GATE = 29440, SNT_XQ = 35584, SNT_N = 36096;
constexpr size_t WS_TAB = 4 * MiB;
constexpr size_t TAB_COS = WS_TAB, TAB_SIN = WS_TAB + 256 * 1024, TAB_BIAS = WS_TAB + 512 * 1024, TAB_SGUW = WS_TAB + 640 * 1024;
constexpr int BIAS_STRIDE = 132;
constexpr size_t WS_W = 5 * MiB;
constexpr size_t W_GU0 = WS_W, W_D0 = W_GU0 + 44 * MiB, W_GU1 = W_D0 + 22 * MiB, W_D1 = W_GU1 + 44 * MiB, W_IN = W_D1 + 22 * MiB, W_GATE = W_IN + 27 * MiB,
                 W_UQ = W_GATE + 24 * MiB, W_UKV = W_UQ + 2 * MiB, W_PA = W_UKV + 2 * MiB, W_PB = W_PA + 4 * MiB, W_PC = W_PB + 2 * MiB, W_OUT = W_PC + 2 * MiB,
                 W_XQ = W_OUT + 8 * MiB, W_XKV = W_XQ + 2 * MiB, W_XO = W_XKV + 4 * MiB, W_END = W_XO + 2 * MiB;
static_assert(W_END <= 218 * MiB, "weights");
constexpr size_t WS_XB = 218 * MiB;
constexpr size_t WS_MEMB = 346 * MiB;
constexpr size_t WS_KVX = 362 * MiB;
constexpr size_t WS_LSE = 370 * MiB;
constexpr size_t WS_R = 372 * MiB;
constexpr size_t R_H = WS_R;
constexpr size_t R_KPE = WS_R, R_CQ = WS_R + 4 * MiB, R_CKV = WS_R + 36 * MiB, R_OA = R_CQ  , R_Z = WS_R + 68 * MiB, R_QKV = WS_R + 132 * MiB,
                 R_QM = WS_R + 420 * MiB, R_KVM = WS_R + 516 * MiB, R_OC = WS_R + 644 * MiB, R_END = WS_R + 676 * MiB;
constexpr size_t R_GATE = R_QKV, R_MERGED = R_KVM;
constexpr size_t R_QX = R_QM, R_OX = R_QM + 32 * MiB;
constexpr size_t GATE_PLANE = (size_t)M * D;
constexpr size_t R_GATE2 = R_END, WS_NEED = R_END + GATE_PLANE;
static_assert((size_t)M * FF_LD * 2 <= 420 * MiB && R_GATE + (size_t)M * NGATE * 2 == R_KVM && R_QM + 96 * MiB == R_KVM && R_MERGED + 128 * MiB <= R_OC, "overlays");

constexpr int CW_PCNT = 16384;
constexpr int CW_BAR = 4096;

constexpr int LDS_BYTES = 147456;
constexpr int LDSCTL_OFF = 143360, MISC_OFF = LDSCTL_OFF;

#define GAS __attribute__((address_space(1)))
#define LAS __attribute__((address_space(3)))
typedef unsigned short bf16;
typedef pg8::f32x4 f32x4;
typedef pg8::f32x2 f32x2;
typedef pg8::u32x4 u32x4;
typedef pg8::u32x2 u32x2;
typedef pg8::bf16x8 bf16x8;
typedef short s16x4 __attribute__((ext_vector_type(4)));
typedef GAS unsigned gu32;
#define LDS_WAIT() asm volatile("s_waitcnt lgkmcnt(0)" ::: "memory")
#define VM_WAIT() asm volatile("s_waitcnt vmcnt(0)" ::: "memory")
__device__ __forceinline__ float bf2f(unsigned short b) { return __uint_as_float(((unsigned)b) << 16); }
__device__ __forceinline__ float bflo(unsigned w) { return __uint_as_float(w << 16); }
__device__ __forceinline__ float bfhi(unsigned w) { return __uint_as_float(w & 0xffff0000u); }
typedef float f32x2v_t __attribute__((ext_vector_type(2)));
typedef __bf16 bf16x2v_t __attribute__((ext_vector_type(2)));
__device__ __forceinline__ unsigned pk2(float lo, float hi) { const f32x2v_t v = {lo, hi}; const bf16x2v_t b = __builtin_convertvector(v, bf16x2v_t); return __builtin_bit_cast(unsigned, b); }
__device__ __forceinline__ float fsigmoid(float x) { return __builtin_amdgcn_rcpf(1.0f + __builtin_amdgcn_exp2f(-LOG2E * x)); }
__device__ __forceinline__ int lane_id_local() { int z = 0; asm volatile("" : "+v"(z)); return __builtin_amdgcn_mbcnt_hi(-1, __builtin_amdgcn_mbcnt_lo(-1, z)); }
__device__ __forceinline__ float shx(float v, int m) { return __builtin_bit_cast(float, __builtin_amdgcn_ds_bpermute((lane_id_local() ^ m) << 2, __builtin_bit_cast(int, v))); }
__device__ __forceinline__ float shx_l(float v, int m, int lane) { return __builtin_bit_cast(float, __builtin_amdgcn_ds_bpermute((lane ^ m) << 2, __builtin_bit_cast(int, v))); }
__device__ __forceinline__ float xmax_16_32(float v) {
    const auto r = __builtin_amdgcn_permlane16_swap(__float_as_uint(v), __float_as_uint(v), false, false); const unsigned r0 = r[0], r1 = r[1];
    v = fmaxf(__uint_as_float(r0), __uint_as_float(r1));
    const auto q = __builtin_amdgcn_permlane32_swap(__float_as_uint(v), __float_as_uint(v), false, false); const unsigned q0 = q[0], q1 = q[1];
    return fmaxf(__uint_as_float(q0), __uint_as_float(q1));
}
__device__ __forceinline__ float xsum_16_32(float v) {
    const auto r = __builtin_amdgcn_permlane16_swap(__float_as_uint(v), __float_as_uint(v), false, false); const unsigned r0 = r[0], r1 = r[1];
    v = __uint_as_float(r0) + __uint_as_float(r1);
    const auto q = __builtin_amdgcn_permlane32_swap(__float_as_uint(v), __float_as_uint(v), false, false); const unsigned q0 = q[0], q1 = q[1];
    return __uint_as_float(q0) + __uint_as_float(q1);
}
__device__ __forceinline__ float wave_sum(float v) {
#pragma unroll
    for (int o = 1; o < 64; o <<= 1) v += shx(v, o);
    return v;
}
__device__ __forceinline__ float wave_max(float v) {
#pragma unroll
    for (int o = 1; o < 64; o <<= 1) v = fmaxf(v, shx(v, o));
    return v;
}

#define XB_TMO      128
#define XB_XCNT(j)  (256  + 64 * (j))
#define XB_XSUB(j)  (1280 + 64 * (j))
#define XB_XGEN(j)  (2304 + 64 * (j))
#define XB_TOP      3328
#define XB_TOPGEN   3392
#define XCD_BAR_WORDS 3456
#define XB_SPIN_CAP (1u << 20)

__device__ __forceinline__ unsigned xb_ld(unsigned* p)              { return __hip_atomic_load(p, __ATOMIC_RELAXED, __HIP_MEMORY_SCOPE_AGENT); }
__device__ __forceinline__ unsigned xb_add(unsigned* p, unsigned v) { return __hip_atomic_fetch_add(p, v, __ATOMIC_RELAXED, __HIP_MEMORY_SCOPE_AGENT); }
__device__ __forceinline__ unsigned xb_xcc_id() { return (unsigned)__builtin_amdgcn_s_getreg((3 << 11) | 20) & 0xFu; }
#define XB_SPIN(cond, bar) do { unsigned _sp = 0; while (cond) { __builtin_amdgcn_s_sleep(1); \
    if ((++_sp & 255u) == 0u) { if (xb_ld(&(bar)[XB_TMO])) break; if (_sp > XB_SPIN_CAP) { atomicAdd(&(bar)[XB_TMO], 1u); break; } } } } while (0)

struct XcdBarrier { unsigned* bar; unsigned x; volatile LAS unsigned* st; };

__device__ __forceinline__ XcdBarrier xcd_barrier_post(unsigned* bar, volatile LAS unsigned* st) {
    XcdBarrier b; b.bar = bar; b.x = xb_xcc_id(); b.st = st;
    if (threadIdx.x == 0) (void)xb_add(&bar[XB_XCNT(b.x)], 1u);
    return b;
}
__device__ __forceinline__ void xcd_barrier_complete(unsigned* bar, unsigned x, unsigned& nloc, unsigned& nx) {
    const unsigned G = gridDim.x * gridDim.y * gridDim.z;
    unsigned sum, cnt, mine, sp = 0u;
    for (;;) {
        sum = 0u; cnt = 0u; mine = 0u;
#pragma unroll
        for (unsigned j = 0; j < 16; ++j) { const unsigned c = xb_ld(&bar[XB_XCNT(j)]); sum += c; cnt += (c > 0u) ? 1u : 0u; mine = (j == x) ? c : mine; }
        if (sum == G) break;
        __builtin_amdgcn_s_sleep(1);
        if ((++sp & 255u) == 0u) { if (xb_ld(&bar[XB_TMO])) break; if (sp > XB_SPIN_CAP) { atomicAdd(&bar[XB_TMO], 1u); break; } }
    }
    nloc = mine > 0u ? mine : 1u; nx = cnt > 0u ? cnt : 1u;
}
__device__ __forceinline__ void xcd_barrier(const XcdBarrier& b) {
    asm volatile("s_waitcnt vmcnt(0)" ::: "memory");
    __syncthreads();
    if (threadIdx.x == 0) {
        unsigned* bar = b.bar; { size_t z_ = 0; asm volatile("" : "+s"(z_)); bar += z_; }
        __builtin_amdgcn_s_waitcnt(0);
        unsigned nloc = b.st[0], nx = b.st[1];
        if (nloc == 0u) { xcd_barrier_complete(bar, b.x, nloc, nx); b.st[0] = nloc; b.st[1] = nx; }
        const unsigned old = xb_add(&bar[XB_XSUB(b.x)], 1u);
        const unsigned gen = old / nloc;
        if (old + 1u == (gen + 1u) * nloc) {
            __builtin_amdgcn_fence(__ATOMIC_RELEASE, "agent");
            asm volatile("s_waitcnt vmcnt(0)" ::: "memory");
            const unsigned og = xb_add(&bar[XB_TOP], 1u);
            const unsigned tg = og / nx;
            if (og + 1u == (tg + 1u) * nx) xb_add(&bar[XB_TOPGEN], 1u);
            else XB_SPIN(xb_ld(&bar[XB_TOPGEN]) == tg, bar);
            __builtin_amdgcn_fence(__ATOMIC_ACQUIRE, "agent");
            xb_add(&bar[XB_XGEN(b.x)], 1u);
            asm volatile("s_waitcnt vmcnt(0)" ::: "memory");
        } else {
            XB_SPIN(xb_ld(&bar[XB_XGEN(b.x)]) == gen, bar);
            __builtin_amdgcn_fence(__ATOMIC_ACQUIRE, "agent");
            asm volatile("s_waitcnt vmcnt(0)" ::: "memory");
        }
    }
    __syncthreads();
}

__device__ __forceinline__ u32x4 ld16_sc1_nowait(const void* p) { u32x4 v; asm volatile("global_load_dwordx4 %0, %1, off sc0 sc1" : "=v"(v) : "v"(p) : "memory"); return v; }
__device__ __forceinline__ u32x4 ld16_sc1(const void* p) { u32x4 v; asm volatile("global_load_dwordx4 %0, %1, off sc0 sc1\n\ts_waitcnt vmcnt(0)" : "=v"(v) : "v"(p) : "memory"); return v; }
using pg8::Unit;
struct LnFold {
    const float* stats; const float* sn; const float* tn;
    __device__ __forceinline__ void row(int r, float& mu, float& rs) const {
        if (!stats) { mu = 0.f; rs = 1.f; return; }
        const f32x2 st = *(const f32x2*)(stats + 2 * (size_t)r); const float m_ = st.x * (1.0f / D); rs = __builtin_amdgcn_rsqf(st.y * (1.0f / D) - m_ * m_ + LN_EPS); mu = -m_ * rs;
    }
    __device__ __forceinline__ void cols(int c, float (&s)[8], float (&t)[8]) const {
        if (!stats) {
#pragma unroll
            for (int j = 0; j < 8; ++j) { s[j] = 0.f; t[j] = 0.f; }
            return; }
        const f32x4 s0 = *(const f32x4*)(sn + c), s1 = *(const f32x4*)(sn + c + 4), t0 = *(const f32x4*)(tn + c), t1 = *(const f32x4*)(tn + c + 4);
        s[0] = s0.x; s[1] = s0.y; s[2] = s0.z; s[3] = s0.w; s[4] = s1.x; s[5] = s1.y; s[6] = s1.z; s[7] = s1.w;
        t[0] = t0.x; t[1] = t0.y; t[2] = t0.z; t[3] = t0.w; t[4] = t1.x; t[5] = t1.y; t[6] = t1.z; t[7] = t1.w;
    }
};
struct EpiSwiglu {
    static constexpr bool PERM = true, AFTER_DRAIN = false;
    bf16* H; LnFold ln;
    __device__ __forceinline__ void operator()(const f32x4 (&acc)[2][2][4][2], const Unit& u, int wr, int wc, int fr, int fq) const {
        const int row0 = u.pm * 256 + wr * 64 + fr, col0 = u.pn * 128 + wc * 32 + 8 * fq, wrow = u.pn * 256 + wc * 32 + 8 * fq;
        float sg[8], tg[8], su[8], tu[8];
        ln.cols(wrow, sg, tg); ln.cols(wrow + 128, su, tu);
#pragma unroll
        for (int ai = 0; ai < 2; ++ai)
#pragma unroll
            for (int m = 0; m < 4; ++m) {
                const int row = row0 + ai * 128 + m * 16;
                float mu, rs; ln.row(row, mu, rs);
                float h[8];
#pragma unroll
                for (int n = 0; n < 2; ++n)
#pragma unroll
                    for (int j = 0; j < 4; ++j) { const float g = __builtin_fmaf(rs, acc[ai][0][m][n][j], __builtin_fmaf(mu, sg[4 * n + j], tg[4 * n + j])), up = __builtin_fmaf(rs, acc[ai][1][m][n][j], __builtin_fmaf(mu, su[4 * n + j], tu[4 * n + j]));
                        h[4 * n + j] = g * fsigmoid(g) * up; }
                u32x4 w; w.x = pk2(h[0], h[1]); w.y = pk2(h[2], h[3]); w.z = pk2(h[4], h[5]); w.w = pk2(h[6], h[7]);
                if (H_NT) __builtin_nontemporal_store(w, (u32x4*)(H + (size_t)row * FF_LD + col0)); else *(u32x4*)(H + (size_t)row * FF_LD + col0) = w;
            }
    }
};
struct EpiResidLn {
    static constexpr bool PERM = true, AFTER_DRAIN = false;
    const float* xin;
    bf16* ZB; const bf16* zl_in; bf16* zl_out; const float* stats_prev; const float* g_prev; const float* b_prev; float* stats_out; float alpha, scale;
    __device__ __forceinline__ void operator()(const f32x4 (&acc)[2][2][4][2], const Unit& u, int wr, int wc, int fr, int fq) const {
        const int row0 = u.pm * 256 + wr * 64 + fr;
        float gg[2][8], bb[2][8];
#pragma unroll
        for (int bj = 0; bj < 2; ++bj) { const int col = u.pn * 256 + bj * 128 + wc * 32 + 8 * fq;
            if (xin) {
#pragma unroll
                for (int j = 0; j < 8; ++j) { gg[bj][j] = 1.f; bb[bj][j] = 0.f; }
            } else { const f32x4 g0 = *(const f32x4*)(g_prev + col), g1 = *(const f32x4*)(g_prev + col + 4), b0 = *(const f32x4*)(b_prev + col), b1 = *(const f32x4*)(b_prev + col + 4);
                gg[bj][0] = g0.x; gg[bj][1] = g0.y; gg[bj][2] = g0.z; gg[bj][3] = g0.w; gg[bj][4] = g1.x; gg[bj][5] = g1.y; gg[bj][6] = g1.z; gg[bj][7] = g1.w;
                bb[bj][0] = b0.x; bb[bj][1] = b0.y; bb[bj][2] = b0.z; bb[bj][3] = b0.w; bb[bj][4] = b1.x; bb[bj][5] = b1.y; bb[bj][6] = b1.z; bb[bj][7] = b1.w; } }
#pragma unroll
        for (int ap = 0; ap < 4; ++ap) {
            const int ai = ap >> 1;
            f32x4 pv[2][2][2]; f32x2 st[2];
#pragma unroll
            for (int mm = 0; mm < 2; ++mm) {
                const int m = 2 * (ap & 1) + mm, row = row0 + ai * 128 + m * 16;
                st[mm] = xin ? (f32x2){0.f, 0.f} : *(const f32x2*)(stats_prev + 2 * (size_t)row);
#pragma unroll
                for (int bj = 0; bj < 2; ++bj) { const size_t off = (size_t)row * D + u.pn * 256 + bj * 128 + wc * 32 + 8 * fq;
                    if (xin) { pv[mm][bj][0] = *(const f32x4*)(xin + off); pv[mm][bj][1] = *(const f32x4*)(xin + off + 4); }
                    else { const u32x4 h = *(const u32x4*)(ZB + off), l = *(const u32x4*)(zl_in + off);
                        pv[mm][bj][0] = (f32x4){bflo(h.x) + bflo(l.x), bfhi(h.x) + bfhi(l.x), bflo(h.y) + bflo(l.y), bfhi(h.y) + bfhi(l.y)};
                        pv[mm][bj][1] = (f32x4){bflo(h.z) + bflo(l.z), bfhi(h.z) + bfhi(l.z), bflo(h.w) + bflo(l.w), bfhi(h.w) + bfhi(l.w)}; } }
            }
#pragma unroll
            for (int mm = 0; mm < 2; ++mm) {
                const int m = 2 * (ap & 1) + mm, row = row0 + ai * 128 + m * 16;
                float mu = 0.f, rs = 1.f;
                if (!xin) { mu = st[mm].x * (1.0f / D); rs = __builtin_amdgcn_rsqf(st[mm].y * (1.0f / D) - mu * mu + LN_EPS); }
                float s1 = 0.f, s2 = 0.f;
#pragma unroll
                for (int bj = 0; bj < 2; ++bj) {
                    const size_t off = (size_t)row * D + u.pn * 256 + bj * 128 + wc * 32 + 8 * fq;
                    float z[8], zr[8];
#pragma unroll
                    for (int j = 0; j < 8; ++j) { const float xp = (pv[mm][bj][j >> 2][j & 3] - mu) * rs * gg[bj][j] + bb[bj][j]; z[j] = alpha * xp + scale * acc[ai][bj][m][j >> 2][j & 3]; s1 += z[j]; s2 += z[j] * z[j]; }
                    u32x4 o; o.x = pk2(z[0], z[1]); o.y = pk2(z[2], z[3]); o.z = pk2(z[4], z[5]); o.w = pk2(z[6], z[7]);
                    zr[0] = z[0] - bflo(o.x); zr[1] = z[1] - bfhi(o.x); zr[2] = z[2] - bflo(o.y); zr[3] = z[3] - bfhi(o.y); zr[4] = z[4] - bflo(o.z); zr[5] = z[5] - bfhi(o.z); zr[6] = z[6] - bflo(o.w); zr[7] = z[7] - bfhi(o.w);
                    u32x4 ol; ol.x = pk2(zr[0], zr[1]); ol.y = pk2(zr[2], zr[3]); ol.z = pk2(zr[4], zr[5]); ol.w = pk2(zr[6], zr[7]);
                    *(u32x4*)(ZB + off) = o; *(u32x4*)(zl_out + off) = ol;
                }
                s1 = xsum_16_32(s1); s2 = xsum_16_32(s2);
                if (fq < 2) unsafeAtomicAdd(stats_out + 2 * (size_t)row + fq, fq ? s2 : s1);
            }
            asm volatile("" ::: "memory");
        }
    }
};
struct EpiResidLnFinal {
    static constexpr bool PERM = true, AFTER_DRAIN = false;
    const bf16* ZB; const bf16* zl_in; const float* stats_prev; const float* g_prev; const float* b_prev; float* stats_out; unsigned* pcnt; const float* g_fin; const float* b_fin; float* out; float alpha, scale;
    __device__ __forceinline__ void operator()(const f32x4 (&acc_)[2][2][4][2], const Unit& u, int wr, int wc, int fr_, int fq_) const {
        f32x4 (&acc)[2][2][4][2] = const_cast<f32x4 (&)[2][2][4][2]>(acc_);
        int fr = fr_, fq = fq_; asm volatile("" : "+v"(fr), "+v"(fq));
        int row0 = u.pm * 256 + wr * 64 + fr;
        {
            float gg[2][8], bb[2][8];
#pragma unroll
            for (int bj = 0; bj < 2; ++bj) { const int col = u.pn * 256 + bj * 128 + wc * 32 + 8 * fq;
                const f32x4 g0 = *(const f32x4*)(g_prev + col), g1 = *(const f32x4*)(g_prev + col + 4), b0 = *(const f32x4*)(b_prev + col), b1 = *(const f32x4*)(b_prev + col + 4);
                gg[bj][0] = g0.x; gg[bj][1] = g0.y; gg[bj][2] = g0.z; gg[bj][3] = g0.w; gg[bj][4] = g1.x; gg[bj][5] = g1.y; gg[bj][6] = g1.z; gg[bj][7] = g1.w;
                bb[bj][0] = b0.x; bb[bj][1] = b0.y; bb[bj][2] = b0.z; bb[bj][3] = b0.w; bb[bj][4] = b1.x; bb[bj][5] = b1.y; bb[bj][6] = b1.z; bb[bj][7] = b1.w; }
#pragma unroll
            for (int ap = 0; ap < 4; ++ap) {
                const int ai = ap >> 1;
                f32x4 pv[2][2][2]; f32x2 st[2];
#pragma unroll
                for (int mm = 0; mm < 2; ++mm) {
                    const int m = 2 * (ap & 1) + mm, row = row0 + ai * 128 + m * 16;
                    st[mm] = *(const f32x2*)(stats_prev + 2 * (size_t)row);
#pragma unroll
                    for (int bj = 0; bj < 2; ++bj) { const size_t off = (size_t)row * D + u.pn * 256 + bj * 128 + wc * 32 + 8 * fq;
                        const u32x4 h = *(const u32x4*)(ZB + off), l = *(const u32x4*)(zl_in + off);
                        pv[mm][bj][0] = (f32x4){bflo(h.x) + bflo(l.x), bfhi(h.x) + bfhi(l.x), bflo(h.y) + bflo(l.y), bfhi(h.y) + bfhi(l.y)};
                        pv[mm][bj][1] = (f32x4){bflo(h.z) + bflo(l.z), bfhi(h.z) + bfhi(l.z), bflo(h.w) + bflo(l.w), bfhi(h.w) + bfhi(l.w)}; }
                }
#pragma unroll
                for (int mm = 0; mm < 2; ++mm) {
                    const int m = 2 * (ap & 1) + mm, row = row0 + ai * 128 + m * 16;
                    const float mu = st[mm].x * (1.0f / D), rs = __builtin_amdgcn_rsqf(st[mm].y * (1.0f / D) - mu * mu + LN_EPS);
                    float s1 = 0.f, s2 = 0.f;
#pragma unroll
                    for (int bj = 0; bj < 2; ++bj)
#pragma unroll
                        for (int j = 0; j < 8; ++j) { const float xp = (pv[mm][bj][j >> 2][j & 3] - mu) * rs * gg[bj][j] + bb[bj][j]; const float z = alpha * xp + scale * acc[ai][bj][m][j >> 2][j & 3];
                            acc[ai][bj][m][j >> 2][j & 3] = z; s1 += z; s2 += z * z; }
                    s1 = xsum_16_32(s1); s2 = xsum_16_32(s2);
                    if (fq < 2) unsafeAtomicAdd(stats_out + 2 * (size_t)row + fq, fq ? s2 : s1);
                }
                asm volatile("" ::: "memory");
            }
        }
        asm volatile("s_waitcnt vmcnt(0)" ::: "memory");
        __syncthreads();
        if (threadIdx.x == 0) {
            unsigned* pc = pcnt + 16 * u.pm;
            (void)xb_add(pc, 1u);
            unsigned sp = 0u;
            while (xb_ld(pc) < (unsigned)(D / 256) && ++sp < (1u << 22)) __builtin_amdgcn_s_sleep(1);
            __builtin_amdgcn_fence(__ATOMIC_ACQUIRE, "agent");
        }
        __syncthreads();
        asm volatile("" : "+v"(fr), "+v"(fq)); row0 = u.pm * 256 + wr * 64 + fr;
        {
            float gf[2][8], bf_[2][8];
#pragma unroll
            for (int bj = 0; bj < 2; ++bj) { const int col = u.pn * 256 + bj * 128 + wc * 32 + 8 * fq;
                const f32x4 g0 = *(const f32x4*)(g_fin + col), g1 = *(const f32x4*)(g_fin + col + 4), b0 = *(const f32x4*)(b_fin + col), b1 = *(const f32x4*)(b_fin + col + 4);
                gf[bj][0] = g0.x; gf[bj][1] = g0.y; gf[bj][2] = g0.z; gf[bj][3] = g0.w; gf[bj][4] = g1.x; gf[bj][5] = g1.y; gf[bj][6] = g1.z; gf[bj][7] = g1.w;
                bf_[bj][0] = b0.x; bf_[bj][1] = b0.y; bf_[bj][2] = b0.z; bf_[bj][3] = b0.w; bf_[bj][4] = b1.x; bf_[bj][5] = b1.y; bf_[bj][6] = b1.z; bf_[bj][7] = b1.w; }
            float mu8[2][4], rs8[2][4];
#pragma unroll
            for (int ai = 0; ai < 2; ++ai)
#pragma unroll
                for (int m = 0; m < 4; ++m) { float* sp_ = stats_out + 2 * (size_t)(row0 + ai * 128 + m * 16);
                    mu8[ai][m] = __hip_atomic_load(sp_, __ATOMIC_RELAXED, __HIP_MEMORY_SCOPE_AGENT); rs8[ai][m] = __hip_atomic_load(sp_ + 1, __ATOMIC_RELAXED, __HIP_MEMORY_SCOPE_AGENT); }
#pragma unroll
            for (int ai = 0; ai < 2; ++ai)
#pragma unroll
                for (int m = 0; m < 4; ++m) { const float mean = mu8[ai][m] * (1.0f / D); rs8[ai][m] = __builtin_amdgcn_rsqf(rs8[ai][m] * (1.0f / D) - mean * mean + LN_EPS); mu8[ai][m] = mean; }
#pragma unroll
            for (int ai = 0; ai < 2; ++ai)
#pragma unroll
                for (int m = 0; m < 4; ++m) {
                    const int row = row0 + ai * 128 + m * 16;
#pragma unroll
                    for (int bj = 0; bj < 2; ++bj) { float* op = out + (size_t)row * D + u.pn * 256 + bj * 128 + wc * 32 + 8 * fq;
                        f32x4 o0, o1;
#pragma unroll
                        for (int j = 0; j < 4; ++j) { o0[j] = (acc[ai][bj][m][0][j] - mu8[ai][m]) * rs8[ai][m] * gf[bj][j] + bf_[bj][j]; o1[j] = (acc[ai][bj][m][1][j] - mu8[ai][m]) * rs8[ai][m] * gf[bj][4 + j] + bf_[bj][4 + j]; }
                        *(f32x4*)op = o0; *(f32x4*)(op + 4) = o1; }
                }
        }
    }
};
template <int MODE  > struct EpiBf {
    static constexpr bool PERM = true, AFTER_DRAIN = false;
    bf16* O; int ldc; const float* ssq; const float* cosT; const float* sinT; LnFold ln;
    __device__ __forceinline__ void operator()(const f32x4 (&acc)[2][2][4][2], const Unit& u, int wr, int wc, int fr, int fq) const {
        const int row0 = u.pm * 256 + wr * 64 + fr;
        float sc[2][8], tc[2][8];
#pragma unroll
        for (int bj = 0; bj < 2; ++bj) ln.cols(u.pn * 256 + bj * 128 + wc * 32 + 8 * fq, sc[bj], tc[bj]);
#pragma unroll
        for (int ai = 0; ai < 2; ++ai)
#pragma unroll
            for (int m = 0; m < 4; ++m) {
                const int row = row0 + ai * 128 + m * 16;
                float rs = 1.f;
                if (MODE == 1 || MODE == 2) rs = __builtin_amdgcn_rsqf(ssq[row] * (1.0f / 512.0f) + RMS_EPS);
                float mu, lr; ln.row(row, mu, lr);
#pragma unroll
                for (int bj = 0; bj < 2; ++bj) {
                    const int col0 = u.pn * 256 + bj * 128 + wc * 32 + 8 * fq;
                    float v[8];
#pragma unroll
                    for (int n = 0; n < 2; ++n)
#pragma unroll
                        for (int j = 0; j < 4; ++j) v[4 * n + j] = __builtin_fmaf(lr, acc[ai][bj][m][n][j], __builtin_fmaf(mu, sc[bj][4 * n + j], tc[bj][4 * n + j])) * rs;
                    if (MODE == 2) {
                        const int hd = col0 / 192, w = col0 - hd * 192;
                        if (w >= 128) {
                            const int pos = row & (SEQ - 1), jj0 = (w - 128) >> 1;
                            const f32x4 c = *(const f32x4*)(cosT + pos * 32 + jj0), s = *(const f32x4*)(sinT + pos * 32 + jj0);
#pragma unroll
                            for (int p = 0; p < 4; ++p) { const float a = v[2 * p], b = v[2 * p + 1]; v[2 * p] = a * c[p] - b * s[p]; v[2 * p + 1] = a * s[p] + b * c[p]; }
                        }
                    }
                    u32x4 o; o.x = pk2(v[0], v[1]); o.y = pk2(v[2], v[3]); o.z = pk2(v[4], v[5]); o.w = pk2(v[6], v[7]);
                    *(u32x4*)(O + (size_t)row * ldc + col0) = o;
                }
            }
    }
};
struct EpiWin {
    static constexpr bool PERM = true, AFTER_DRAIN = false;
    bf16 *CQ, *CKV, *Z, *QKV, *KPE; float* ssq_q; float* ssq_kv; const float* cosT; const float* sinT; LnFold ln;
    __device__ __forceinline__ void operator()(const f32x4 (&acc)[2][2][4][2], const Unit& u, int wr, int wc, int fr, int fq) const {
        const int row0 = u.pm * 256 + wr * 64 + fr, pn = u.pn;
        bf16* base; int ldc, ct; int kind;
        float* ssq = nullptr;
        if (pn < 2) { base = CQ; ldc = 512; ct = pn; kind = 1; ssq = ssq_q; }
        else if (pn < 4) { base = CKV; ldc = 512; ct = pn - 2; kind = 1; ssq = ssq_kv; }
        else if (pn < 8) { base = Z; ldc = ZW; ct = pn - 4; kind = 2; }
        else if (pn < 26) { base = QKV; ldc = QKVW; ct = pn - 8; kind = 0; }
        else { base = KPE; ldc = 64; ct = 0; kind = 3; }
        float sc[2][8], tc[2][8];
#pragma unroll
        for (int bj = 0; bj < 2; ++bj) ln.cols(pn * 256 + bj * 128 + wc * 32 + 8 * fq, sc[bj], tc[bj]);
#pragma unroll
        for (int ai = 0; ai < 2; ++ai)
#pragma unroll
            for (int m = 0; m < 4; ++m) {
                const int row = row0 + ai * 128 + m * 16;
                float mu, lr; ln.row(row, mu, lr);
                float sq = 0.f;
#pragma unroll
                for (int bj = 0; bj < 2; ++bj) {
                    const int cl = bj * 128 + wc * 32 + 8 * fq;
                    float v[8];
#pragma unroll
                    for (int n = 0; n < 2; ++n)
#pragma unroll
                        for (int j = 0; j < 4; ++j) v[4 * n + j] = __builtin_fmaf(lr, acc[ai][bj][m][n][j], __builtin_fmaf(mu, sc[bj][4 * n + j], tc[bj][4 * n + j]));
                    if (kind == 1) {
#pragma unroll
                        for (int j = 0; j < 8; ++j) sq += v[j] * v[j];
                    }
                    if (kind == 2) {
#pragma unroll
                        for (int p = 0; p < 4; ++p) { const f32x2 g = pg8::gelu_pk((f32x2){v[2 * p], v[2 * p + 1]}); v[2 * p] = g.x; v[2 * p + 1] = g.y; }
                    }
                    if (kind == 3) {
                        if (cl < 64) {
                            const int pos = row & (SEQ - 1), jj0 = cl >> 1;
                            const f32x4 c = *(const f32x4*)(cosT + pos * 32 + jj0), s = *(const f32x4*)(sinT + pos * 32 + jj0);
#pragma unroll
                            for (int p = 0; p < 4; ++p) { const float a = v[2 * p], b = v[2 * p + 1]; v[2 * p] = a * c[p] - b * s[p]; v[2 * p + 1] = a * s[p] + b * c[p]; }
                        }
                    }
                    if (kind != 3 || cl < 64) {
                        u32x4 o; o.x = pk2(v[0], v[1]); o.y = pk2(v[2], v[3]); o.z = pk2(v[4], v[5]); o.w = pk2(v[6], v[7]);
                        *(u32x4*)(base + (size_t)row * ldc + ct * 256 + cl) = o;
                    }
                }
                if (kind == 1) {
                    sq = xsum_16_32(sq);
                    if (fq == 0) unsafeAtomicAdd(ssq + row, sq);
                }
            }
    }
};
struct EpiGate8 {
    static constexpr bool PERM = true, AFTER_DRAIN = false;
    unsigned char* G01; unsigned char* G2; LnFold ln;
    __device__ __forceinline__ void operator()(const f32x4 (&acc)[2][2][4][2], const Unit& u, int wr, int wc, int fr, int fq) const {
        const int row0 = u.pm * 256 + wr * 64 + fr, pl = u.pn >> 3, pc = (u.pn & 7) * 256;
        unsigned char* O = pl < 2 ? G01 + (size_t)pl * GATE_PLANE : G2;
        float sc[2][8], tc[2][8];
#pragma unroll
        for (int bj = 0; bj < 2; ++bj) ln.cols(u.pn * 256 + bj * 128 + wc * 32 + 8 * fq, sc[bj], tc[bj]);
#pragma unroll
        for (int ai = 0; ai < 2; ++ai)
#pragma unroll
            for (int m = 0; m < 4; ++m) {
                const int row = row0 + ai * 128 + m * 16;
                float mu, lr; ln.row(row, mu, lr);
#pragma unroll
                for (int bj = 0; bj < 2; ++bj) {
                    const int col0 = pc + bj * 128 + wc * 32 + 8 * fq;
                    unsigned b[8];
#pragma unroll
                    for (int n = 0; n < 2; ++n)
#pragma unroll
                        for (int j = 0; j < 4; ++j) b[4 * n + j] = (unsigned)(fsigmoid(__builtin_fmaf(lr, acc[ai][bj][m][n][j], __builtin_fmaf(mu, sc[bj][4 * n + j], tc[bj][4 * n + j]))) * 255.0f + 0.5f);
                    *(u32x2*)(O + (size_t)row * D + col0) = (u32x2){b[0] | (b[1] << 8) | (b[2] << 16) | (b[3] << 24), b[4] | (b[5] << 8) | (b[6] << 16) | (b[7] << 24)};
                }
            }
    }
};
struct EpiWinGate {
    static constexpr bool PERM = true, AFTER_DRAIN = false;
    EpiWin w; EpiGate8 g;
    __device__ __forceinline__ void operator()(const f32x4 (&acc)[2][2][4][2], const Unit& u, int wr, int wc, int fr, int fq) const {
        if (u.pn < NWIN / 256) w(acc, u, wr, wc, fr, fq); else { Unit v; v.pm = u.pm; v.pn = u.pn - NWIN / 256; g(acc, v, wr, wc, fr, fq); }
    }
};
struct EpiGate8Raw {
    static constexpr bool PERM = true, AFTER_DRAIN = false;
    unsigned char* O;
    __device__ __forceinline__ void operator()(const f32x4 (&acc)[2][2][4][2], const Unit& u, int wr, int wc, int fr, int fq) const {
        const int row0 = u.pm * 256 + wr * 64 + fr;
#pragma unroll
        for (int ai = 0; ai < 2; ++ai)
#pragma unroll
            for (int m = 0; m < 4; ++m)
#pragma unroll
                for (int bj = 0; bj < 2; ++bj) {
                    const f32x4 a = acc[ai][bj][m][0], b = acc[ai][bj][m][1];
                    *(u32x2*)(O + (size_t)(row0 + ai * 128 + m * 16) * NGATE + u.pn * 256 + bj * 128 + wc * 32 + 8 * fq) = (u32x2){pk2(a.x + a.y, a.z + a.w), pk2(b.x + b.y, b.z + b.w)};
                }
    }
};
struct EpiMerge {
    static constexpr bool PERM = true, AFTER_DRAIN = false;
    const unsigned char* G01; const unsigned char* G2; bf16* MG;
    template <int WHICH> __device__ __forceinline__ void scale(f32x4 (&acc)[2][2][4][2], const Unit& u, int wr, int wc, int fr_, int fq_) const {
        int fr = fr_, fq = fq_; asm volatile("" : "+v"(fr), "+v"(fq));
        const int row0 = u.pm * 256 + wr * 64 + fr;
#pragma unroll
        for (int ai = 0; ai < 2; ++ai) {
            u32x2 gn[4][2], gd[4][2];
#pragma unroll
            for (int m = 0; m < 4; ++m)
#pragma unroll
                for (int bj = 0; bj < 2; ++bj) {
                    const size_t go = (size_t)(row0 + ai * 128 + m * 16) * D + u.pn * 256 + bj * 128 + wc * 32 + 8 * fq;
                    gn[m][bj] = *(const u32x2*)((WHICH == 0 ? G01 : WHICH == 1 ? G01 + GATE_PLANE : G2) + go);
                    if (WHICH < 2) gd[m][bj] = *(const u32x2*)((WHICH == 0 ? G01 + GATE_PLANE : G2) + go); else gd[m][bj] = (u32x2){0u, 0u};
                }
#pragma unroll
            for (int m = 0; m < 4; ++m)
#pragma unroll
                for (int bj = 0; bj < 2; ++bj)
#pragma unroll
                    for (int j = 0; j < 8; ++j) {
                        const unsigned nb = ((j < 4 ? gn[m][bj].x : gn[m][bj].y) >> (8 * (j & 3))) & 255u, db = ((j < 4 ? gd[m][bj].x : gd[m][bj].y) >> (8 * (j & 3))) & 255u;
                        const float num = (float)(WHICH == 0 ? nb : (nb > 1u ? nb : 1u));
                        const float s = WHICH < 2 ? num * __builtin_amdgcn_rcpf((float)(db > 1u ? db : 1u)) : num * (1.0f / 255.0f);
                        acc[ai][bj][m][j >> 2][j & 3] *= s;
                    }
        }
    }
    __device__ __forceinline__ void mid(f32x4 (&acc)[2][2][4][2], const Unit& u, int which, int wr, int wc, int fr, int fq) const {
        if (which == 0) scale<0>(acc, u, wr, wc, fr, fq); else scale<1>(acc, u, wr, wc, fr, fq);
    }
    __device__ __forceinline__ void operator()(f32x4 (&acc)[2][2][4][2], const Unit& u, int wr, int wc, int fr, int fq) const {
        scale<2>(acc, u, wr, wc, fr, fq);
        const int row0 = u.pm * 256 + wr * 64 + fr;
#pragma unroll
        for (int ai = 0; ai < 2; ++ai)
#pragma unroll
            for (int m = 0; m < 4; ++m)
#pragma unroll
                for (int bj = 0; bj < 2; ++bj) {
                    const f32x4 a = acc[ai][bj][m][0], b = acc[ai][bj][m][1];
                    u32x4 o; o.x = pk2(a.x, a.y); o.y = pk2(a.z, a.w); o.z = pk2(b.x, b.y); o.w = pk2(b.z, b.w);
                    *(u32x4*)(MG + (size_t)(row0 + ai * 128 + m * 16) * D + u.pn * 256 + bj * 128 + wc * 32 + 8 * fq) = o;
                }
    }
};

struct Frame {
    LAS unsigned char* lds;
    gu32* ctl;
    unsigned char* ws;
    int wave, vcu, G, gw, NGW;
    float* out;
};
constexpr int PTR_OFF = LDSCTL_OFF + 256;
__device__ __forceinline__ const float* inptr(const Frame& F, int i) {
    int z = 0; asm volatile("" : "+v"(z));
    const volatile LAS unsigned* p = (const volatile LAS unsigned*)(F.lds + PTR_OFF + 8 * i + z);
    const unsigned lo = __builtin_amdgcn_readfirstlane(p[0]), hi = __builtin_amdgcn_readfirstlane(p[1]);
    return (const float*)(((unsigned long long)hi << 32) | lo);
}
#define INP(i) inptr(F, (i))
__device__ __forceinline__ int tid_opaque() { int t = (int)threadIdx.x; asm volatile("" : "+v"(t)); return t; }
#define TID_ tid_opaque()
#define LANE_ (tid_opaque() & 63)
template <class T> __device__ __forceinline__ T* wsp(const Frame& F, size_t off) { return (T*)(F.ws + off); }
__device__ __forceinline__ size_t szero() { size_t z = 0; asm volatile("" : "+s"(z)); return z; }
__device__ __forceinline__ unsigned char* ws_launder(unsigned char* p) { return p + szero(); }
__device__ __forceinline__ int vlaunder(int v) { asm volatile("" : "+v"(v)); return v; }

__device__ __forceinline__ int rowmap(int mode, int n) {
    switch (mode) {
        case 1: return 256 * (n >> 7) + (n & 127);
        case 2: return 256 * (n >> 7) + 128 + (n & 127);
        case 3: {
            if (n < 1024) return n;
            if (n < 1088) { const int j = n - 1024; return 6656 + 2 * (j & 31) + (j >> 5); }
            return n - 64; }
        case 4: { const int hd = n / 192, w = n - hd * 192; if (w < 128) return n; const int j = w - 128; return hd * 192 + 128 + 2 * (j & 31) + (j >> 5); }
        default: return n;
    }
}
struct TrJob { const float* src; const float* ks; const float* lnb; float* sn; int ldw, K, nblk, mode, r; size_t dstoff; bool hit; };
__device__ __forceinline__ void tr_load(const TrJob& j, f32x4 (&v)[16], int lane) {
    const int k0 = 64 * (j.r / j.nblk), n0 = 64 * (j.r % j.nblk);
#pragma unroll
    for (int i = 0; i < 16; ++i) { const int kk = 4 * i + (lane >> 4); v[i] = __builtin_nontemporal_load((const f32x4*)(j.src + (size_t)(k0 + kk) * j.ldw + n0 + 4 * (lane & 15))); }
}
__device__ __forceinline__ void tr_store(const TrJob& j, const f32x4 (&v)[16], unsigned char* ws, LAS float* scr, LAS float* tmp, int lane) {
    const int k0 = 64 * (j.r / j.nblk), n0 = 64 * (j.r % j.nblk);
    bf16* WT = (bf16*)(ws + j.dstoff);
    f32x4 ts = (f32x4){0.f, 0.f, 0.f, 0.f};
#pragma unroll
    for (int i = 0; i < 16; ++i) { const int kk = 4 * i + (lane >> 4); f32x4 x = v[i];
        if (j.lnb) ts += x * j.lnb[k0 + kk];
        if (j.ks) x = x * j.ks[k0 + kk];
        LAS float* d = scr + kk * 65 + 4 * (lane & 15); d[0] = x.x; d[1] = x.y; d[2] = x.z; d[3] = x.w; }
    if (j.lnb) {
#pragma unroll
        for (int e = 0; e < 4; ++e) { float t = ts[e]; t += shx(t, 16); t += shx(t, 32); ts[e] = t; }
        if ((lane >> 4) == 0) {
#pragma unroll
            for (int e = 0; e < 4; ++e) tmp[4 * (lane & 15) + e] = ts[e];
        }
    }
    LDS_WAIT(); asm volatile("" ::: "memory");
    const int c8 = lane & 7;
#pragma unroll
    for (int jj = 0; jj < 8; ++jj) { const int n = (lane >> 3) + 8 * jj; const LAS float* s = scr + (8 * c8) * 65 + n;
        u32x4 o; o.x = pk2(s[0 * 65], s[1 * 65]); o.y = pk2(s[2 * 65], s[3 * 65]); o.z = pk2(s[4 * 65], s[5 * 65]); o.w = pk2(s[6 * 65], s[7 * 65]);
        const int drow = rowmap(j.mode, n0 + n);
        *(GAS u32x4*)(WT + (size_t)drow * j.K + k0 + 8 * c8) = o;
        if (j.lnb) { float sv = ((bflo(o.x) + bfhi(o.x)) + (bflo(o.y) + bfhi(o.y))) + ((bflo(o.z) + bfhi(o.z)) + (bflo(o.w) + bfhi(o.w)));
            sv += shx(sv, 1); sv += shx(sv, 2); sv += shx(sv, 4);
            if (c8 == 0) tmp[64 + n] = sv; } }
    LDS_WAIT(); asm volatile("" ::: "memory");
    if (j.lnb) {
        const int drow = rowmap(j.mode, n0 + lane);
        unsafeAtomicAdd(j.sn + SNT_N + drow, tmp[lane]); unsafeAtomicAdd(j.sn + drow, tmp[64 + lane]);
        LDS_WAIT(); asm volatile("" ::: "memory");
    }
}
__device__ __forceinline__ void cvt_rows(const Frame& F, const float* src, bf16* dst, size_t n) {
    for (size_t i = ((size_t)F.gw * 64 + LANE_) * 8; i < n; i += (size_t)F.NGW * 64 * 8) {
        const f32x4 a = __builtin_nontemporal_load((const f32x4*)(src + i)), b = __builtin_nontemporal_load((const f32x4*)(src + i + 4));
        u32x4 o; o.x = pk2(a.x, a.y); o.y = pk2(a.z, a.w); o.z = pk2(b.x, b.y); o.w = pk2(b.z, b.w);
        *(u32x4*)(dst + i) = o; }
}
__device__ __forceinline__ int t5_bucket(int dist) {
    if (dist < 16) return dist;
    const float df = (float)dist;
    int large = 16 + (int)(logf(df / 16.0f) / logf(128.0f) * 16.0f);
    return large < 31 ? large : 31;
}
__device__ __forceinline__ void p0_prologue(const Frame& F_, int l) {
    Frame F = F_;  F.ws = F_.ws + szero();
    LAS float* scr = (LAS float*)(F.lds + F.wave * 16640);
    LAS float* tmp = (LAS float*)(F.lds + 8 * 16640 + F.wave * 512);
#define TRJOB(SRC, LDW, KK, NN, DSTOFF, MODE, KS, LNB, SNOFF) if (!j.hit) { const int items = ((KK) / 64) * ((NN) / 64); if (r < items) { j.hit = true; j.src = (SRC); j.ldw = (LDW); j.K = (KK); j.nblk = (NN) / 64; \
        j.dstoff = (DSTOFF); j.mode = (MODE); j.ks = (KS); j.lnb = (LNB); j.sn = snt + (SNOFF); j.r = r; } else r -= items; }
    const float* wg = INP(4) + (size_t)l * 2 * D * FF; const float* wu = INP(5) + (size_t)l * 2 * D * FF; const float* wd = INP(6) + (size_t)l * 2 * FF * D;
    const float* win = INP(7) + (size_t)l * D * N_IN_SRC;
    const float* wbr = INP(17) + (size_t)l * D * D;
    const float* lng = INP(2); const float* lnb = INP(3);
    const float* g_f0 = l ? lng + (size_t)((l - 1) * 4 + 3) * D : nullptr; const float* b_f0 = l ? lnb + (size_t)((l - 1) * 4 + 3) * D : nullptr;
    const float* g_m = lng + (size_t)(l * 4 + 0) * D; const float* b_m = lnb + (size_t)(l * 4 + 0) * D;
    const float* g_x = lng + (size_t)(l * 4 + 1) * D; const float* b_x = lnb + (size_t)(l * 4 + 1) * D;
    const float* g_f1 = lng + (size_t)(l * 4 + 2) * D; const float* b_f1 = lnb + (size_t)(l * 4 + 2) * D;
    float* snt = (float*)(F.ws + CTL_SNT) + (size_t)l * 2 * SNT_N;
    constexpr int ITEMS = 6 * (D / 64) * (FF / 64) + (D / 64) * (N_IN_SRC / 64) + (512 / 64) * ((QW + KVW) / 64) + 2 * (D / 64) * (D / 64) + (D / 64) * ((512 + 1024) / 64) + (512 / 64) * (D / 64);
    auto select = [&](int it) -> TrJob {
        TrJob j; j.hit = false; j.src = nullptr; j.ks = nullptr; j.lnb = nullptr; j.sn = nullptr; j.ldw = 0; j.K = 0; j.nblk = 1; j.mode = 0; j.r = 0; j.dstoff = 0;
        if (it >= ITEMS) return j;
        int r = it;
        TRJOB(wg, FF, D, FF, W_GU0, 1, g_f0, b_f0, SNT_FFN0)
        TRJOB(wu, FF, D, FF, W_GU0, 2, g_f0, b_f0, SNT_FFN0)
        TRJOB(wd, D, FF, D, W_D0, 0, nullptr, nullptr, 0)
        TRJOB(wg + (size_t)D * FF, FF, D, FF, W_GU1, 1, g_f1, b_f1, SNT_FFN1)
        TRJOB(wu + (size_t)D * FF, FF, D, FF, W_GU1, 2, g_f1, b_f1, SNT_FFN1)
        TRJOB(wd + (size_t)FF * D, D, FF, D, W_D1, 0, nullptr, nullptr, 0)
        TRJOB(win, N_IN_SRC, D, NWIN_SRC, W_IN, 3, g_m, b_m, SNT_WIN)
        TRJOB(win + NWIN_SRC, N_IN_SRC, D, NGATE, W_GATE, 0, g_m, b_m, SNT_GATE)
        TRJOB(INP(10) + (size_t)l * 512 * QW, QW, 512, QW, W_UQ, 4, INP(8) + l * 512, nullptr, 0)
        TRJOB(INP(11) + (size_t)l * 512 * KVW, KVW, 512, KVW, W_UKV, 0, INP(9) + l * 512, nullptr, 0)
        TRJOB(wbr, D, D, D, W_PA, 0, nullptr, nullptr, 0)
        TRJOB(INP(18) + (size_t)l * D * D, D, D, D, W_OUT, 0, nullptr, nullptr, 0)
        TRJOB(INP(19) + (size_t)l * D * 512, 512, D, 512, W_XQ, 0, g_x, b_x, SNT_XQ)
        TRJOB(INP(20) + (size_t)l * D * 1024, 1024, D, 1024, W_XKV, 0, nullptr, nullptr, 0)
        TRJOB(INP(21) + (size_t)l * 512 * D, D, 512, D, W_XO, 0, nullptr, nullptr, 0)
        return j;
    };
    {
        f32x4 va[16], vb[16];
        int it = F.gw; TrJob ja = select(it); if (ja.hit) tr_load(ja, va, LANE_);
        while (ja.hit) {
            TrJob jb = select(it + F.NGW); if (jb.hit) tr_load(jb, vb, LANE_);
            tr_store(ja, va, F.ws, scr, tmp, LANE_);
            if (!jb.hit) break;
            it += 2 * F.NGW; ja = select(it); if (ja.hit) tr_load(ja, va, LANE_);
            tr_store(jb, vb, F.ws, scr, tmp, LANE_);
        }
    }
#undef TRJOB
    { bf16* pad = wsp<bf16>(F, W_IN) + (size_t)NWIN_SRC * D; const size_t n = (size_t)(NWIN - NWIN_SRC) * D;
      const unsigned z_ = (unsigned)vlaunder(0);
      for (size_t i = ((size_t)F.gw * 64 + LANE_) * 8; i < n; i += (size_t)F.NGW * 64 * 8) *(u32x4*)(pad + i) = (u32x4){z_, z_, z_, z_}; }
    { const float* ws_ = INP(14) + (size_t)l * 4 * 128 * 128; bf16* o = wsp<bf16>(F, TAB_SGUW);
      for (int i = F.gw * 64 + LANE_; i < 4 * 128 * 128; i += F.NGW * 64) { const int t = (i >> 7) & 127, s = i & 127; o[i] = (bf16)(pk2(s <= t ? ws_[i] : 0.f, 0.f) & 0xffffu); } }
    if (l == 0) {
        cvt_rows(F, INP(0), wsp<bf16>(F, WS_XB), (size_t)M * D);
        cvt_rows(F, INP(1), wsp<bf16>(F, WS_MEMB), (size_t)BATCH * MEM * D);
        float* cosT = wsp<float>(F, TAB_COS); float* sinT = wsp<float>(F, TAB_SIN);
        for (int i = F.gw * 64 + LANE_; i < SEQ * 32; i += F.NGW * 64) { const int pos = i >> 5, j = i & 31;
            const float inv = powf(10000.0f, -(float)(2 * j) / 64.0f); const float ang = (float)pos * inv; cosT[i] = cosf(ang); sinT[i] = sinf(ang); }
        float* bt = wsp<float>(F, TAB_BIAS); const float* rel = INP(16);
        for (int i = F.gw * 64 + LANE_; i < 12 * BIAS_STRIDE; i += F.NGW * 64) { const int gh = i / BIAS_STRIDE, j = i - gh * BIAS_STRIDE; const int g = gh >> 2;
            const int dil = g == 0 ? 1 : (g == 1 ? 4 : 16);
            bt[i] = j <= 128 ? rel[t5_bucket(j * dil) * 12 + gh] * LOG2E : 0.f; }
    }
}

__device__ __forceinline__ void ln_final(const Frame& F, const bf16* ZH, const bf16* ZLo, float* out, const float* g, const float* b) {
    const int lane_ = vlaunder(LANE_);
    for (int m = F.gw; m < M; m += F.NGW) {
        const GAS u32x4* hr = (const GAS u32x4*)(ZH + (size_t)m * D) + lane_; const GAS u32x4* lr = (const GAS u32x4*)(ZLo + (size_t)m * D) + lane_;
        float v[4][8]; float s = 0.f;
#pragma unroll
        for (int j = 0; j < 4; ++j) { const u32x4 h = hr[64 * j], l = lr[64 * j];
            v[j][0] = bflo(h.x) + bflo(l.x); v[j][1] = bfhi(h.x) + bfhi(l.x); v[j][2] = bflo(h.y) + bflo(l.y); v[j][3] = bfhi(h.y) + bfhi(l.y);
            v[j][4] = bflo(h.z) + bflo(l.z); v[j][5] = bfhi(h.z) + bfhi(l.z); v[j][6] = bflo(h.w) + bflo(l.w); v[j][7] = bfhi(h.w) + bfhi(l.w);
#pragma unroll
            for (int e = 0; e < 8; ++e) s += v[j][e]; }
        const float mean = wave_sum(s) * (1.f / D); float s2 = 0.f;
#pragma unroll
        for (int j = 0; j < 4; ++j)
#pragma unroll
            for (int e = 0; e < 8; ++e) { v[j][e] -= mean; s2 += v[j][e] * v[j][e]; }
        const float rstd = 1.f / sqrtf(wave_sum(s2) * (1.f / D) + LN_EPS);
        GAS f32x4* orow = (GAS f32x4*)(out + (size_t)m * D);
#pragma unroll
        for (int j = 0; j < 4; ++j) { const int c = 8 * (lane_ + 64 * j);
            const f32x4 g0 = *(const f32x4*)(g + c), g1 = *(const f32x4*)(g + c + 4), b0 = *(const f32x4*)(b + c), b1 = *(const f32x4*)(b + c + 4);
            orow[2 * (lane_ + 64 * j)] = (f32x4){v[j][0] * rstd * g0.x + b0.x, v[j][1] * rstd * g0.y + b0.y, v[j][2] * rstd * g0.z + b0.z, v[j][3] * rstd * g0.w + b0.w};
            orow[2 * (lane_ + 64 * j) + 1] = (f32x4){v[j][4] * rstd * g1.x + b1.x, v[j][5] * rstd * g1.y + b1.y, v[j][6] * rstd * g1.z + b1.z, v[j][7] * rstd * g1.w + b1.w}; }
    }
}

constexpr int AT_KN = 0, AT_KR = 16384, AT_V = 24576, AT_BUF = 43008, AT_BIAS = 4 * (16384 + 18432);
constexpr int VPITCH = 288;
template <int DK, int QT, int NWV, class Src, class Msk, bool PIPE = false>
__device__ __forceinline__ void attn_unit(const Frame& F, const Src& src, const Msk& msk, int kt0, int kt1) {
    constexpr int KS = DK / 32, NKC = DK == 192 ? 3 : 2, NT = 64 * NWV, NI = 1024 / NT, BUFB = (NWV == 8) ? AT_BUF : (AT_KR + 18432), OFF_V = (NWV == 8) ? AT_V : AT_KR;
    static_assert(NWV == 8 || DK == 128, "the half-workgroup form has no rope buffer");
    const int tid_ = vlaunder(TID_), lane = tid_ & 63, tid = tid_ & (NT - 1), w = F.wave & (NWV - 1), q16 = lane & 15, kq = lane >> 4;
    LAS unsigned char* lds = F.lds + (F.wave / NWV) * (2 * BUFB);
    bf16x8 qf[QT][KS];
#pragma unroll
    for (int qt = 0; qt < QT; ++qt) { const bf16* qr = src.qrow(w * 16 * QT + 16 * qt + q16);
#pragma unroll
        for (int ks = 0; ks < KS; ++ks) qf[qt][ks] = *(const bf16x8*)(qr + 32 * ks + 8 * kq); }
    f32x4 o[QT][8];
    float mrun[QT], lrun[QT];
    float z0 = 0.f; asm volatile("" : "+v"(z0));
#pragma unroll
    for (int qt = 0; qt < QT; ++qt) { mrun[qt] = NEGBIG; lrun[qt] = z0;
#pragma unroll
        for (int dt = 0; dt < 8; ++dt) o[qt][dt] = (f32x4){z0, z0, z0, z0}; }
    u32x4 kr[NI + (DK == 192 ? 1 : 0)], vr[NI];
#define AT_LOAD(kt) do { const int kb = 64 * (kt); \
        _Pragma("unroll") for (int i = 0; i < NI; ++i) { const int it = tid + NT * i, row = it >> 4, ch = it & 15; kr[i] = *(const u32x4*)src.kptr(kb + row, ch); vr[i] = *(const u32x4*)src.vptr(kb + row, ch); } \
        if (DK == 192) { const int row = tid >> 3, ch = tid & 7; kr[NI] = *(const u32x4*)src.kptr(kb + row, 16 + ch); } } while (0)
#define AT_STORE(buf) do { LAS unsigned char* bb = lds + (buf) * BUFB; \
        _Pragma("unroll") for (int i = 0; i < NI; ++i) { const int it = tid + NT * i, row = it >> 4, ch = it & 15; \
            *(LAS u32x4*)(bb + AT_KN + row * 256 + ((ch ^ (row & 15)) << 4)) = kr[i]; *(LAS u32x4*)(bb + OFF_V + row * VPITCH + (ch << 4)) = vr[i]; } \
        if (DK == 192) { const int row = tid >> 3, ch = tid & 7; *(LAS u32x4*)(bb + AT_KR + row * 128 + ((ch ^ ((row >> 1) & 7)) << 4)) = kr[NI]; } } while (0)
    if constexpr (PIPE) {
    static_assert(NWV == 8, "pipelined form: one unit per workgroup");
#define AT_LOADK(kt) do { const int kb = 64 * (kt); \
        _Pragma("unroll") for (int i = 0; i < NI; ++i) { const int it = tid + NT * i, row = it >> 4, ch = it & 15; kr[i] = *(const u32x4*)src.kptr(kb + row, ch); } \
        if (DK == 192) { const int row = tid >> 3, ch = tid & 7; kr[NI] = *(const u32x4*)src.kptr(kb + row, 16 + ch); } } while (0)
#define AT_LOADV(kt) do { const int kb = 64 * (kt); \
        _Pragma("unroll") for (int i = 0; i < NI; ++i) { const int it = tid + NT * i, row = it >> 4, ch = it & 15; vr[i] = *(const u32x4*)src.vptr(kb + row, ch); } } while (0)
#define AT_KBUF(slot) (lds + ((slot) < 2 ? (slot) * BUFB : 2 * BUFB))
#define AT_STOREK(slot) do { LAS unsigned char* bb = AT_KBUF(slot); \
        _Pragma("unroll") for (int i = 0; i < NI; ++i) { const int it = tid + NT * i, row = it >> 4, ch = it & 15; *(LAS u32x4*)(bb + AT_KN + row * 256 + ((ch ^ (row & 15)) << 4)) = kr[i]; } \
        if (DK == 192) { const int row = tid >> 3, ch = tid & 7; *(LAS u32x4*)(bb + AT_KR + row * 128 + ((ch ^ ((row >> 1) & 7)) << 4)) = kr[NI]; } } while (0)
#define AT_STOREV(buf) do { LAS unsigned char* bb = lds + (buf) * BUFB; \
        _Pragma("unroll") for (int i = 0; i < NI; ++i) { const int it = tid + NT * i, row = it >> 4, ch = it & 15; *(LAS u32x4*)(bb + OFF_V + row * VPITCH + (ch << 4)) = vr[i]; } } while (0)
#define AT_QKH(S_, slot, h) do { const LAS unsigned char* bb = AT_KBUF(slot); \
        _Pragma("unroll") for (int qt = 0; qt < QT; ++qt) _Pragma("unroll") for (int s2 = 0; s2 < 2; ++s2) S_[qt][s2] = (f32x4){0.f, 0.f, 0.f, 0.f}; \
        _Pragma("unroll") for (int s2 = 0; s2 < 2; ++s2) { const int row = 16 * (2 * (h) + s2) + q16; \
            _Pragma("unroll") for (int ks = 0; ks < KS; ++ks) { bf16x8 kf; \
                if (ks < 4) kf = *(const LAS bf16x8*)(bb + AT_KN + row * 256 + (((4 * ks + kq) ^ q16) << 4)); \
                else        kf = *(const LAS bf16x8*)(bb + AT_KR + row * 128 + (((4 * (ks - 4) + kq) ^ (q16 >> 1)) << 4)); \
                _Pragma("unroll") for (int qt = 0; qt < QT; ++qt) S_[qt][s2] = __builtin_amdgcn_mfma_f32_16x16x32_bf16(kf, qf[qt][ks], S_[qt][s2], 0, 0, 0); } } } while (0)
#define AT_SMPV(S_, kt, h, vbuf) do { bf16x8 pf[QT]; \
        _Pragma("unroll") for (int qt = 0; qt < QT; ++qt) { const int ql = w * 16 * QT + 16 * qt + q16; float mx = NEGBIG; \
            _Pragma("unroll") for (int s2 = 0; s2 < 2; ++s2) _Pragma("unroll") for (int j = 0; j < 4; ++j) { const float v = msk.apply(S_[qt][s2][j], ql, 64 * (kt) + 32 * (h) + 16 * s2 + 4 * kq + j); S_[qt][s2][j] = v; mx = fmaxf(mx, v); } \
            mx = xmax_16_32(mx); \
            const float mnew = fmaxf(mrun[qt], mx), alpha = __builtin_amdgcn_exp2f(mrun[qt] - mnew); mrun[qt] = mnew; float rs = 0.f; \
            _Pragma("unroll") for (int s2 = 0; s2 < 2; ++s2) _Pragma("unroll") for (int j = 0; j < 4; ++j) { const float p = __builtin_amdgcn_exp2f(S_[qt][s2][j] - mnew); S_[qt][s2][j] = p; rs += p; } \
            lrun[qt] = lrun[qt] * alpha + rs; \
            _Pragma("unroll") for (int dt = 0; dt < 8; ++dt) o[qt][dt] *= alpha; \
            u32x4 pw; pw.x = pk2(S_[qt][0][0], S_[qt][0][1]); pw.y = pk2(S_[qt][0][2], S_[qt][0][3]); pw.z = pk2(S_[qt][1][0], S_[qt][1][1]); pw.w = pk2(S_[qt][1][2], S_[qt][1][3]); \
            pf[qt] = __builtin_bit_cast(bf16x8, pw); } \
        const LAS unsigned char* vb = lds + (vbuf) * BUFB + OFF_V + (4 * kq + (q16 >> 2)) * VPITCH + (q16 & 3) * 8; \
        _Pragma("unroll") for (int dt = 0; dt < 8; ++dt) { \
            const s16x4 lo = __builtin_bit_cast(s16x4, __builtin_amdgcn_ds_read_tr16_b64_v4i16((LAS s16x4*)(vb + (32 * (h)) * VPITCH + dt * 32))); \
            const s16x4 hi = __builtin_bit_cast(s16x4, __builtin_amdgcn_ds_read_tr16_b64_v4i16((LAS s16x4*)(vb + (32 * (h) + 16) * VPITCH + dt * 32))); \
            const bf16x8 vf = __builtin_shufflevector(lo, hi, 0, 1, 2, 3, 4, 5, 6, 7); \
            _Pragma("unroll") for (int qt = 0; qt < QT; ++qt) o[qt][dt] = __builtin_amdgcn_mfma_f32_16x16x32_bf16(vf, pf[qt], o[qt][dt], 0, 0, 0); } } while (0)
    f32x4 sa[QT][2], sb[QT][2];
    AT_LOADK(kt0); AT_LOADV(kt0); AT_STOREK(0); AT_STOREV(0);
    if (kt0 + 1 < kt1) { AT_LOADK(kt0 + 1); AT_STOREK(1); }
    __syncthreads();
    if (msk.active(w, kt0)) AT_QKH(sa, 0, 0);
    int k0 = 0, k1 = 1, k2 = 2;
    for (int kt = kt0; kt < kt1; ++kt) {
        const int buf = (kt - kt0) & 1;
        if (kt + 2 < kt1) AT_LOADK(kt + 2);
        if (kt + 1 < kt1) AT_LOADV(kt + 1);
        const bool act = msk.active(w, kt), actn = (kt + 1 < kt1) && msk.active(w, kt + 1);
        if (act) { AT_QKH(sb, k0, 1); AT_SMPV(sa, kt, 0, buf); }
        if (actn) AT_QKH(sa, k1, 0);
        if (act) AT_SMPV(sb, kt, 1, buf);
        if (kt + 2 < kt1) AT_STOREK(k2);
        if (kt + 1 < kt1) AT_STOREV(buf ^ 1);
        __syncthreads();
        { const int t_ = k0; k0 = k1; k1 = k2; k2 = t_; }
    }
#undef AT_LOADK
#undef AT_LOADV
#undef AT_KBUF
#undef AT_STOREK
#undef AT_STOREV
#undef AT_QKH
#undef AT_SMPV
    } else {
    AT_LOAD(kt0); AT_STORE(0);
    __syncthreads();
    for (int kt = kt0; kt < kt1; ++kt) {
        const int buf = (kt - kt0) & 1;
        if (kt + 1 < kt1) AT_LOAD(kt + 1);
        if (msk.active(w, kt)) {
            const LAS unsigned char* bb = lds + buf * BUFB;
            f32x4 s[QT][4];
#pragma unroll
            for (int qt = 0; qt < QT; ++qt)
#pragma unroll
                for (int sub = 0; sub < 4; ++sub) s[qt][sub] = (f32x4){0.f, 0.f, 0.f, 0.f};
            {
                constexpr int KR = 5, NSTEP = 4 * KS;
                bf16x8 kfr[KR];
#define AT_KS_(idx) ((idx) >> 2)
#define AT_SUB_(idx) ((idx) & 3)
#define AT_KF(idx) (AT_KS_(idx) < 4 ? *(const LAS bf16x8*)(bb + AT_KN + (16 * AT_SUB_(idx) + q16) * 256 + (((4 * AT_KS_(idx) + kq) ^ q16) << 4)) \
                                     : *(const LAS bf16x8*)(bb + AT_KR + (16 * AT_SUB_(idx) + q16) * 128 + (((4 * (AT_KS_(idx) - 4) + kq) ^ (q16 >> 1)) << 4)))
#pragma unroll
                for (int i = 0; i < KR - 1; ++i) kfr[i] = AT_KF(i);
#pragma unroll
                for (int idx = 0; idx < NSTEP; ++idx) {
                    if (idx + KR - 1 < NSTEP) kfr[(idx + KR - 1) % KR] = AT_KF(idx + KR - 1);
#pragma unroll
                    for (int qt = 0; qt < QT; ++qt) s[qt][AT_SUB_(idx)] = __builtin_amdgcn_mfma_f32_16x16x32_bf16(kfr[idx % KR], qf[qt][AT_KS_(idx)], s[qt][AT_SUB_(idx)], 0, 0, 0);
                }
#undef AT_KF
#undef AT_KS_
#undef AT_SUB_
            }
            bf16x8 pf[QT][2];
#pragma unroll
            for (int qt = 0; qt < QT; ++qt) {
                const int ql = w * 16 * QT + 16 * qt + q16;
                float mx = NEGBIG;
#pragma unroll
                for (int sub = 0; sub < 4; ++sub)
#pragma unroll
                    for (int j = 0; j < 4; ++j) { const float v = msk.apply(s[qt][sub][j], ql, 64 * kt + 16 * sub + 4 * kq + j); s[qt][sub][j] = v; mx = fmaxf(mx, v); }
                mx = xmax_16_32(mx);
                const float mnew = fmaxf(mrun[qt], mx), alpha = __builtin_amdgcn_exp2f(mrun[qt] - mnew);
                mrun[qt] = mnew;
                float rs = 0.f;
#pragma unroll
                for (int sub = 0; sub < 4; ++sub)
#pragma unroll
                    for (int j = 0; j < 4; ++j) { const float p = __builtin_amdgcn_exp2f(s[qt][sub][j] - mnew); s[qt][sub][j] = p; rs += p; }
                lrun[qt] = lrun[qt] * alpha + rs;
#pragma unroll
                for (int dt = 0; dt < 8; ++dt) o[qt][dt] *= alpha;
#pragma unroll
                for (int c = 0; c < 2; ++c) {
                    u32x4 pw; pw.x = pk2(s[qt][2 * c][0], s[qt][2 * c][1]); pw.y = pk2(s[qt][2 * c][2], s[qt][2 * c][3]);
                    pw.z = pk2(s[qt][2 * c + 1][0], s[qt][2 * c + 1][1]); pw.w = pk2(s[qt][2 * c + 1][2], s[qt][2 * c + 1][3]);
                    pf[qt][c] = __builtin_bit_cast(bf16x8, pw);
                }
            }
            const LAS unsigned char* vb = bb + OFF_V + (4 * kq + (q16 >> 2)) * VPITCH + (q16 & 3) * 8;
            {
                constexpr int VR = 4;
                s16x4 vlo[VR], vhi[VR];
#define AT_VLO(st) __builtin_bit_cast(s16x4, __builtin_amdgcn_ds_read_tr16_b64_v4i16((LAS s16x4*)(vb + (32 * ((st) >> 3)) * VPITCH + ((st) & 7) * 32)))
#define AT_VHI(st) __builtin_bit_cast(s16x4, __builtin_amdgcn_ds_read_tr16_b64_v4i16((LAS s16x4*)(vb + (32 * ((st) >> 3) + 16) * VPITCH + ((st) & 7) * 32)))
#pragma unroll
                for (int i = 0; i < VR - 1; ++i) { vlo[i] = AT_VLO(i); vhi[i] = AT_VHI(i); }
#pragma unroll
                for (int st = 0; st < 16; ++st) {
                    if (st + VR - 1 < 16) { vlo[(st + VR - 1) % VR] = AT_VLO(st + VR - 1); vhi[(st + VR - 1) % VR] = AT_VHI(st + VR - 1); }
                    const bf16x8 vf = __builtin_shufflevector(vlo[st % VR], vhi[st % VR], 0, 1, 2, 3, 4, 5, 6, 7);
#pragma unroll
                    for (int qt = 0; qt < QT; ++qt) o[qt][st & 7] = __builtin_amdgcn_mfma_f32_16x16x32_bf16(vf, pf[qt][st >> 3], o[qt][st & 7], 0, 0, 0);
                }
#undef AT_VLO
#undef AT_VHI
            }
        }
        if (kt + 1 < kt1) AT_STORE(buf ^ 1);
        __syncthreads();
    }
    }
#undef AT_LOAD
#undef AT_STORE
#pragma unroll
    for (int qt = 0; qt < QT; ++qt) {
        float l = xsum_16_32(lrun[qt]);
        const float inv = 1.0f / l;
        const int ql = w * 16 * QT + 16 * qt + q16;
        bf16* orow = src.orow(ql);
#pragma unroll
        for (int dt = 0; dt < 8; ++dt) { const f32x4 v = o[qt][dt] * inv; *(u32x2*)(orow + 16 * dt + 4 * kq) = (u32x2){pk2(v.x, v.y), pk2(v.z, v.w)}; }
        if (kq == 0) src.put_lse(ql, (mrun[qt] + __builtin_amdgcn_logf(l)) * LN2);
    }
}

struct MlaSrc {
    const bf16* Q; const bf16* KV; const bf16* KPE; bf16* O; size_t rb; int h, q0;
    __device__ __forceinline__ const bf16* qrow(int r) const { return Q + (rb + q0 + r) * QW + h * 192; }
    __device__ __forceinline__ const bf16* kptr(int key, int ch) const { return ch < 16 ? KV + (rb + key) * KVW + h * 256 + ch * 8 : KPE + (rb + key) * 64 + (ch - 16) * 8; }
    __device__ __forceinline__ const bf16* vptr(int key, int ch) const { return KV + (rb + key) * KVW + h * 256 + 128 + ch * 8; }
    __device__ __forceinline__ bf16* orow(int r) const { return O + (rb + q0 + r) * 1024 + h * 128; }
    __device__ __forceinline__ void put_lse(int, float) const {}
};
struct MlaMsk {
    int q0; float c;
    __device__ __forceinline__ bool active(int w, int kt) const { return 64 * kt <= q0 + 32 * w + 31; }
    __device__ __forceinline__ float apply(float s, int ql, int key) const { return key <= q0 + ql ? s * c : NEGBIG; }
};
struct XaSrc {
    const bf16* Q; const bf16* KVX; bf16* O; size_t rb, kb; int h, q0;
    __device__ __forceinline__ const bf16* qrow(int r) const { return Q + (rb + q0 + r) * 512 + h * 128; }
    __device__ __forceinline__ const bf16* kptr(int key, int ch) const { return KVX + (kb + key) * 1024 + h * 128 + ch * 8; }
    __device__ __forceinline__ const bf16* vptr(int key, int ch) const { return KVX + (kb + key) * 1024 + 512 + h * 128 + ch * 8; }
    __device__ __forceinline__ bf16* orow(int r) const { return O + (rb + q0 + r) * 512 + h * 128; }
    __device__ __forceinline__ void put_lse(int, float) const {}
};
struct XaMsk {
    float c;
    __device__ __forceinline__ bool active(int, int) const { return true; }
    __device__ __forceinline__ float apply(float s, int, int) const { return s * c; }
};
struct DilSrc {
    bf16* QKV; float* LSE; size_t rb; int dil, r, n, col;
    __device__ __forceinline__ size_t row(int sub) const { return rb + (size_t)sub * dil + r; }
    __device__ __forceinline__ const bf16* qrow(int q) const { return QKV + row(128 * n + q) * QKVW + col; }
    __device__ __forceinline__ const bf16* kptr(int k, int ch) const { return QKV + row(128 * (n - 1) + k) * QKVW + 1536 + col + ch * 8; }
    __device__ __forceinline__ const bf16* vptr(int k, int ch) const { return QKV + row(128 * (n - 1) + k) * QKVW + 3072 + col + ch * 8; }
    __device__ __forceinline__ bf16* orow(int q) const { return QKV + row(128 * n + q) * QKVW + col; }
    __device__ __forceinline__ void put_lse(int q, float v) const { LSE[row(128 * n + q) * 4] = v; }
};
struct DilMsk {
    const LAS float* bias; float c;
    __device__ __forceinline__ bool active(int w, int kt) const { return 64 * kt + 63 >= 32 * w && 64 * kt <= 32 * w + 31 + 128; }
    __device__ __forceinline__ float apply(float s, int ql, int k) const { const int j = ql + 128 - k; const int jc = j < 0 ? 0 : (j > 128 ? 128 : j); const float bv = bias[jc]; return (j >= 0 && j <= 128) ? s * c + bv : NEGBIG; }
};

constexpr int SG_PITCH = 1056;
__device__ __forceinline__ void sgu_unit(const Frame& F, bf16* Z, const float* lng, const float* lnb, const bf16* SW, const float* bs, int unit) {
    const int lane = vlaunder(LANE_), w = F.wave, q16 = lane & 15, kq = lane >> 4;
    const size_t m0 = (size_t)unit * 128;
    LAS unsigned char* lds = F.lds;
    float gg[8], bb[8];
    { const f32x4 g0 = *(const f32x4*)(lng + 8 * lane), g1 = *(const f32x4*)(lng + 8 * lane + 4), b0 = *(const f32x4*)(lnb + 8 * lane), b1 = *(const f32x4*)(lnb + 8 * lane + 4);
      gg[0] = g0.x; gg[1] = g0.y; gg[2] = g0.z; gg[3] = g0.w; gg[4] = g1.x; gg[5] = g1.y; gg[6] = g1.z; gg[7] = g1.w;
      bb[0] = b0.x; bb[1] = b0.y; bb[2] = b0.z; bb[3] = b0.w; bb[4] = b1.x; bb[5] = b1.y; bb[6] = b1.z; bb[7] = b1.w; }
#pragma unroll 1
    for (int hb = 0; hb < 2; ++hb) {
        u32x4 raw[8]; float s[8], q[8];
#pragma unroll
        for (int i = 0; i < 8; ++i) raw[i] = *(const u32x4*)(Z + (m0 + 16 * w + 8 * hb + i) * ZW + 512 + 8 * lane);
#pragma unroll
        for (int i = 0; i < 8; ++i) s[i] = ((bflo(raw[i].x) + bfhi(raw[i].x)) + (bflo(raw[i].y) + bfhi(raw[i].y))) + ((bflo(raw[i].z) + bfhi(raw[i].z)) + (bflo(raw[i].w) + bfhi(raw[i].w)));
#pragma unroll
        for (int o = 1; o < 64; o <<= 1) {
#pragma unroll
            for (int i = 0; i < 8; ++i) s[i] += shx_l(s[i], o, lane); }
#pragma unroll
        for (int i = 0; i < 8; ++i) { const float mean = s[i] * (1.f / 512.f); s[i] = mean;
            const float v[8] = {bflo(raw[i].x) - mean, bfhi(raw[i].x) - mean, bflo(raw[i].y) - mean, bfhi(raw[i].y) - mean, bflo(raw[i].z) - mean, bfhi(raw[i].z) - mean, bflo(raw[i].w) - mean, bfhi(raw[i].w) - mean};
            float a2 = 0.f;
#pragma unroll
            for (int j = 0; j < 8; ++j) a2 += v[j] * v[j];
            q[i] = a2; }
#pragma unroll
        for (int o = 1; o < 64; o <<= 1) {
#pragma unroll
            for (int i = 0; i < 8; ++i) q[i] += shx_l(q[i], o, lane); }
#pragma unroll
        for (int i = 0; i < 8; ++i) { const float mean = s[i], rstd = 1.f / sqrtf(q[i] * (1.f / 512.f) + LN_EPS);
            float v[8] = {bflo(raw[i].x), bfhi(raw[i].x), bflo(raw[i].y), bfhi(raw[i].y), bflo(raw[i].z), bfhi(raw[i].z), bflo(raw[i].w), bfhi(raw[i].w)};
#pragma unroll
            for (int j = 0; j < 8; ++j) v[j] = (v[j] - mean) * rstd * gg[j] + bb[j];
            u32x4 o; o.x = pk2(v[0], v[1]); o.y = pk2(v[2], v[3]); o.z = pk2(v[4], v[5]); o.w = pk2(v[6], v[7]);
            *(LAS u32x4*)(lds + (16 * w + 8 * hb + i) * SG_PITCH + lane * 16) = o; }
    }
    __syncthreads();
    const int g = w >> 1, th = w & 1;
    bf16x8 wf[4][4];
#pragma unroll
    for (int tt = 0; tt < 4; ++tt) { const bf16* wr_ = SW + (size_t)g * 128 * 128 + (size_t)(16 * (4 * th + tt) + q16) * 128;
#pragma unroll
        for (int ks = 0; ks < 4; ++ks) { const u32x2 a = *(const u32x2*)(wr_ + 32 * ks + 4 * kq), b = *(const u32x2*)(wr_ + 32 * ks + 16 + 4 * kq);
            wf[tt][ks] = __builtin_bit_cast(bf16x8, (u32x4){a.x, a.y, b.x, b.y}); } }
    const LAS unsigned char* vb = lds + (4 * kq + (q16 >> 2)) * SG_PITCH + g * 256 + (q16 & 3) * 8;
    float bias4[4];
#pragma unroll
    for (int tt = 0; tt < 4; ++tt) bias4[tt] = bs[g * 128 + 16 * (4 * th + tt) + q16];
    u32x2 uu[4], un[4];
#pragma unroll
    for (int tt = 0; tt < 4; ++tt) uu[tt] = *(const u32x2*)(Z + (m0 + 16 * (4 * th + tt) + q16) * ZW + g * 128 + 4 * kq);
#pragma unroll 1
    for (int dt = 0; dt < 8; ++dt) {
        f32x4 acc[4];
#pragma unroll
        for (int tt = 0; tt < 4; ++tt) acc[tt] = (f32x4){0.f, 0.f, 0.f, 0.f};
        if (dt < 7) {
#pragma unroll
            for (int tt = 0; tt < 4; ++tt) un[tt] = *(const u32x2*)(Z + (m0 + 16 * (4 * th + tt) + q16) * ZW + g * 128 + 16 * (dt + 1) + 4 * kq);
        }
#pragma unroll
        for (int ks = 0; ks < 4; ++ks) {
            const s16x4 lo = __builtin_bit_cast(s16x4, __builtin_amdgcn_ds_read_tr16_b64_v4i16((LAS s16x4*)(vb + (32 * ks) * SG_PITCH + dt * 32)));
            const s16x4 hi = __builtin_bit_cast(s16x4, __builtin_amdgcn_ds_read_tr16_b64_v4i16((LAS s16x4*)(vb + (32 * ks + 16) * SG_PITCH + dt * 32)));
            const bf16x8 af = __builtin_shufflevector(lo, hi, 0, 1, 2, 3, 4, 5, 6, 7);
#pragma unroll
            for (int tt = 0; tt < 4; ++tt) acc[tt] = __builtin_amdgcn_mfma_f32_16x16x32_bf16(af, wf[tt][ks], acc[tt], 0, 0, 0);
        }
#pragma unroll
        for (int tt = 0; tt < 4; ++tt) {
            const int t = 16 * (4 * th + tt) + q16;
            const float bias = bias4[tt];
            bf16* up = Z + (m0 + t) * ZW + g * 128 + 16 * dt + 4 * kq;
            const float o0 = bflo(uu[tt].x) * (acc[tt].x + bias), o1 = bfhi(uu[tt].x) * (acc[tt].y + bias), o2 = bflo(uu[tt].y) * (acc[tt].z + bias), o3 = bfhi(uu[tt].y) * (acc[tt].w + bias);
            *(u32x2*)up = (u32x2){pk2(o0, o1), pk2(o2, o3)};
        }
#pragma unroll
        for (int tt = 0; tt < 4; ++tt) uu[tt] = un[tt];
    }
    __syncthreads();
}

__device__ __forceinline__ void dil_combine(const Frame& F, const bf16* QKV, const float* LSE, bf16* OC) {
    const int lane = vlaunder(LANE_), hh = lane >> 4;
    for (int m = F.gw; m < M; m += F.NGW) {
        const float l0 = LSE[((size_t)0 * M + m) * 4 + hh], l1 = LSE[((size_t)1 * M + m) * 4 + hh], l2 = LSE[((size_t)2 * M + m) * 4 + hh];
        const float mx = fmaxf(l0, fmaxf(l1, l2));
        float w0 = __expf(l0 - mx), w1 = __expf(l1 - mx), w2 = __expf(l2 - mx);
        const float inv = 1.0f / (w0 + w1 + w2); w0 *= inv; w1 *= inv; w2 *= inv;
        const bf16* qr = QKV + (size_t)m * QKVW + hh * 128 + (lane & 15) * 8;
        const u32x4 a = *(const u32x4*)qr, b = *(const u32x4*)(qr + 512), c = *(const u32x4*)(qr + 1024);
        u32x4 o;
        o.x = pk2(w0 * bflo(a.x) + w1 * bflo(b.x) + w2 * bflo(c.x), w0 * bfhi(a.x) + w1 * bfhi(b.x) + w2 * bfhi(c.x));
        o.y = pk2(w0 * bflo(a.y) + w1 * bflo(b.y) + w2 * bflo(c.y), w0 * bfhi(a.y) + w1 * bfhi(b.y) + w2 * bfhi(c.y));
        o.z = pk2(w0 * bflo(a.z) + w1 * bflo(b.z) + w2 * bflo(c.z), w0 * bfhi(a.z) + w1 * bfhi(b.z) + w2 * bfhi(c.z));
        o.w = pk2(w0 * bflo(a.w) + w1 * bflo(b.w) + w2 * bflo(c.w), w0 * bfhi(a.w) + w1 * bfhi(b.w) + w2 * bfhi(c.w));
        *(u32x4*)(OC + (size_t)m * 512 + hh * 128 + (lane & 15) * 8) = o;
    }
}

struct Args { const float* in[22]; float* out; unsigned char* ws; };
#define GEMM_CALL(EPI, E, Aptr, LDA, Bptr, MM, NN, KK) do { pg8::Gemm g_{(Aptr), (Bptr), (LDA), (MM), (NN), (KK)}; pg8::StaticOrder S_; S_.init((MM), (NN), F.G, (int)blockIdx.x); \
        pg8::gemm_phase<EPI, pg8::StaticOrder, true, true>(F.lds, g_, S_, (E)); } while (0)

#define GEMM_CALL_REV(EPI, E, Aptr, LDA, Bptr, MM, NN, KK) do { pg8::Gemm g_{(Aptr), (Bptr), (LDA), (MM), (NN), (KK)}; pg8::RevOrder S_; S_.init((MM), (NN), F.G, (int)blockIdx.x); \
        pg8::gemm_phase<EPI, pg8::RevOrder, true, true>(F.lds, g_, S_, (E)); } while (0)

__global__ void __launch_bounds__(NTHR, 2) fwd_kernel(Args args) {
    extern __shared__ __attribute__((aligned(16))) unsigned char lds_raw[];
    Frame F;
    F.lds = (LAS unsigned char*)lds_raw;
    F.wave = __builtin_amdgcn_readfirstlane(TID_ >> 6);
    F.G = gridDim.x; { const int bx = blockIdx.x; F.vcu = (F.G % 8 == 0) ? (bx % 8) * (F.G / 8) + bx / 8 : bx; }
    F.gw = F.vcu * NWAVES + F.wave; F.NGW = F.G * NWAVES;
    F.ws = args.ws; F.ctl = (gu32*)(args.ws + WS_CTL); F.out = args.out;
    volatile LAS unsigned* MISC = (volatile LAS unsigned*)(F.lds + MISC_OFF);
    for (int u = TID_; u < (LDS_BYTES - LDSCTL_OFF) / 4; u += NTHR) ((LAS unsigned*)(F.lds + LDSCTL_OFF))[u] = 0u;
    __syncthreads();
    if (TID_ < 22) *(LAS unsigned long long*)(F.lds + PTR_OFF + 8 * TID_) = (unsigned long long)args.in[TID_];
    __syncthreads();
    XcdBarrier bar = xcd_barrier_post((unsigned*)(F.ctl + CW_BAR), MISC + 8);
#define GRID_BAR() xcd_barrier(bar)
#ifndef TP
#define TP 0
#endif
#define TPW ((LAS unsigned long long*)(F.lds + LDSCTL_OFF + 768))
#define PB(id) do { if (TP == (id) && TID_ == 0) TPW[0] = __builtin_amdgcn_s_memrealtime(); } while (0)
#define PE(id) do { if (TP == (id) && TID_ == 0) TPW[1] += __builtin_amdgcn_s_memrealtime() - TPW[0]; } while (0)

#define WSL ws_launder(F.ws)
#define XB ((bf16*)(WSL + WS_XB))
#define HB ((bf16*)(WSL + R_H))
#define cosT ((const float*)(WSL + TAB_COS))
#define sinT ((const float*)(WSL + TAB_SIN))
#define ZLO ((bf16*)(F.out + szero()))
#define ZL2 ((bf16*)(WSL + R_KVM))
#define ZLAST ((bf16*)(WSL + R_QM))
#define CQ ((bf16*)(WSL + R_CQ))
#define CKV ((bf16*)(WSL + R_CKV))
#define ZB ((bf16*)(WSL + R_Z))
#define QKV ((bf16*)(WSL + R_QKV))
#define KPE ((bf16*)(WSL + R_KPE))
#define QM ((bf16*)(WSL + R_QM))
#define KVM ((bf16*)(WSL + R_KVM))
#define OA ((bf16*)(WSL + R_OA))
#define OC ((bf16*)(WSL + R_OC))
#define GATE01 ((unsigned char*)(F.out + szero()) + 2 * GATE_PLANE)
#define GATE2 ((unsigned char*)(WSL + R_GATE2))
#define MG ((bf16*)(WSL + R_MERGED))
#define KVX ((bf16*)(WSL + WS_KVX))
#define QX ((bf16*)(WSL + R_QX))
#define OX ((bf16*)(WSL + R_OX))
#define LSE ((float*)(WSL + WS_LSE))
#define WP(off) ((bf16*)(WSL + (off)))
#define ssq_q ((float*)(WSL + CTL_SSQ) + (size_t)(l * 2 + 0) * M)
#define ssq_kv ((float*)(WSL + CTL_SSQ) + (size_t)(l * 2 + 1) * M)
#define STATS(site) ((float*)(WSL + CTL_STATS) + (size_t)(site) * M * 2)
#define SNP(off) ((const float*)(WSL + CTL_SNT) + (size_t)l * 2 * SNT_N + (off))
#define LNG(site) (INP(2) + (size_t)(site) * D)
#define LNB(site) (INP(3) + (size_t)(site) * D)
#define LNFOLD(site, off) LnFold{STATS(site), SNP(off), SNP(off) + SNT_N}
#define NOLN LnFold{nullptr, nullptr, nullptr}

    for (int l = 0; l < DEPTH; ++l) {
        PB(10); p0_prologue(F, l);
        GRID_BAR(); PE(10);
        for (int f = 0; f < 2; ++f) {
            if (f == 1) {
                PB(6); { EpiWinGate E{EpiWin{CQ, CKV, ZB, QKV, KPE, ssq_q, ssq_kv, cosT, sinT, LNFOLD(l * 4 + 0, SNT_WIN)}, EpiGate8{GATE01, GATE2, LNFOLD(l * 4 + 0, SNT_GATE)}};
                  GEMM_CALL(EpiWinGate, E, XB, D, WP(W_IN), M, NWIN + NGATE, D); }
                if ((int)blockIdx.x >= F.G / 2) { EpiBf<0> E{KVX, 1024, nullptr, nullptr, nullptr, NOLN}; pg8::Gemm g_{WP(WS_MEMB), WP(W_XKV), D, BATCH * MEM, 1024, D}; pg8::StaticOrder S_; S_.init(BATCH * MEM, 1024, F.G / 2, (int)blockIdx.x - F.G / 2);
                    pg8::gemm_phase<EpiBf<0>, pg8::StaticOrder, true, true>(F.lds, g_, S_, E); }
                GRID_BAR(); PE(6);
                PB(4); { EpiBf<2> E{QM, QW, ssq_q, cosT, sinT, NOLN}; GEMM_CALL(EpiBf<2>, E, CQ, 512, WP(W_UQ), M, QW, 512); }
                { EpiBf<1> E{KVM, KVW, ssq_kv, nullptr, nullptr, NOLN}; GEMM_CALL(EpiBf<1>, E, CKV, 512, WP(W_UKV), M, KVW, 512); }
                PB(25); for (int u = blockIdx.x; u < BATCH * 16; u += F.G)
                    sgu_unit(F, ZB, INP(12) + l * 512, INP(13) + l * 512, WP(TAB_SGUW), INP(15) + l * 512, u); PE(25);
                for (int u0 = F.vcu; u0 < 3 * BATCH * 16 * 4; u0 += 2 * F.G) {
                    const int u = u0 + (F.wave >> 2) * F.G;
                    const int hh = u & 3, blk = (u >> 2) & 15, b = (u >> 6) & 15, g = u >> 10;
                    const int dil = g == 0 ? 1 : (g == 1 ? 4 : 16), nb = 16 / dil;
                    const int r = blk / nb, n = blk - r * nb;
                    LAS float* bl = (LAS float*)(F.lds + AT_BIAS);
                    { const int t_ = vlaunder(TID_); if (t_ < BIAS_STRIDE) bl[t_] = ((const float*)(WSL + TAB_BIAS))[(g * 4 + hh) * BIAS_STRIDE + t_]; }
                    DilSrc src{QKV, LSE + (size_t)g * M * 4 + hh, (size_t)b * SEQ, dil, r, n, (4 * g + hh) * 128};
                    DilMsk msk{bl, 0.08838834764831845f * LOG2E};
                    attn_unit<128, 2, 4>(F, src, msk, n == 0 ? 2 : 0, 4);
                }
                GRID_BAR(); PE(4);
                PB(5); PB(18); for (int u = blockIdx.x; u < BATCH * 8 * 8; u += F.G) {
                    const int c = (F.G == 256) ? F.vcu : u % F.G, i = u / F.G;
                    int bh, qb;
                    if (F.G == 256) { bh = 2 * (c >> 2) + (i & 1); qb = (i >> 1) ? 7 - (c & 3) : (c & 3); } else { bh = u >> 3; qb = u & 7; }
                    const int b = bh >> 3, h = bh & 7;
                    MlaSrc src{QM, KVM, KPE, OA, (size_t)b * SEQ, h, qb * 256};
                    MlaMsk msk{qb * 256, 0.07216878364870322f * LOG2E};
                    attn_unit<192, 2, 8>(F, src, msk, 0, (qb + 1) * 4);
                }
                PE(18); PB(19); dil_combine(F, QKV, LSE, OC); PE(19);
                GRID_BAR(); PE(5);
                PB(2); { EpiMerge E{GATE01, GATE2, MG}; pg8::Gemm g_{nullptr, WP(W_PA), D, M, D, D}; pg8::ASeg3 AS_{OA, ZB, OC, 1024, 512, 16, 24};
                  pg8::StaticOrder S_; S_.init(M, D, F.G, (int)blockIdx.x); pg8::gemm_phase_seg<EpiMerge, pg8::StaticOrder, true, pg8::ASeg3>(F.lds, g_, AS_, S_, E); }
                GRID_BAR(); PE(2);
                PB(3); { EpiResidLn E{nullptr, XB, ZLO, ZLO, STATS(l * 4 + 0), LNG(l * 4 + 0), LNB(l * 4 + 0), STATS(l * 4 + 1), ALPHA, 1.0f}; GEMM_CALL(EpiResidLn, E, MG, D, WP(W_OUT), M, D, D); }
                GRID_BAR(); PE(3);
                { EpiBf<0> E{QX, 512, nullptr, nullptr, nullptr, LNFOLD(l * 4 + 1, SNT_XQ)}; GEMM_CALL(EpiBf<0>, E, XB, D, WP(W_XQ), M, 512, D); }
                GRID_BAR();
                for (int u = blockIdx.x; u < BATCH * 4 * 8; u += F.G) {
                    const int qb = u & 7, h = (u >> 3) & 3, b = u >> 5;
                    XaSrc src{QX, KVX, OX, (size_t)b * SEQ, (size_t)b * MEM, h, qb * 256};
                    XaMsk msk{0.08838834764831845f * LOG2E};
                    attn_unit<128, 2, 8>(F, src, msk, 0, 4);
                }
                GRID_BAR();
                { EpiResidLn E{nullptr, XB, ZLO, (l == DEPTH - 1) ? ZL2 : ZLO, STATS(l * 4 + 1), LNG(l * 4 + 1), LNB(l * 4 + 1), STATS(l * 4 + 2), ALPHA, 1.0f}; GEMM_CALL(EpiResidLn, E, OX, 512, WP(W_XO), M, D, 512); }
                GRID_BAR();
            }
            const int site_in = f ? l * 4 + 2 : l * 4 - 1, site_out = f ? l * 4 + 3 : l * 4;
            const bool raw_in = (l == 0 && f == 0);
            if (TP == 12 || TP == 13) {
                PG8_LAS unsigned long long* st_ = (PG8_LAS unsigned long long*)(F.lds + LDSCTL_OFF + 1024); if (TID_ == 0) st_[0] = (unsigned long long)(unsigned)vlaunder(0); __syncthreads();
                { EpiSwiglu E{HB, raw_in ? NOLN : LNFOLD(site_in, f ? SNT_FFN1 : SNT_FFN0)}; pg8::Gemm g_{XB, WP(f ? W_GU1 : W_GU0), D, M, 2 * FF, D}; pg8::ProbeOrder S_; S_.init(M, 2 * FF, F.G, (int)blockIdx.x); S_.st = st_;
                  pg8::gemm_phase<EpiSwiglu, pg8::ProbeOrder, true, true>(F.lds, g_, S_, E); }
                if (TID_ == 0) TPW[1] += (TP == 12) ? st_[1 + 6] - st_[1 + 0] : st_[1 + 20] - st_[1 + 14];
            } else {
            PB(7); { EpiSwiglu E{HB, raw_in ? NOLN : LNFOLD(site_in, f ? SNT_FFN1 : SNT_FFN0)}; GEMM_CALL(EpiSwiglu, E, XB, D, WP(f ? W_GU1 : W_GU0), M, 2 * FF, D); } }
            GRID_BAR(); PE(7);
            if (TP == 14 || TP == 15) {
                PG8_LAS unsigned long long* st_ = (PG8_LAS unsigned long long*)(F.lds + LDSCTL_OFF + 1024); if (TID_ == 0) st_[0] = (unsigned long long)(unsigned)vlaunder(0); __syncthreads();
                { EpiResidLn E{raw_in ? INP(0) : nullptr, XB, ZLO, (l == DEPTH - 1 && f == 1) ? ZLAST : ZLO, STATS(raw_in ? 0 : site_in), LNG(raw_in ? 0 : site_in), LNB(raw_in ? 0 : site_in), STATS(site_out), ALPHA, 0.5f};
                  pg8::Gemm g_{HB, WP(f ? W_D1 : W_D0), FF_LD, M, D, FF}; pg8::ProbeOrder S_; S_.init(M, D, F.G, (int)blockIdx.x); S_.st = st_;
                  pg8::gemm_phase<EpiResidLn, pg8::ProbeOrder, true, true>(F.lds, g_, S_, E); }
                if (TID_ == 0) TPW[1] += (TP == 14) ? st_[1 + 2] - st_[1 + 0] : st_[1 + 3] - st_[1 + 2];
            } else {
            const bool lastseam = (l == DEPTH - 1 && f == 1);
            if (lastseam && F.G == 256) {
                EpiResidLnFinal E{XB, ZL2, STATS(site_in), LNG(site_in), LNB(site_in), STATS(site_out), (unsigned*)(F.ctl + CW_PCNT), INP(2) + (size_t)7 * D, INP(3) + (size_t)7 * D, F.out + szero(), ALPHA, 0.5f};
                pg8::Gemm g_{HB, WP(W_D1), FF_LD, M, D, FF}; pg8::RevOrder S_; S_.init(M, D, F.G, (int)blockIdx.x); pg8::gemm_phase<EpiResidLnFinal, pg8::RevOrder, true, true>(F.lds, g_, S_, E);
            } else {
            PB(8); { EpiResidLn E{raw_in ? INP(0) : nullptr, XB, lastseam ? ZL2 : ZLO, lastseam ? ZLAST : ZLO, STATS(raw_in ? 0 : site_in), LNG(raw_in ? 0 : site_in), LNB(raw_in ? 0 : site_in), STATS(site_out), ALPHA, 0.5f};
                pg8::Gemm g_{HB, WP(f ? W_D1 : W_D0), FF_LD, M, D, FF}; pg8::RevOrder S_; S_.init(M, D, F.G, (int)blockIdx.x); pg8::gemm_phase<EpiResidLn, pg8::RevOrder, true, true>(F.lds, g_, S_, E); }
            GRID_BAR(); PE(8); } }
            if (TP == 16 || TP == 17) {
                PG8_LAS unsigned long long* st_ = (PG8_LAS unsigned long long*)(F.lds + LDSCTL_OFF + 1024); if (TID_ == 0) st_[0] = (unsigned long long)(unsigned)vlaunder(0); __syncthreads();
                for (int pass_ = 0; pass_ < 2; ++pass_) {
                    EpiBf<0> E{(bf16*)(F.ws + R_KVM + 32 * MiB + szero()), D, nullptr, nullptr, nullptr, NOLN}; pg8::Gemm g_{HB, WP(f ? W_D1 : W_D0), FF_LD, 16384, D, FF}; pg8::ProbeOrder S_; S_.init(16384, D, F.G, (int)blockIdx.x); S_.st = st_;
                    pg8::gemm_phase<EpiBf<0>, pg8::ProbeOrder, true, true>(F.lds, g_, S_, E); GRID_BAR();
                }
                if (TID_ == 0) TPW[1] += (TP == 16) ? st_[1 + 1] - st_[1 + 0] : st_[1 + 3] - st_[1 + 2];
            }
        }
    }
    if (F.G != 256) ln_final(F, XB, ZLAST, F.out + szero(), INP(2) + (size_t)7 * D, INP(3) + (size_t)7 * D);
    if (TP > 0 && blockIdx.x == 0 && TID_ == 0) { const unsigned long long t0 = __builtin_amdgcn_s_memrealtime(); const unsigned long long w_ = 4ull * TPW[1]; while (__builtin_amdgcn_s_memrealtime() - t0 < w_) __builtin_amdgcn_s_sleep(8); }

}

extern "C" void kernel_launch(void* const* d_in, const int* in_sizes, int n_in, void* d_out, int out_size, void* d_ws, size_t ws_size, hipStream_t stream) {
    static int grid = 0;
    if (grid == 0) {
        if (n_in != 22 || in_sizes[0] != M * D || out_size != M * D || ws_size < WS_NEED) {
            fprintf(stderr, "kernel_launch: unexpected problem: n_in %d in0 %d out %d ws %zu (need %zu); nothing launched\n", n_in, n_in > 0 ? in_sizes[0] : -1, out_size, ws_size, (size_t)WS_NEED); grid = -1; return; }
        int dev = 0, cus = 0, per_cu = 0;
        if (hipGetDevice(&dev) != hipSuccess || hipDeviceGetAttribute(&cus, hipDeviceAttributeMultiprocessorCount, dev) != hipSuccess) { grid = -1; return; }
        if (hipFuncSetAttribute((const void*)fwd_kernel, hipFuncAttributeMaxDynamicSharedMemorySize, LDS_BYTES) != hipSuccess) { fprintf(stderr, "kernel_launch: hipFuncSetAttribute failed\n"); grid = -1; return; }
        if (hipOccupancyMaxActiveBlocksPerMultiprocessor(&per_cu, (const void*)fwd_kernel, NTHR, LDS_BYTES) != hipSuccess || per_cu < 1)
            fprintf(stderr, "kernel_launch: note: occupancy query reports %d workgroups per CU\n", per_cu);
        (void)hipGetLastError();
        if (cus != 256) { fprintf(stderr, "kernel_launch: built for a 256-CU device (unit deals and the paired dilated-attention units assume 256 workgroups), found %d CUs; nothing launched\n", cus); grid = -1; return; }
        grid = cus;
    }
    if (grid < 0) return;
    if (hipMemsetAsync((char*)d_ws + WS_CTL, 0, CTL_ZERO_BYTES, stream) != hipSuccess) return;
    Args a{};
    for (int i = 0; i < 22; ++i) a.in[i] = (const float*)d_in[i];
    a.out = (float*)d_out; a.ws = (unsigned char*)d_ws;
    hipLaunchKernelGGL(fwd_kernel, dim3(grid), dim3(NTHR), LDS_BYTES, stream, a);
    const hipError_t le = hipPeekAtLastError();
    if (le != hipSuccess) fprintf(stderr, "kernel_launch: launch failed: %s\n", hipGetErrorName(le));
}
```

```cpp
#include <hip/hip_runtime.h>
#include <cstdio>
#include <cstdint>

namespace pg8 {
#define PG8_LAS __attribute__((address_space(3)))
typedef unsigned short bf16_t;
typedef short bf16x8 __attribute__((ext_vector_type(8)));
typedef float f32x4 __attribute__((ext_vector_type(4)));
typedef float f32x2 __attribute__((ext_vector_type(2)));
typedef unsigned u32x4 __attribute__((ext_vector_type(4)));
typedef unsigned u32x2 __attribute__((ext_vector_type(2)));
constexpr int BM = 256, BK = 64, HALF = 128, HTB = HALF * BK * 2  , STAGE_BYTES = 8 * HTB, NXCD = 8, WGM = 8;

__host__ __device__ __forceinline__ int lds_byte(int r, int c) { const int st = (r >> 4) * 2 + (c >> 5), rr = r & 15, cc = c & 31, ob = rr * 64 + cc * 2; return st * 1024 + (ob ^ (((ob >> 9) & 1) << 5)); }
__host__ __device__ __forceinline__ void stage_rc(int b, int& R, int& C) { const int st = b / 1024, sb = b % 1024, swz = sb ^ (((sb >> 9) & 1) << 5); R = (st >> 1) * 16 + swz / 64; C = (st & 1) * 32 + (swz % 64) / 2; }
__host__ __device__ __forceinline__ int perm32(int rho) { const int n = rho >> 4, i = rho & 15; return 8 * (i >> 2) + 4 * n + (i & 3); }

struct Unit { int pm, pn; };
struct Gemm { const bf16_t* A; const bf16_t* Bt; int lda, M, N, K; };

struct ASeg3 {
    const bf16_t* A0; const bf16_t* A1; const bf16_t* A2; int lda0, lda1, t1, t2;
    __device__ __forceinline__ const char* base(int pm, int tile) const {
        return tile < t1 ? (const char*)A0 + (size_t)pm * 512 * lda0 + (size_t)tile * 128
             : tile < t2 ? (const char*)A1 + (size_t)pm * 512 * lda0 + (size_t)(tile - t1) * 128
                         : (const char*)A2 + (size_t)pm * 512 * lda1 + (size_t)(tile - t2) * 128; }
    __device__ __forceinline__ size_t hstep(int tile) const { return (size_t)256 * (tile < t2 ? lda0 : lda1); }
    __device__ __forceinline__ bool sel(int tile) const { return tile >= t2; }
};
struct StaticOrder {
    int nM, nN, nwg, G, c, wgm;
    __host__ __device__ void init(int M, int N, int G_, int c_) { nM = M / BM; nN = N / BM; nwg = nM * nN; G = G_; c = c_; wgm = (nN == 8) ? 4 : WGM; }
    __host__ __device__ bool next(int i, Unit& u) const {
        const long L = (long)i * G + c; if (L >= nwg) return false;
        int wgid = (int)L; { const int q = nwg / NXCD, r = nwg % NXCD, xcd = wgid % NXCD, off = wgid / NXCD; wgid = (xcd < r ? xcd * (q + 1) : r * (q + 1) + (xcd - r) * q) + off; }
        const int nig = wgm * nN, gid = wgid / nig, fm = gid * wgm, gsz = (nM - fm) < wgm ? (nM - fm) : wgm;
        u.pm = fm + ((wgid % nig) % gsz); u.pn = (wgid % nig) / gsz; return true;
    }
    __device__ __forceinline__ void a_ready(const Unit&) const {}
    __device__ __forceinline__ void done(const Unit&) const {}
};

struct GateOrder {
    StaticOrder base;
    __device__ bool next(int i, Unit& u) const { Unit t; if (!base.next(i / 3, t)) return false; u.pm = t.pm; u.pn = t.pn + 8 * (i % 3); return true; }
    __device__ __forceinline__ void a_ready(const Unit&) const {}
    __device__ __forceinline__ void done(const Unit&) const {}
};
struct RevOrder {
    StaticOrder base; int nr;
    __device__ void init(int M, int N, int G_, int c_) { base.init(M, N, G_, c_); nr = (base.nwg + G_ - 1) / G_; if ((nr - 1) * G_ + c_ >= base.nwg) --nr; }
    __device__ bool next(int i, Unit& u) const { if (i >= nr) return false; return base.next(nr - 1 - i, u); }
    __device__ __forceinline__ void a_ready(const Unit&) const {}
    __device__ __forceinline__ void done(const Unit&) const {}
};
struct ProbeOrder : StaticOrder {
    PG8_LAS unsigned long long* st;
    __device__ __forceinline__ void done(const Unit&) const { if (threadIdx.x == 0) { const unsigned long long k = st[0]; if (k < 30) st[1 + k] = __builtin_amdgcn_s_memrealtime(); st[0] = k + 1; } }
};
__device__ __forceinline__ unsigned cvt_pk_bf16(float lo, float hi) { unsigned r; asm volatile("v_cvt_pk_bf16_f32 %0, %1, %2" : "=v"(r) : "v"(lo), "v"(hi)); return r; }
__device__ __forceinline__ f32x2 gelu_pk(f32x2 v) {
    const f32x2 av = __builtin_elementwise_abs(v), d = av * 0.2316418882f + 1.0f;
    f32x2 t; t.x = __builtin_amdgcn_rcpf(d.x); t.y = __builtin_amdgcn_rcpf(d.y);
    f32x2 q = t * 0.5307027145f + (-0.7265760135f); q = q * t + 0.7107068705f; q = q * t + (-0.142248368f); q = q * t + 0.127414796f; q = q * t;
    const f32x2 s = (v * v) * (-0.72134752044f);
    f32x2 e; e.x = __builtin_amdgcn_exp2f(s.x); e.y = __builtin_amdgcn_exp2f(s.y);
    const f32x2 m = v * (q * e), r = v - m;
    f32x2 o; o.x = v.x < 0.f ? m.x : r.x; o.y = v.y < 0.f ? m.y : r.y; return o;
}
template <class Epi, class Sched, bool ALIGN_EPI = false, bool SP2 = false>
__device__ __forceinline__ void gemm_phase(PG8_LAS unsigned char* lds, const Gemm g, const Sched& S, const Epi& E) {
    int tid_ = threadIdx.x; asm volatile("" : "+v"(tid_));
    const int tid = tid_, wid = __builtin_amdgcn_readfirstlane(tid >> 6), lane = tid & 63, wr = wid >> 2, wc = wid & 3, fr = lane & 15, fq = lane >> 4;
    const int K = g.K, nt = K / BK;
    unsigned voffA[2], voffB[2];
#pragma unroll
    for (int i = 0; i < 2; ++i) { int R, C; stage_rc(tid * 16 + i * 8192, R, C); const int Rb = Epi::PERM ? ((R & ~31) + perm32(R & 31)) : R;
        voffA[i] = (unsigned)(R * g.lda + C) * 2u; voffB[i] = (unsigned)(Rb * K + C) * 2u; }
    const size_t kstep = (size_t)(BK * 2);
    const size_t hstepB = (size_t)HALF * K * 2, hstepA = (size_t)HALF * g.lda * 2;
    const size_t tstepA = 2 * hstepA, tstepB = 2 * hstepB;
    const unsigned ldsw = (unsigned)wid * 1024u;
    const int aoff = lds_byte(wr * 64 + fr, fq * 8), boff = lds_byte(wc * 32 + fr, fq * 8);
#define PG8_SA(b, h) (((b) * 2 + (h)) * HTB)
#define PG8_SB(b, h) ((4 + (b) * 2 + (h)) * HTB)
#define PG8_STAGE(bufoff, gbase, voff) do { _Pragma("unroll") for (int _i = 0; _i < 2; ++_i) \
        __builtin_amdgcn_global_load_lds((const unsigned*)((const char*)(gbase) + (voff)[_i]), (PG8_LAS unsigned*)(lds + (bufoff) + ldsw + _i * 8192), 16, 0, 0); } while (0)
#define PG8_LDA(dst, b, h) do { _Pragma("unroll") for (int m = 0; m < 4; ++m) _Pragma("unroll") for (int k = 0; k < 2; ++k) dst[m][k] = *(const PG8_LAS bf16x8*)(lds + PG8_SA(b, h) + aoff + m * 2048 + k * 1024); } while (0)
#define PG8_LDB(dst, b, h) do { _Pragma("unroll") for (int n = 0; n < 2; ++n) _Pragma("unroll") for (int k = 0; k < 2; ++k) dst[n][k] = *(const PG8_LAS bf16x8*)(lds + PG8_SB(b, h) + boff + n * 2048 + k * 1024); } while (0)
#define PG8_MMA(ai, bj, At, Bt) do { __builtin_amdgcn_s_setprio(1); _Pragma("unroll") for (int m = 0; m < 4; ++m) _Pragma("unroll") for (int n = 0; n < 2; ++n) _Pragma("unroll") for (int k = 0; k < 2; ++k) \
        acc[ai][bj][m][n] = __builtin_amdgcn_mfma_f32_16x16x32_bf16(Bt[n][k], At[m][k], acc[ai][bj][m][n], 0, 0, 0); __builtin_amdgcn_s_setprio(0); } while (0)
#define PG8_WAIT_V(n) asm volatile("s_waitcnt vmcnt(" #n ")" ::: "memory")
#define PG8_WAIT_L(n) asm volatile("s_waitcnt lgkmcnt(" #n ")" ::: "memory")
#define PG8_BAR __builtin_amdgcn_s_barrier()
#define PG8_SCHED __builtin_amdgcn_sched_barrier(0)
    Unit cur, nxt; int ui = 0;
    if (!S.next(0, cur)) return;
    f32x4 acc[2][2][4][2];
#pragma unroll
    for (int a = 0; a < 2; ++a)
#pragma unroll
        for (int b = 0; b < 2; ++b)
#pragma unroll
            for (int m = 0; m < 4; ++m)
#pragma unroll
                for (int n = 0; n < 2; ++n) acc[a][b][m][n] = (f32x4){0.f, 0.f, 0.f, 0.f};
    bf16x8 At[4][2], B0[2][2], B1[2][2];
    const char* cA = (const char*)g.A + (size_t)cur.pm * tstepA; const char* cB = (const char*)g.Bt + (size_t)cur.pn * tstepB;
    S.a_ready(cur);
    if constexpr (SP2) {
        PG8_STAGE(PG8_SB(0, 0), cB, voffB); PG8_STAGE(PG8_SB(0, 1), cB + hstepB, voffB); PG8_STAGE(PG8_SA(0, 0), cA, voffA); PG8_STAGE(PG8_SA(0, 1), cA + hstepA, voffA);
        if (wr == 1) PG8_BAR;
        PG8_WAIT_V(2); PG8_BAR;
        PG8_STAGE(PG8_SB(1, 0), cB + kstep, voffB); PG8_STAGE(PG8_SA(1, 0), cA + kstep, voffA); PG8_STAGE(PG8_SB(1, 1), cB + hstepB + kstep, voffB);
        PG8_WAIT_V(6); PG8_BAR;
    } else {
        PG8_STAGE(PG8_SB(0, 0), cB, voffB); PG8_STAGE(PG8_SA(0, 0), cA, voffA); PG8_STAGE(PG8_SB(0, 1), cB + hstepB, voffB); PG8_STAGE(PG8_SA(0, 1), cA + hstepA, voffA);
        if (wr == 1) PG8_BAR;
        PG8_WAIT_V(4); PG8_BAR;
        PG8_STAGE(PG8_SB(1, 0), cB + kstep, voffB); PG8_STAGE(PG8_SA(1, 0), cA + kstep, voffA); PG8_STAGE(PG8_SB(1, 1), cB + hstepB + kstep, voffB);
        PG8_WAIT_V(6); PG8_BAR;
    }
    for (;;) {
        const bool has_next = S.next(ui + 1, nxt);
        const char* nA = has_next ? (const char*)g.A + (size_t)nxt.pm * tstepA : cA; const char* nB = has_next ? (const char*)g.Bt + (size_t)nxt.pn * tstepB : cB;
        for (int t = 0; t < nt; t += 2) {
            const bool last = (t == nt - 2);
            const char* a1 = cA + (size_t)(t + 1) * kstep;
            const char* a2 = last ? nA : cA + (size_t)(t + 2) * kstep; const char* b2 = last ? nB : cB + (size_t)(t + 2) * kstep;
            const char* a3 = a2 + kstep; const char* b3 = b2 + kstep;
            if (last && has_next) S.a_ready(nxt);
            if constexpr (SP2) {
            PG8_LDB(B0, 0, 0); PG8_LDB(B1, 0, 1); PG8_SCHED; PG8_LDA(At, 0, 0); PG8_STAGE(PG8_SA(1, 1), a1 + hstepA, voffA);
            PG8_WAIT_V(8); PG8_WAIT_L(0); PG8_BAR; PG8_MMA(0, 0, At, B0); PG8_MMA(0, 1, At, B1); PG8_BAR; PG8_SCHED;
            PG8_LDA(At, 0, 1); PG8_STAGE(PG8_SB(0, 0), b2, voffB); PG8_STAGE(PG8_SB(0, 1), b2 + hstepB, voffB); PG8_STAGE(PG8_SA(0, 0), a2, voffA);
            PG8_WAIT_V(8); PG8_WAIT_L(0); PG8_BAR; PG8_MMA(1, 0, At, B0); PG8_MMA(1, 1, At, B1); PG8_BAR; PG8_SCHED;
            PG8_LDB(B0, 1, 0); PG8_LDB(B1, 1, 1); PG8_SCHED; PG8_LDA(At, 1, 0); PG8_STAGE(PG8_SA(0, 1), a2 + hstepA, voffA);
            PG8_WAIT_V(8); PG8_WAIT_L(0); PG8_BAR; PG8_MMA(0, 0, At, B0); PG8_MMA(0, 1, At, B1); PG8_BAR; PG8_SCHED;
            PG8_LDA(At, 1, 1); PG8_STAGE(PG8_SB(1, 0), b3, voffB); PG8_STAGE(PG8_SB(1, 1), b3 + hstepB, voffB); PG8_STAGE(PG8_SA(1, 0), a3, voffA);
            PG8_WAIT_V(8); PG8_WAIT_L(0); PG8_BAR; PG8_MMA(1, 0, At, B0); PG8_MMA(1, 1, At, B1); PG8_BAR; PG8_SCHED;
            } else {
            PG8_LDB(B0, 0, 0); PG8_SCHED; PG8_LDA(At, 0, 0); PG8_STAGE(PG8_SA(1, 1), a1 + hstepA, voffA);
            PG8_WAIT_L(8); PG8_BAR; PG8_WAIT_L(0); PG8_MMA(0, 0, At, B0); PG8_BAR; PG8_SCHED;
            PG8_LDB(B1, 0, 1); PG8_STAGE(PG8_SB(0, 0), b2, voffB);
            PG8_BAR; PG8_WAIT_L(0); PG8_MMA(0, 1, At, B1); PG8_BAR;
            PG8_LDA(At, 0, 1); PG8_STAGE(PG8_SA(0, 0), a2, voffA);
            PG8_BAR; PG8_WAIT_L(0); PG8_MMA(1, 0, At, B0); PG8_BAR; PG8_SCHED;
            PG8_STAGE(PG8_SB(0, 1), b2 + hstepB, voffB);
            PG8_WAIT_V(6); PG8_BAR; PG8_MMA(1, 1, At, B1); PG8_BAR;
            PG8_LDB(B0, 1, 0); PG8_SCHED; PG8_LDA(At, 1, 0); PG8_STAGE(PG8_SA(0, 1), a2 + hstepA, voffA);
            PG8_WAIT_L(8); PG8_BAR; PG8_WAIT_L(0); PG8_MMA(0, 0, At, B0); PG8_BAR; PG8_SCHED;
            PG8_LDB(B1, 1, 1); PG8_STAGE(PG8_SB(1, 0), b3, voffB);
            PG8_BAR; PG8_WAIT_L(0); PG8_MMA(0, 1, At, B1); PG8_BAR;
            PG8_LDA(At, 1, 1); PG8_STAGE(PG8_SA(1, 0), a3, voffA);
            PG8_BAR; PG8_WAIT_L(0); PG8_MMA(1, 0, At, B0); PG8_BAR; PG8_SCHED;
            PG8_STAGE(PG8_SB(1, 1), b3 + hstepB, voffB);
            PG8_WAIT_V(6); PG8_BAR; PG8_MMA(1, 1, At, B1); PG8_BAR;
            }
        }
        if constexpr (ALIGN_EPI) { if (wr == 0) PG8_BAR; }
        if constexpr (!Epi::AFTER_DRAIN) { E(acc, cur, wr, wc, fr, fq); S.done(cur); }
        if (!has_next) break;
#pragma unroll
        for (int a = 0; a < 2; ++a)
#pragma unroll
            for (int b = 0; b < 2; ++b)
#pragma unroll
                for (int m = 0; m < 4; ++m)
#pragma unroll
                    for (int n = 0; n < 2; ++n) acc[a][b][m][n] = (f32x4){0.f, 0.f, 0.f, 0.f};
        cur = nxt; cA = nA; cB = nB; ++ui;
        if constexpr (ALIGN_EPI) { if (wr == 1) PG8_BAR; }
    }
    PG8_WAIT_V(0);
    if constexpr (!ALIGN_EPI) { if (wr == 0) PG8_BAR; }
    PG8_BAR;
    if constexpr (Epi::AFTER_DRAIN) { E.fused(acc, cur, wr, wc, fr, fq, lds, wid, lane); S.done(cur); }
#undef PG8_SA
#undef PG8_SB
#undef PG8_STAGE
#undef PG8_LDA
#undef PG8_LDB
#undef PG8_MMA
#undef PG8_WAIT_V
#undef PG8_WAIT_L
#undef PG8_BAR
#undef PG8_SCHED
}
template <class Epi, class Sched, bool ALIGN_EPI, class ASrc>
__device__ __forceinline__ void gemm_phase_seg(PG8_LAS unsigned char* lds, const Gemm g, const ASrc AS, const Sched& S, const Epi& E) {
    constexpr bool SP2 = true;
    int tid_ = threadIdx.x; asm volatile("" : "+v"(tid_));
    const int tid = tid_, wid = __builtin_amdgcn_readfirstlane(tid >> 6), lane = tid & 63, wr = wid >> 2, wc = wid & 3, fr = lane & 15, fq = lane >> 4;
    const int K = g.K, nt = K / BK;
    unsigned voffA[2], voffA2[2], voffB[2];
#pragma unroll
    for (int i = 0; i < 2; ++i) { int R, C; stage_rc(tid * 16 + i * 8192, R, C); const int Rb = Epi::PERM ? ((R & ~31) + perm32(R & 31)) : R;
        voffA[i] = (unsigned)(R * AS.lda0 + C) * 2u; voffA2[i] = (unsigned)(R * AS.lda1 + C) * 2u; voffB[i] = (unsigned)(Rb * K + C) * 2u; }
    const size_t kstep = (size_t)(BK * 2);
    const size_t hstepB = (size_t)HALF * K * 2, tstepB = 2 * hstepB;
    const unsigned ldsw = (unsigned)wid * 1024u;
    const int aoff = lds_byte(wr * 64 + fr, fq * 8), boff = lds_byte(wc * 32 + fr, fq * 8);
#define PG8_SA(b, h) (((b) * 2 + (h)) * HTB)
#define PG8_SB(b, h) ((4 + (b) * 2 + (h)) * HTB)
#define PG8_STAGE(bufoff, gbase, voff) do { _Pragma("unroll") for (int _i = 0; _i < 2; ++_i) \
        __builtin_amdgcn_global_load_lds((const unsigned*)((const char*)(gbase) + (voff)[_i]), (PG8_LAS unsigned*)(lds + (bufoff) + ldsw + _i * 8192), 16, 0, 0); } while (0)
#define PG8_LDA(dst, b, h) do { _Pragma("unroll") for (int m = 0; m < 4; ++m) _Pragma("unroll") for (int k = 0; k < 2; ++k) dst[m][k] = *(const PG8_LAS bf16x8*)(lds + PG8_SA(b, h) + aoff + m * 2048 + k * 1024); } while (0)
#define PG8_LDB(dst, b, h) do { _Pragma("unroll") for (int n = 0; n < 2; ++n) _Pragma("unroll") for (int k = 0; k < 2; ++k) dst[n][k] = *(const PG8_LAS bf16x8*)(lds + PG8_SB(b, h) + boff + n * 2048 + k * 1024); } while (0)
#define PG8_MMA(ai, bj, At, Bt) do { __builtin_amdgcn_s_setprio(1); _Pragma("unroll") for (int m = 0; m < 4; ++m) _Pragma("unroll") for (int n = 0; n < 2; ++n) _Pragma("unroll") for (int k = 0; k < 2; ++k) \
        acc[ai][bj][m][n] = __builtin_amdgcn_mfma_f32_16x16x32_bf16(Bt[n][k], At[m][k], acc[ai][bj][m][n], 0, 0, 0); __builtin_amdgcn_s_setprio(0); } while (0)
#define PG8_WAIT_V(n) asm volatile("s_waitcnt vmcnt(" #n ")" ::: "memory")
#define PG8_WAIT_L(n) asm volatile("s_waitcnt lgkmcnt(" #n ")" ::: "memory")
#define PG8_BAR __builtin_amdgcn_s_barrier()
#define PG8_SCHED __builtin_amdgcn_sched_barrier(0)
    Unit cur, nxt; int ui = 0;
    if (!S.next(0, cur)) return;
    f32x4 acc[2][2][4][2];
#pragma unroll
    for (int a = 0; a < 2; ++a)
#pragma unroll
        for (int b = 0; b < 2; ++b)
#pragma unroll
            for (int m = 0; m < 4; ++m)
#pragma unroll
                for (int n = 0; n < 2; ++n) acc[a][b][m][n] = (f32x4){0.f, 0.f, 0.f, 0.f};
    bf16x8 At[4][2], B0[2][2], B1[2][2];
    const char* cB = (const char*)g.Bt + (size_t)cur.pn * tstepB;
    S.a_ready(cur);
    if constexpr (SP2) {
        PG8_STAGE(PG8_SB(0, 0), cB, voffB); PG8_STAGE(PG8_SB(0, 1), cB + hstepB, voffB); PG8_STAGE(PG8_SA(0, 0), AS.base(cur.pm, 0), voffA); PG8_STAGE(PG8_SA(0, 1), AS.base(cur.pm, 0) + AS.hstep(0), voffA);
        if (wr == 1) PG8_BAR;
        PG8_WAIT_V(2); PG8_BAR;
        PG8_STAGE(PG8_SB(1, 0), cB + kstep, voffB); PG8_STAGE(PG8_SA(1, 0), AS.base(cur.pm, 1), voffA); PG8_STAGE(PG8_SB(1, 1), cB + hstepB + kstep, voffB);
        PG8_WAIT_V(6); PG8_BAR;
    }
    for (;;) {
        const bool has_next = S.next(ui + 1, nxt);
        const int npm = has_next ? nxt.pm : cur.pm; const char* nB = has_next ? (const char*)g.Bt + (size_t)nxt.pn * tstepB : cB;
        for (int t = 0; t < nt; t += 2) {
            const bool last = (t == nt - 2);
            if (t == AS.t1) E.mid(acc, cur, 0, wr, wc, fr, fq);
            if (t == AS.t2) E.mid(acc, cur, 1, wr, wc, fr, fq);
            const char* a1 = AS.base(cur.pm, t + 1); const size_t h1 = AS.hstep(t + 1); const bool s1 = AS.sel(t + 1);
            const char* a2 = last ? AS.base(npm, 0) : AS.base(cur.pm, t + 2); const char* b2 = last ? nB : cB + (size_t)(t + 2) * kstep;
            const char* a3 = last ? AS.base(npm, 1) : AS.base(cur.pm, t + 3); const char* b3 = b2 + kstep;
            const size_t h2 = last ? AS.hstep(0) : AS.hstep(t + 2); const bool s2 = last ? false : AS.sel(t + 2);
            const unsigned v1a[2] = {s1 ? voffA2[0] : voffA[0], s1 ? voffA2[1] : voffA[1]}, v2a[2] = {s2 ? voffA2[0] : voffA[0], s2 ? voffA2[1] : voffA[1]};
            if (last && has_next) S.a_ready(nxt);
            if constexpr (SP2) {
            PG8_LDB(B0, 0, 0); PG8_LDB(B1, 0, 1); PG8_SCHED; PG8_LDA(At, 0, 0); PG8_STAGE(PG8_SA(1, 1), a1 + h1, v1a);
            PG8_WAIT_V(8); PG8_WAIT_L(0); PG8_BAR; PG8_MMA(0, 0, At, B0); PG8_MMA(0, 1, At, B1); PG8_BAR; PG8_SCHED;
            PG8_LDA(At, 0, 1); PG8_STAGE(PG8_SB(0, 0), b2, voffB); PG8_STAGE(PG8_SB(0, 1), b2 + hstepB, voffB); PG8_STAGE(PG8_SA(0, 0), a2, v2a);
            PG8_WAIT_V(8); PG8_WAIT_L(0); PG8_BAR; PG8_MMA(1, 0, At, B0); PG8_MMA(1, 1, At, B1); PG8_BAR; PG8_SCHED;
            PG8_LDB(B0, 1, 0); PG8_LDB(B1, 1, 1); PG8_SCHED; PG8_LDA(At, 1, 0); PG8_STAGE(PG8_SA(0, 1), a2 + h2, v2a);
            PG8_WAIT_V(8); PG8_WAIT_L(0); PG8_BAR; PG8_MMA(0, 0, At, B0); PG8_MMA(0, 1, At, B1); PG8_BAR; PG8_SCHED;
            PG8_LDA(At, 1, 1); PG8_STAGE(PG8_SB(1, 0), b3, voffB); PG8_STAGE(PG8_SB(1, 1), b3 + hstepB, voffB); PG8_STAGE(PG8_SA(1, 0), a3, v2a);
            PG8_WAIT_V(8); PG8_WAIT_L(0); PG8_BAR; PG8_MMA(1, 0, At, B0); PG8_MMA(1, 1, At, B1); PG8_BAR; PG8_SCHED;
            }
        }
        if constexpr (ALIGN_EPI) { if (wr == 0) PG8_BAR; }
        if constexpr (!Epi::AFTER_DRAIN) { E(acc, cur, wr, wc, fr, fq); S.done(cur); }
        if (!has_next) break;
#pragma unroll
        for (int a = 0; a < 2; ++a)
#pragma unroll
            for (int b = 0; b < 2; ++b)
#pragma unroll
                for (int m = 0; m < 4; ++m)
#pragma unroll
                    for (int n = 0; n < 2; ++n) acc[a][b][m][n] = (f32x4){0.f, 0.f, 0.f, 0.f};
        cur = nxt; cB = nB; ++ui;
        if constexpr (ALIGN_EPI) { if (wr == 1) PG8_BAR; }
    }
    PG8_WAIT_V(0);
    if constexpr (!ALIGN_EPI) { if (wr == 0) PG8_BAR; }
    PG8_BAR;
    if constexpr (Epi::AFTER_DRAIN) { E.fused(acc, cur, wr, wc, fr, fq, lds, wid, lane); S.done(cur); }
#undef PG8_SA
#undef PG8_SB
#undef PG8_STAGE
#undef PG8_LDA
#undef PG8_LDB
#undef PG8_MMA
#undef PG8_WAIT_V
#undef PG8_WAIT_L
#undef PG8_BAR
#undef PG8_SCHED
}
}

constexpr int NWAVES = 8, NTHR = NWAVES * 64;
constexpr int D = 2048, BATCH = 16, SEQ = 2048, M = BATCH * SEQ, FF = 5632, MEM = 256, DEPTH = 2;
constexpr int N_IN_SRC = 12864, NWIN = 6912  , NWIN_SRC = 6720, NGATE = 6144;
constexpr int QKVW = 4608, ZW = 1024, QW = 1536, KVW = 2048;
#ifndef H_NT
#define H_NT 0
#endif
#ifndef FF_PAD
#define FF_PAD 0
#endif
constexpr int FF_LD = FF + FF_PAD;
constexpr float LN_EPS = 1e-5f, RMS_EPS = 1e-6f, ALPHA = 1.41421356237309515f, LOG2E = 1.4426950408889634f, LN2 = 0.6931471805599453f;
constexpr float NEGBIG = -1e30f;

constexpr size_t MiB = 1u << 20;
constexpr size_t WS_CTL = 0, CTL_ZERO_BYTES = 4 * MiB;
constexpr size_t CTL_SSQ = 256 * 1024;
constexpr size_t CTL_STATS = 1 * MiB;
constexpr size_t CTL_SNT = 3 * MiB;
constexpr int SNT_FFN0 = 0, SNT_FFN1 = 11264, SNT_WIN = 22528, SNT_GATE = 29440, SNT_XQ = 35584, SNT_N = 36096;
constexpr size_t WS_TAB = 4 * MiB;
constexpr size_t TAB_COS = WS_TAB, TAB_SIN = WS_TAB + 256 * 1024, TAB_BIAS = WS_TAB + 512 * 1024, TAB_SGUW = WS_TAB + 640 * 1024;
constexpr int BIAS_STRIDE = 132;
constexpr size_t WS_W = 5 * MiB;
constexpr size_t W_GU0 = WS_W, W_D0 = W_GU0 + 44 * MiB, W_GU1 = W_D0 + 22 * MiB, W_D1 = W_GU1 + 44 * MiB, W_IN = W_D1 + 22 * MiB, W_GATE = W_IN + 27 * MiB,
                 W_UQ = W_GATE + 24 * MiB, W_UKV = W_UQ + 2 * MiB, W_PA = W_UKV + 2 * MiB, W_PB = W_PA + 4 * MiB, W_PC = W_PB + 2 * MiB, W_OUT = W_PC + 2 * MiB,
                 W_XQ = W_OUT + 8 * MiB, W_XKV = W_XQ + 2 * MiB, W_XO = W_XKV + 4 * MiB, W_END = W_XO + 2 * MiB;
static_assert(W_END <= 218 * MiB, "weights");
constexpr size_t WS_XB = 218 * MiB;
constexpr size_t WS_MEMB = 346 * MiB;
constexpr size_t WS_KVX = 362 * MiB;
constexpr size_t WS_LSE = 370 * MiB;
constexpr size_t WS_R = 372 * MiB;
constexpr size_t R_H = WS_R;
constexpr size_t R_KPE = WS_R, R_CQ = WS_R + 4 * MiB, R_CKV = WS_R + 36 * MiB, R_OA = R_CQ  , R_Z = WS_R + 68 * MiB, R_QKV = WS_R + 132 * MiB,
                 R_QM = WS_R + 420 * MiB, R_KVM = WS_R + 516 * MiB, R_OC = WS_R + 644 * MiB, R_END = WS_R + 676 * MiB;
constexpr size_t R_GATE = R_QKV, R_MERGED = R_KVM;
constexpr size_t R_QX = R_QM, R_OX = R_QM + 32 * MiB;
constexpr size_t GATE_PLANE = (size_t)M * D;
constexpr size_t R_GATE2 = R_END, WS_NEED = R_END + GATE_PLANE;
static_assert((size_t)M * FF_LD * 2 <= 420 * MiB && R_GATE + (size_t)M * NGATE * 2 == R_KVM && R_QM + 96 * MiB == R_KVM && R_MERGED + 128 * MiB <= R_OC, "overlays");

constexpr int CW_PCNT = 16384;
constexpr int CW_BAR = 4096;

constexpr int LDS_BYTES = 147456;
constexpr int LDSCTL_OFF = 143360, MISC_OFF = LDSCTL_OFF;

#define GAS __attribute__((address_space(1)))
#define LAS __attribute__((address_space(3)))
typedef unsigned short bf16;
typedef pg8::f32x4 f32x4;
typedef pg8::f32x2 f32x2;
typedef pg8::u32x4 u32x4;
typedef pg8::u32x2 u32x2;
typedef pg8::bf16x8 bf16x8;
typedef short s16x4 __attribute__((ext_vector_type(4)));
typedef GAS unsigned gu32;
#define LDS_WAIT() asm volatile("s_waitcnt lgkmcnt(0)" ::: "memory")
#define VM_WAIT() asm volatile("s_waitcnt vmcnt(0)" ::: "memory")
__device__ __forceinline__ float bf2f(unsigned short b) { return __uint_as_float(((unsigned)b) << 16); }
__device__ __forceinline__ float bflo(unsigned w) { return __uint_as_float(w << 16); }
__device__ __forceinline__ float bfhi(unsigned w) { return __uint_as_float(w & 0xffff0000u); }
typedef float f32x2v_t __attribute__((ext_vector_type(2)));
typedef __bf16 bf16x2v_t __attribute__((ext_vector_type(2)));
__device__ __forceinline__ unsigned pk2(float lo, float hi) { const f32x2v_t v = {lo, hi}; const bf16x2v_t b = __builtin_convertvector(v, bf16x2v_t); return __builtin_bit_cast(unsigned, b); }
__device__ __forceinline__ float fsigmoid(float x) { return __builtin_amdgcn_rcpf(1.0f + __builtin_amdgcn_exp2f(-LOG2E * x)); }
__device__ __forceinline__ int lane_id_local() { int z = 0; asm volatile("" : "+v"(z)); return __builtin_amdgcn_mbcnt_hi(-1, __builtin_amdgcn_mbcnt_lo(-1, z)); }
__device__ __forceinline__ float shx(float v, int m) { return __builtin_bit_cast(float, __builtin_amdgcn_ds_bpermute((lane_id_local() ^ m) << 2, __builtin_bit_cast(int, v))); }
__device__ __forceinline__ float shx_l(float v, int m, int lane) { return __builtin_bit_cast(float, __builtin_amdgcn_ds_bpermute((lane ^ m) << 2, __builtin_bit_cast(int, v))); }
__device__ __forceinline__ float xmax_16_32(float v) {
    const auto r = __builtin_amdgcn_permlane16_swap(__float_as_uint(v), __float_as_uint(v), false, false); const unsigned r0 = r[0], r1 = r[1];
    v = fmaxf(__uint_as_float(r0), __uint_as_float(r1));
    const auto q = __builtin_amdgcn_permlane32_swap(__float_as_uint(v), __float_as_uint(v), false, false); const unsigned q0 = q[0], q1 = q[1];
    return fmaxf(__uint_as_float(q0), __uint_as_float(q1));
}
__device__ __forceinline__ float xsum_16_32(float v) {
    const auto r = __builtin_amdgcn_permlane16_swap(__float_as_uint(v), __float_as_uint(v), false, false); const unsigned r0 = r[0], r1 = r[1];
    v = __uint_as_float(r0) + __uint_as_float(r1);
    const auto q = __builtin_amdgcn_permlane32_swap(__float_as_uint(v), __float_as_uint(v), false, false); const unsigned q0 = q[0], q1 = q[1];
    return __uint_as_float(q0) + __uint_as_float(q1);
}
__device__ __forceinline__ float wave_sum(float v) {
#pragma unroll
    for (int o = 1; o < 64; o <<= 1) v += shx(v, o);
    return v;
}
__device__ __forceinline__ float wave_max(float v) {
#pragma unroll
    for (int o = 1; o < 64; o <<= 1) v = fmaxf(v, shx(v, o));
    return v;
}

#define XB_TMO      128
#define XB_XCNT(j)  (256  + 64 * (j))
#define XB_XSUB(j)  (1280 + 64 * (j))
#define XB_XGEN(j)  (2304 + 64 * (j))
#define XB_TOP      3328
#define XB_TOPGEN   3392
#define XCD_BAR_WORDS 3456
#define XB_SPIN_CAP (1u << 20)

__device__ __forceinline__ unsigned xb_ld(unsigned* p)              { return __hip_atomic_load(p, __ATOMIC_RELAXED, __HIP_MEMORY_SCOPE_AGENT); }
__device__ __forceinline__ unsigned xb_add(unsigned* p, unsigned v) { return __hip_atomic_fetch_add(p, v, __ATOMIC_RELAXED, __HIP_MEMORY_SCOPE_AGENT); }
__device__ __forceinline__ unsigned xb_xcc_id() { return (unsigned)__builtin_amdgcn_s_getreg((3 << 11) | 20) & 0xFu; }
#define XB_SPIN(cond, bar) do { unsigned _sp = 0; while (cond) { __builtin_amdgcn_s_sleep(1); \
    if ((++_sp & 255u) == 0u) { if (xb_ld(&(bar)[XB_TMO])) break; if (_sp > XB_SPIN_CAP) { atomicAdd(&(bar)[XB_TMO], 1u); break; } } } } while (0)

struct XcdBarrier { unsigned* bar; unsigned x; volatile LAS unsigned* st; };

__device__ __forceinline__ XcdBarrier xcd_barrier_post(unsigned* bar, volatile LAS unsigned* st) {
    XcdBarrier b; b.bar = bar; b.x = xb_xcc_id(); b.st = st;
    if (threadIdx.x == 0) (void)xb_add(&bar[XB_XCNT(b.x)], 1u);
    return b;
}
__device__ __forceinline__ void xcd_barrier_complete(unsigned* bar, unsigned x, unsigned& nloc, unsigned& nx) {
    const unsigned G = gridDim.x * gridDim.y * gridDim.z;
    unsigned sum, cnt, mine, sp = 0u;
    for (;;) {
        sum = 0u; cnt = 0u; mine = 0u;
#pragma unroll
        for (unsigned j = 0; j < 16; ++j) { const unsigned c = xb_ld(&bar[XB_XCNT(j)]); sum += c; cnt += (c > 0u) ? 1u : 0u; mine = (j == x) ? c : mine; }
        if (sum == G) break;
        __builtin_amdgcn_s_sleep(1);
        if ((++sp & 255u) == 0u) { if (xb_ld(&bar[XB_TMO])) break; if (sp > XB_SPIN_CAP) { atomicAdd(&bar[XB_TMO], 1u); break; } }
    }
    nloc = mine > 0u ? mine : 1u; nx = cnt > 0u ? cnt : 1u;
}
__device__ __forceinline__ void xcd_barrier(const XcdBarrier& b) {
    asm volatile("s_waitcnt vmcnt(0)" ::: "memory");
    __syncthreads();
    if (threadIdx.x == 0) {
        unsigned* bar = b.bar; { size_t z_ = 0; asm volatile("" : "+s"(z_)); bar += z_; }
        __builtin_amdgcn_s_waitcnt(0);
        unsigned nloc = b.st[0], nx = b.st[1];
        if (nloc == 0u) { xcd_barrier_complete(bar, b.x, nloc, nx); b.st[0] = nloc; b.st[1] = nx; }
        const unsigned old = xb_add(&bar[XB_XSUB(b.x)], 1u);
        const unsigned gen = old / nloc;
        if (old + 1u == (gen + 1u) * nloc) {
            __builtin_amdgcn_fence(__ATOMIC_RELEASE, "agent");
            asm volatile("s_waitcnt vmcnt(0)" ::: "memory");
            const unsigned og = xb_add(&bar[XB_TOP], 1u);
            const unsigned tg = og / nx;
            if (og + 1u == (tg + 1u) * nx) xb_add(&bar[XB_TOPGEN], 1u);
            else XB_SPIN(xb_ld(&bar[XB_TOPGEN]) == tg, bar);
            __builtin_amdgcn_fence(__ATOMIC_ACQUIRE, "agent");
            xb_add(&bar[XB_XGEN(b.x)], 1u);
            asm volatile("s_waitcnt vmcnt(0)" ::: "memory");
        } else {
            XB_SPIN(xb_ld(&bar[XB_XGEN(b.x)]) == gen, bar);
            __builtin_amdgcn_fence(__ATOMIC_ACQUIRE, "agent");
            asm volatile("s_waitcnt vmcnt(0)" ::: "memory");
        }
    }
    __syncthreads();
}

__device__ __forceinline__ u32x4 ld16_sc1_nowait(const void* p) { u32x4 v; asm volatile("global_load_dwordx4 %0, %1, off sc0 sc1" : "=v"(v) : "v"(p) : "memory"); return v; }
__device__ __forceinline__ u32x4 ld16_sc1(const void* p) { u32x4 v; asm volatile("global_load_dwordx4 %0, %1, off sc0 sc1\n\ts_waitcnt vmcnt(0)" : "=v"(v) : "v"(p) : "memory"); return v; }
using pg8::Unit;
struct LnFold {
    const float* stats; const float* sn; const float* tn;
    __device__ __forceinline__ void row(int r, float& mu, float& rs) const {
        if (!stats) { mu = 0.f; rs = 1.f; return; }
        const f32x2 st = *(const f32x2*)(stats + 2 * (size_t)r); const float m_ = st.x * (1.0f / D); rs = __builtin_amdgcn_rsqf(st.y * (1.0f / D) - m_ * m_ + LN_EPS); mu = -m_ * rs;
    }
    __device__ __forceinline__ void cols(int c, float (&s)[8], float (&t)[8]) const {
        if (!stats) {
#pragma unroll
            for (int j = 0; j < 8; ++j) { s[j] = 0.f; t[j] = 0.f; }
            return; }
        const f32x4 s0 = *(const f32x4*)(sn + c), s1 = *(const f32x4*)(sn + c + 4), t0 = *(const f32x4*)(tn + c), t1 = *(const f32x4*)(tn + c + 4);
        s[0] = s0.x; s[1] = s0.y; s[2] = s0.z; s[3] = s0.w; s[4] = s1.x; s[5] = s1.y; s[6] = s1.z; s[7] = s1.w;
        t[0] = t0.x; t[1] = t0.y; t[2] = t0.z; t[3] = t0.w; t[4] = t1.x; t[5] = t1.y; t[6] = t1.z; t[7] = t1.w;
    }
};
struct EpiSwiglu {
    static constexpr bool PERM = true, AFTER_DRAIN = false;
    bf16* H; LnFold ln;
    __device__ __forceinline__ void operator()(const f32x4 (&acc)[2][2][4][2], const Unit& u, int wr, int wc, int fr, int fq) const {
        const int row0 = u.pm * 256 + wr * 64 + fr, col0 = u.pn * 128 + wc * 32 + 8 * fq, wrow = u.pn * 256 + wc * 32 + 8 * fq;
        float sg[8], tg[8], su[8], tu[8];
        ln.cols(wrow, sg, tg); ln.cols(wrow + 128, su, tu);
#pragma unroll
        for (int ai = 0; ai < 2; ++ai)
#pragma unroll
            for (int m = 0; m < 4; ++m) {
                const int row = row0 + ai * 128 + m * 16;
                float mu, rs; ln.row(row, mu, rs);
                float h[8];
#pragma unroll
                for (int n = 0; n < 2; ++n)
#pragma unroll
                    for (int j = 0; j < 4; ++j) { const float g = __builtin_fmaf(rs, acc[ai][0][m][n][j], __builtin_fmaf(mu, sg[4 * n + j], tg[4 * n + j])), up = __builtin_fmaf(rs, acc[ai][1][m][n][j], __builtin_fmaf(mu, su[4 * n + j], tu[4 * n + j]));
                        h[4 * n + j] = g * fsigmoid(g) * up; }
                u32x4 w; w.x = pk2(h[0], h[1]); w.y = pk2(h[2], h[3]); w.z = pk2(h[4], h[5]); w.w = pk2(h[6], h[7]);
                if (H_NT) __builtin_nontemporal_store(w, (u32x4*)(H + (size_t)row * FF_LD + col0)); else *(u32x4*)(H + (size_t)row * FF_LD + col0) = w;
            }
    }
};
struct EpiResidLn {
    static constexpr bool PERM = true, AFTER_DRAIN = false;
    const float* xin;
    bf16* ZB; const bf16* zl_in; bf16* zl_out; const float* stats_prev; const float* g_prev; const float* b_prev; float* stats_out; float alpha, scale;
    __device__ __forceinline__ void operator()(const f32x4 (&acc)[2][2][4][2], const Unit& u, int wr, int wc, int fr, int fq) const {
        const int row0 = u.pm * 256 + wr * 64 + fr;
        float gg[2][8], bb[2][8];
#pragma unroll
        for (int bj = 0; bj < 2; ++bj) { const int col = u.pn * 256 + bj * 128 + wc * 32 + 8 * fq;
            if (xin) {
#pragma unroll
                for (int j = 0; j < 8; ++j) { gg[bj][j] = 1.f; bb[bj][j] = 0.f; }
            } else { const f32x4 g0 = *(const f32x4*)(g_prev + col), g1 = *(const f32x4*)(g_prev + col + 4), b0 = *(const f32x4*)(b_prev + col), b1 = *(const f32x4*)(b_prev + col + 4);
                gg[bj][0] = g0.x; gg[bj][1] = g0.y; gg[bj][2] = g0.z; gg[bj][3] = g0.w; gg[bj][4] = g1.x; gg[bj][5] = g1.y; gg[bj][6] = g1.z; gg[bj][7] = g1.w;
                bb[bj][0] = b0.x; bb[bj][1] = b0.y; bb[bj][2] = b0.z; bb[bj][3] = b0.w; bb[bj][4] = b1.x; bb[bj][5] = b1.y; bb[bj][6] = b1.z; bb[bj][7] = b1.w; } }
#pragma unroll
        for (int ap = 0; ap < 4; ++ap) {
            const int ai = ap >> 1;
            f32x4 pv[2][2][2]; f32x2 st[2];
#pragma unroll
            for (int mm = 0; mm < 2; ++mm) {
                const int m = 2 * (ap & 1) + mm, row = row0 + ai * 128 + m * 16;
                st[mm] = xin ? (f32x2){0.f, 0.f} : *(const f32x2*)(stats_prev + 2 * (size_t)row);
#pragma unroll
                for (int bj = 0; bj < 2; ++bj) { const size_t off = (size_t)row * D + u.pn * 256 + bj * 128 + wc * 32 + 8 * fq;
                    if (xin) { pv[mm][bj][0] = *(const f32x4*)(xin + off); pv[mm][bj][1] = *(const f32x4*)(xin + off + 4); }
                    else { const u32x4 h = *(const u32x4*)(ZB + off), l = *(const u32x4*)(zl_in + off);
                        pv[mm][bj][0] = (f32x4){bflo(h.x) + bflo(l.x), bfhi(h.x) + bfhi(l.x), bflo(h.y) + bflo(l.y), bfhi(h.y) + bfhi(l.y)};
                        pv[mm][bj][1] = (f32x4){bflo(h.z) + bflo(l.z), bfhi(h.z) + bfhi(l.z), bflo(h.w) + bflo(l.w), bfhi(h.w) + bfhi(l.w)}; } }
            }
#pragma unroll
            for (int mm = 0; mm < 2; ++mm) {
                const int m = 2 * (ap & 1) + mm, row = row0 + ai * 128 + m * 16;
                float mu = 0.f, rs = 1.f;
                if (!xin) { mu = st[mm].x * (1.0f / D); rs = __builtin_amdgcn_rsqf(st[mm].y * (1.0f / D) - mu * mu + LN_EPS); }
                float s1 = 0.f, s2 = 0.f;
#pragma unroll
                for (int bj = 0; bj < 2; ++bj) {
                    const size_t off = (size_t)row * D + u.pn * 256 + bj * 128 + wc * 32 + 8 * fq;
                    float z[8], zr[8];
#pragma unroll
                    for (int j = 0; j < 8; ++j) { const float xp = (pv[mm][bj][j >> 2][j & 3] - mu) * rs * gg[bj][j] + bb[bj][j]; z[j] = alpha * xp + scale * acc[ai][bj][m][j >> 2][j & 3]; s1 += z[j]; s2 += z[j] * z[j]; }
                    u32x4 o; o.x = pk2(z[0], z[1]); o.y = pk2(z[2], z[3]); o.z = pk2(z[4], z[5]); o.w = pk2(z[6], z[7]);
                    zr[0] = z[0] - bflo(o.x); zr[1] = z[1] - bfhi(o.x); zr[2] = z[2] - bflo(o.y); zr[3] = z[3] - bfhi(o.y); zr[4] = z[4] - bflo(o.z); zr[5] = z[5] - bfhi(o.z); zr[6] = z[6] - bflo(o.w); zr[7] = z[7] - bfhi(o.w);
                    u32x4 ol; ol.x = pk2(zr[0], zr[1]); ol.y = pk2(zr[2], zr[3]); ol.z = pk2(zr[4], zr[5]); ol.w = pk2(zr[6], zr[7]);
                    *(u32x4*)(ZB + off) = o; *(u32x4*)(zl_out + off) = ol;
                }
                s1 = xsum_16_32(s1); s2 = xsum_16_32(s2);
                if (fq < 2) unsafeAtomicAdd(stats_out + 2 * (size_t)row + fq, fq ? s2 : s1);
            }
            asm volatile("" ::: "memory");
        }
    }
};
struct EpiResidLnFinal {
    static constexpr bool PERM = true, AFTER_DRAIN = false;
    const bf16* ZB; const bf16* zl_in; const float* stats_prev; const float* g_prev; const float* b_prev; float* stats_out; unsigned* pcnt; const float* g_fin; const float* b_fin; float* out; float alpha, scale;
    __device__ __forceinline__ void operator()(const f32x4 (&acc_)[2][2][4][2], const Unit& u, int wr, int wc, int fr_, int fq_) const {
        f32x4 (&acc)[2][2][4][2] = const_cast<f32x4 (&)[2][2][4][2]>(acc_);
        int fr = fr_, fq = fq_; asm volatile("" : "+v"(fr), "+v"(fq));
        int row0 = u.pm * 256 + wr * 64 + fr;
        {
            float gg[2][8], bb[2][8];
#pragma unroll
            for (int bj = 0; bj < 2; ++bj) { const int col = u.pn * 256 + bj * 128 + wc * 32 + 8 * fq;
                const f32x4 g0 = *(const f32x4*)(g_prev + col), g1 = *(const f32x4*)(g_prev + col + 4), b0 = *(const f32x4*)(b_prev + col), b1 = *(const f32x4*)(b_prev + col + 4);
                gg[bj][0] = g0.x; gg[bj][1] = g0.y; gg[bj][2] = g0.z; gg[bj][3] = g0.w; gg[bj][4] = g1.x; gg[bj][5] = g1.y; gg[bj][6] = g1.z; gg[bj][7] = g1.w;
                bb[bj][0] = b0.x; bb[bj][1] = b0.y; bb[bj][2] = b0.z; bb[bj][3] = b0.w; bb[bj][4] = b1.x; bb[bj][5] = b1.y; bb[bj][6] = b1.z; bb[bj][7] = b1.w; }
#pragma unroll
            for (int ap = 0; ap < 4; ++ap) {
                const int ai = ap >> 1;
                f32x4 pv[2][2][2]; f32x2 st[2];
#pragma unroll
                for (int mm = 0; mm < 2; ++mm) {
                    const int m = 2 * (ap & 1) + mm, row = row0 + ai * 128 + m * 16;
                    st[mm] = *(const f32x2*)(stats_prev + 2 * (size_t)row);
#pragma unroll
                    for (int bj = 0; bj < 2; ++bj) { const size_t off = (size_t)row * D + u.pn * 256 + bj * 128 + wc * 32 + 8 * fq;
                        const u32x4 h = *(const u32x4*)(ZB + off), l = *(const u32x4*)(zl_in + off);
                        pv[mm][bj][0] = (f32x4){bflo(h.x) + bflo(l.x), bfhi(h.x) + bfhi(l.x), bflo(h.y) + bflo(l.y), bfhi(h.y) + bfhi(l.y)};
                        pv[mm][bj][1] = (f32x4){bflo(h.z) + bflo(l.z), bfhi(h.z) + bfhi(l.z), bflo(h.w) + bflo(l.w), bfhi(h.w) + bfhi(l.w)}; }
                }
#pragma unroll
                for (int mm = 0; mm < 2; ++mm) {
                    const int m = 2 * (ap & 1) + mm, row = row0 + ai * 128 + m * 16;
                    const float mu = st[mm].x * (1.0f / D), rs = __builtin_amdgcn_rsqf(st[mm].y * (1.0f / D) - mu * mu + LN_EPS);
                    float s1 = 0.f, s2 = 0.f;
#pragma unroll
                    for (int bj = 0; bj < 2; ++bj)
#pragma unroll
                        for (int j = 0; j < 8; ++j) { const float xp = (pv[mm][bj][j >> 2][j & 3] - mu) * rs * gg[bj][j] + bb[bj][j]; const float z = alpha * xp + scale * acc[ai][bj][m][j >> 2][j & 3];
                            acc[ai][bj][m][j >> 2][j & 3] = z; s1 += z; s2 += z * z; }
                    s1 = xsum_16_32(s1); s2 = xsum_16_32(s2);
                    if (fq < 2) unsafeAtomicAdd(stats_out + 2 * (size_t)row + fq, fq ? s2 : s1);
                }
                asm volatile("" ::: "memory");
            }
        }
        asm volatile("s_waitcnt vmcnt(0)" ::: "memory");
        __syncthreads();
        if (threadIdx.x == 0) {
            unsigned* pc = pcnt + 16 * u.pm;
            (void)xb_add(pc, 1u);
            unsigned sp = 0u;
            while (xb_ld(pc) < (unsigned)(D / 256) && ++sp < (1u << 22)) __builtin_amdgcn_s_sleep(1);
            __builtin_amdgcn_fence(__ATOMIC_ACQUIRE, "agent");
        }
        __syncthreads();
        asm volatile("" : "+v"(fr), "+v"(fq)); row0 = u.pm * 256 + wr * 64 + fr;
        {
            float gf[2][8], bf_[2][8];
#pragma unroll
            for (int bj = 0; bj < 2; ++bj) { const int col = u.pn * 256 + bj * 128 + wc * 32 + 8 * fq;
                const f32x4 g0 = *(const f32x4*)(g_fin + col), g1 = *(const f32x4*)(g_fin + col + 4), b0 = *(const f32x4*)(b_fin + col), b1 = *(const f32x4*)(b_fin + col + 4);
                gf[bj][0] = g0.x; gf[bj][1] = g0.y; gf[bj][2] = g0.z; gf[bj][3] = g0.w; gf[bj][4] = g1.x; gf[bj][5] = g1.y; gf[bj][6] = g1.z; gf[bj][7] = g1.w;
                bf_[bj][0] = b0.x; bf_[bj][1] = b0.y; bf_[bj][2] = b0.z; bf_[bj][3] = b0.w; bf_[bj][4] = b1.x; bf_[bj][5] = b1.y; bf_[bj][6] = b1.z; bf_[bj][7] = b1.w; }
            float mu8[2][4], rs8[2][4];
#pragma unroll
            for (int ai = 0; ai < 2; ++ai)
#pragma unroll
                for (int m = 0; m < 4; ++m) { float* sp_ = stats_out + 2 * (size_t)(row0 + ai * 128 + m * 16);
                    mu8[ai][m] = __hip_atomic_load(sp_, __ATOMIC_RELAXED, __HIP_MEMORY_SCOPE_AGENT); rs8[ai][m] = __hip_atomic_load(sp_ + 1, __ATOMIC_RELAXED, __HIP_MEMORY_SCOPE_AGENT); }
#pragma unroll
            for (int ai = 0; ai < 2; ++ai)
#pragma unroll
                for (int m = 0; m < 4; ++m) { const float mean = mu8[ai][m] * (1.0f / D); rs8[ai][m] = __builtin_amdgcn_rsqf(rs8[ai][m] * (1.0f / D) - mean * mean + LN_EPS); mu8[ai][m] = mean; }
#pragma unroll
            for (int ai = 0; ai < 2; ++ai)
#pragma unroll
                for (int m = 0; m < 4; ++m) {
                    const int row = row0 + ai * 128 + m * 16;
#pragma unroll
                    for (int bj = 0; bj < 2; ++bj) { float* op = out + (size_t)row * D + u.pn * 256 + bj * 128 + wc * 32 + 8 * fq;
                        f32x4 o0, o1;
#pragma unroll
                        for (int j = 0; j < 4; ++j) { o0[j] = (acc[ai][bj][m][0][j] - mu8[ai][m]) * rs8[ai][m] * gf[bj][j] + bf_[bj][j]; o1[j] = (acc[ai][bj][m][1][j] - mu8[ai][m]) * rs8[ai][m] * gf[bj][4 + j] + bf_[bj][4 + j]; }
                        *(f32x4*)op = o0; *(f32x4*)(op + 4) = o1; }
                }
        }
    }
};
template <int MODE  > struct EpiBf {
    static constexpr bool PERM = true, AFTER_DRAIN = false;
    bf16* O; int ldc; const float* ssq; const float* cosT; const float* sinT; LnFold ln;
    __device__ __forceinline__ void operator()(const f32x4 (&acc)[2][2][4][2], const Unit& u, int wr, int wc, int fr, int fq) const {
        const int row0 = u.pm * 256 + wr * 64 + fr;
        float sc[2][8], tc[2][8];
#pragma unroll
        for (int bj = 0; bj < 2; ++bj) ln.cols(u.pn * 256 + bj * 128 + wc * 32 + 8 * fq, sc[bj], tc[bj]);
#pragma unroll
        for (int ai = 0; ai < 2; ++ai)
#pragma unroll
            for (int m = 0; m < 4; ++m) {
                const int row = row0 + ai * 128 + m * 16;
                float rs = 1.f;
                if (MODE == 1 || MODE == 2) rs = __builtin_amdgcn_rsqf(ssq[row] * (1.0f / 512.0f) + RMS_EPS);
                float mu, lr; ln.row(row, mu, lr);
#pragma unroll
                for (int bj = 0; bj < 2; ++bj) {
                    const int col0 = u.pn * 256 + bj * 128 + wc * 32 + 8 * fq;
                    float v[8];
#pragma unroll
                    for (int n = 0; n < 2; ++n)
#pragma unroll
                        for (int j = 0; j < 4; ++j) v[4 * n + j] = __builtin_fmaf(lr, acc[ai][bj][m][n][j], __builtin_fmaf(mu, sc[bj][4 * n + j], tc[bj][4 * n + j])) * rs;
                    if (MODE == 2) {
                        const int hd = col0 / 192, w = col0 - hd * 192;
                        if (w >= 128) {
                            const int pos = row & (SEQ - 1), jj0 = (w - 128) >> 1;
                            const f32x4 c = *(const f32x4*)(cosT + pos * 32 + jj0), s = *(const f32x4*)(sinT + pos * 32 + jj0);
#pragma unroll
                            for (int p = 0; p < 4; ++p) { const float a = v[2 * p], b = v[2 * p + 1]; v[2 * p] = a * c[p] - b * s[p]; v[2 * p + 1] = a * s[p] + b * c[p]; }
                        }
                    }
                    u32x4 o; o.x = pk2(v[0], v[1]); o.y = pk2(v[2], v[3]); o.z = pk2(v[4], v[5]); o.w = pk2(v[6], v[7]);
                    *(u32x4*)(O + (size_t)row * ldc + col0) = o;
                }
            }
    }
};
struct EpiWin {
    static constexpr bool PERM = true, AFTER_DRAIN = false;
    bf16 *CQ, *CKV, *Z, *QKV, *KPE; float* ssq_q; float* ssq_kv; const float* cosT; const float* sinT; LnFold ln;
    __device__ __forceinline__ void operator()(const f32x4 (&acc)[2][2][4][2], const Unit& u, int wr, int wc, int fr, int fq) const {
        const int row0 = u.pm * 256 + wr * 64 + fr, pn = u.pn;
        bf16* base; int ldc, ct; int kind;
        float* ssq = nullptr;
        if (pn < 2) { base = CQ; ldc = 512; ct = pn; kind = 1; ssq = ssq_q; }
        else if (pn < 4) { base = CKV; ldc = 512; ct = pn - 2; kind = 1; ssq = ssq_kv; }
        else if (pn < 8) { base = Z; ldc = ZW; ct = pn - 4; kind = 2; }
        else if (pn < 26) { base = QKV; ldc = QKVW; ct = pn - 8; kind = 0; }
        else { base = KPE; ldc = 64; ct = 0; kind = 3; }
        float sc[2][8], tc[2][8];
#pragma unroll
        for (int bj = 0; bj < 2; ++bj) ln.cols(pn * 256 + bj * 128 + wc * 32 + 8 * fq, sc[bj], tc[bj]);
#pragma unroll
        for (int ai = 0; ai < 2; ++ai)
#pragma unroll
            for (int m = 0; m < 4; ++m) {
                const int row = row0 + ai * 128 + m * 16;
                float mu, lr; ln.row(row, mu, lr);
                float sq = 0.f;
#pragma unroll
                for (int bj = 0; bj < 2; ++bj) {
                    const int cl = bj * 128 + wc * 32 + 8 * fq;
                    float v[8];
#pragma unroll
                    for (int n = 0; n < 2; ++n)
#pragma unroll
                        for (int j = 0; j < 4; ++j) v[4 * n + j] = __builtin_fmaf(lr, acc[ai][bj][m][n][j], __builtin_fmaf(mu, sc[bj][4 * n + j], tc[bj][4 * n + j]));
                    if (kind == 1) {
#pragma unroll
                        for (int j = 0; j < 8; ++j) sq += v[j] * v[j];
                    }
                    if (kind == 2) {
#pragma unroll
                        for (int p = 0; p < 4; ++p) { const f32x2 g = pg8::gelu_pk((f32x2){v[2 * p], v[2 * p + 1]}); v[2 * p] = g.x; v[2 * p + 1] = g.y; }
                    }
                    if (kind == 3) {
                        if (cl < 64) {
                            const int pos = row & (SEQ - 1), jj0 = cl >> 1;
                            const f32x4 c = *(const f32x4*)(cosT + pos * 32 + jj0), s = *(const f32x4*)(sinT + pos * 32 + jj0);
#pragma unroll
                            for (int p = 0; p < 4; ++p) { const float a = v[2 * p], b = v[2 * p + 1]; v[2 * p] = a * c[p] - b * s[p]; v[2 * p + 1] = a * s[p] + b * c[p]; }
                        }
                    }
                    if (kind != 3 || cl < 64) {
                        u32x4 o; o.x = pk2(v[0], v[1]); o.y = pk2(v[2], v[3]); o.z = pk2(v[4], v[5]); o.w = pk2(v[6], v[7]);
                        *(u32x4*)(base + (size_t)row * ldc + ct * 256 + cl) = o;
                    }
                }
                if (kind == 1) {
                    sq = xsum_16_32(sq);
                    if (fq == 0) unsafeAtomicAdd(ssq + row, sq);
                }
            }
    }
};
struct EpiGate8 {
    static constexpr bool PERM = true, AFTER_DRAIN = false;
    unsigned char* G01; unsigned char* G2; LnFold ln;
    __device__ __forceinline__ void operator()(const f32x4 (&acc)[2][2][4][2], const Unit& u, int wr, int wc, int fr, int fq) const {
        const int row0 = u.pm * 256 + wr * 64 + fr, pl = u.pn >> 3, pc = (u.pn & 7) * 256;
        unsigned char* O = pl < 2 ? G01 + (size_t)pl * GATE_PLANE : G2;
        float sc[2][8], tc[2][8];
#pragma unroll
        for (int bj = 0; bj < 2; ++bj) ln.cols(u.pn * 256 + bj * 128 + wc * 32 + 8 * fq, sc[bj], tc[bj]);
#pragma unroll
        for (int ai = 0; ai < 2; ++ai)
#pragma unroll
            for (int m = 0; m < 4; ++m) {
                const int row = row0 + ai * 128 + m * 16;
                float mu, lr; ln.row(row, mu, lr);
#pragma unroll
                for (int bj = 0; bj < 2; ++bj) {
                    const int col0 = pc + bj * 128 + wc * 32 + 8 * fq;
                    unsigned b[8];
#pragma unroll
                    for (int n = 0; n < 2; ++n)
#pragma unroll
                        for (int j = 0; j < 4; ++j) b[4 * n + j] = (unsigned)(fsigmoid(__builtin_fmaf(lr, acc[ai][bj][m][n][j], __builtin_fmaf(mu, sc[bj][4 * n + j], tc[bj][4 * n + j]))) * 255.0f + 0.5f);
                    *(u32x2*)(O + (size_t)row * D + col0) = (u32x2){b[0] | (b[1] << 8) | (b[2] << 16) | (b[3] << 24), b[4] | (b[5] << 8) | (b[6] << 16) | (b[7] << 24)};
                }
            }
    }
};
struct EpiWinGate {
    static constexpr bool PERM = true, AFTER_DRAIN = false;
    EpiWin w; EpiGate8 g;
    __device__ __forceinline__ void operator()(const f32x4 (&acc)[2][2][4][2], const Unit& u, int wr, int wc, int fr, int fq) const {
        if (u.pn < NWIN / 256) w(acc, u, wr, wc, fr, fq); else { Unit v; v.pm = u.pm; v.pn = u.pn - NWIN / 256; g(acc, v, wr, wc, fr, fq); }
    }
};
struct EpiGate8Raw {
    static constexpr bool PERM = true, AFTER_DRAIN = false;
    unsigned char* O;
    __device__ __forceinline__ void operator()(const f32x4 (&acc)[2][2][4][2], const Unit& u, int wr, int wc, int fr, int fq) const {
        const int row0 = u.pm * 256 + wr * 64 + fr;
#pragma unroll
        for (int ai = 0; ai < 2; ++ai)
#pragma unroll
            for (int m = 0; m < 4; ++m)
#pragma unroll
                for (int bj = 0; bj < 2; ++bj) {
                    const f32x4 a = acc[ai][bj][m][0], b = acc[ai][bj][m][1];
                    *(u32x2*)(O + (size_t)(row0 + ai * 128 + m * 16) * NGATE + u.pn * 256 + bj * 128 + wc * 32 + 8 * fq) = (u32x2){pk2(a.x + a.y, a.z + a.w), pk2(b.x + b.y, b.z + b.w)};
                }
    }
};
struct EpiMerge {
    static constexpr bool PERM = true, AFTER_DRAIN = false;
    const unsigned char* G01; const unsigned char* G2; bf16* MG;
    template <int WHICH> __device__ __forceinline__ void scale(f32x4 (&acc)[2][2][4][2], const Unit& u, int wr, int wc, int fr_, int fq_) const {
        int fr = fr_, fq = fq_; asm volatile("" : "+v"(fr), "+v"(fq));
        const int row0 = u.pm * 256 + wr * 64 + fr;
#pragma unroll
        for (int ai = 0; ai < 2; ++ai) {
            u32x2 gn[4][2], gd[4][2];
#pragma unroll
            for (int m = 0; m < 4; ++m)
#pragma unroll
                for (int bj = 0; bj < 2; ++bj) {
                    const size_t go = (size_t)(row0 + ai * 128 + m * 16) * D + u.pn * 256 + bj * 128 + wc * 32 + 8 * fq;
                    gn[m][bj] = *(const u32x2*)((WHICH == 0 ? G01 : WHICH == 1 ? G01 + GATE_PLANE : G2) + go);
                    if (WHICH < 2) gd[m][bj] = *(const u32x2*)((WHICH == 0 ? G01 + GATE_PLANE : G2) + go); else gd[m][bj] = (u32x2){0u, 0u};
                }
#pragma unroll
            for (int m = 0; m < 4; ++m)
#pragma unroll
                for (int bj = 0; bj < 2; ++bj)
#pragma unroll
                    for (int j = 0; j < 8; ++j) {
                        const unsigned nb = ((j < 4 ? gn[m][bj].x : gn[m][bj].y) >> (8 * (j & 3))) & 255u, db = ((j < 4 ? gd[m][bj].x : gd[m][bj].y) >> (8 * (j & 3))) & 255u;
                        const float num = (float)(WHICH == 0 ? nb : (nb > 1u ? nb : 1u));
                        const float s = WHICH < 2 ? num * __builtin_amdgcn_rcpf((float)(db > 1u ? db : 1u)) : num * (1.0f / 255.0f);
                        acc[ai][bj][m][j >> 2][j & 3] *= s;
                    }
        }
    }
    __device__ __forceinline__ void mid(f32x4 (&acc)[2][2][4][2], const Unit& u, int which, int wr, int wc, int fr, int fq) const {
        if (which == 0) scale<0>(acc, u, wr, wc, fr, fq); else scale<1>(acc, u, wr, wc, fr, fq);
    }
    __device__ __forceinline__ void operator()(f32x4 (&acc)[2][2][4][2], const Unit& u, int wr, int wc, int fr, int fq) const {
        scale<2>(acc, u, wr, wc, fr, fq);
        const int row0 = u.pm * 256 + wr * 64 + fr;
#pragma unroll
        for (int ai = 0; ai < 2; ++ai)
#pragma unroll
            for (int m = 0; m < 4; ++m)
#pragma unroll
                for (int bj = 0; bj < 2; ++bj) {
                    const f32x4 a = acc[ai][bj][m][0], b = acc[ai][bj][m][1];
                    u32x4 o; o.x = pk2(a.x, a.y); o.y = pk2(a.z, a.w); o.z = pk2(b.x, b.y); o.w = pk2(b.z, b.w);
                    *(u32x4*)(MG + (size_t)(row0 + ai * 128 + m * 16) * D + u.pn * 256 + bj * 128 + wc * 32 + 8 * fq) = o;
                }
    }
};

struct Frame {
    LAS unsigned char* lds;
    gu32* ctl;
    unsigned char* ws;
    int wave, vcu, G, gw, NGW;
    float* out;
};
constexpr int PTR_OFF = LDSCTL_OFF + 256;
__device__ __forceinline__ const float* inptr(const Frame& F, int i) {
    int z = 0; asm volatile("" : "+v"(z));
    const volatile LAS unsigned* p = (const volatile LAS unsigned*)(F.lds + PTR_OFF + 8 * i + z);
    const unsigned lo = __builtin_amdgcn_readfirstlane(p[0]), hi = __builtin_amdgcn_readfirstlane(p[1]);
    return (const float*)(((unsigned long long)hi << 32) | lo);
}
#define INP(i) inptr(F, (i))
__device__ __forceinline__ int tid_opaque() { int t = (int)threadIdx.x; asm volatile("" : "+v"(t)); return t; }
#define TID_ tid_opaque()
#define LANE_ (tid_opaque() & 63)
template <class T> __device__ __forceinline__ T* wsp(const Frame& F, size_t off) { return (T*)(F.ws + off); }
__device__ __forceinline__ size_t szero() { size_t z = 0; asm volatile("" : "+s"(z)); return z; }
__device__ __forceinline__ unsigned char* ws_launder(unsigned char* p) { return p + szero(); }
__device__ __forceinline__ int vlaunder(int v) { asm volatile("" : "+v"(v)); return v; }

__device__ __forceinline__ int rowmap(int mode, int n) {
    switch (mode) {
        case 1: return 256 * (n >> 7) + (n & 127);
        case 2: return 256 * (n >> 7) + 128 + (n & 127);
        case 3: {
            if (n < 1024) return n;
            if (n < 1088) { const int j = n - 1024; return 6656 + 2 * (j & 31) + (j >> 5); }
            return n - 64; }
        case 4: { const int hd = n / 192, w = n - hd * 192; if (w < 128) return n; const int j = w - 128; return hd * 192 + 128 + 2 * (j & 31) + (j >> 5); }
        default: return n;
    }
}
struct TrJob { const float* src; const float* ks; const float* lnb; float* sn; int ldw, K, nblk, mode, r; size_t dstoff; bool hit; };
__device__ __forceinline__ void tr_load(const TrJob& j, f32x4 (&v)[16], int lane) {
    const int k0 = 64 * (j.r / j.nblk), n0 = 64 * (j.r % j.nblk);
#pragma unroll
    for (int i = 0; i < 16; ++i) { const int kk = 4 * i + (lane >> 4); v[i] = __builtin_nontemporal_load((const f32x4*)(j.src + (size_t)(k0 + kk) * j.ldw + n0 + 4 * (lane & 15))); }
}
__device__ __forceinline__ void tr_store(const TrJob& j, const f32x4 (&v)[16], unsigned char* ws, LAS float* scr, LAS float* tmp, int lane) {
    const int k0 = 64 * (j.r / j.nblk), n0 = 64 * (j.r % j.nblk);
    bf16* WT = (bf16*)(ws + j.dstoff);
    f32x4 ts = (f32x4){0.f, 0.f, 0.f, 0.f};
#pragma unroll
    for (int i = 0; i < 16; ++i) { const int kk = 4 * i + (lane >> 4); f32x4 x = v[i];
        if (j.lnb) ts += x * j.lnb[k0 + kk];
        if (j.ks) x = x * j.ks[k0 + kk];
        LAS float* d = scr + kk * 65 + 4 * (lane & 15); d[0] = x.x; d[1] = x.y; d[2] = x.z; d[3] = x.w; }
    if (j.lnb) {
#pragma unroll
        for (int e = 0; e < 4; ++e) { float t = ts[e]; t += shx(t, 16); t += shx(t, 32); ts[e] = t; }
        if ((lane >> 4) == 0) {
#pragma unroll
            for (int e = 0; e < 4; ++e) tmp[4 * (lane & 15) + e] = ts[e];
        }
    }
    LDS_WAIT(); asm volatile("" ::: "memory");
    const int c8 = lane & 7;
#pragma unroll
    for (int jj = 0; jj < 8; ++jj) { const int n = (lane >> 3) + 8 * jj; const LAS float* s = scr + (8 * c8) * 65 + n;
        u32x4 o; o.x = pk2(s[0 * 65], s[1 * 65]); o.y = pk2(s[2 * 65], s[3 * 65]); o.z = pk2(s[4 * 65], s[5 * 65]); o.w = pk2(s[6 * 65], s[7 * 65]);
        const int drow = rowmap(j.mode, n0 + n);
        *(GAS u32x4*)(WT + (size_t)drow * j.K + k0 + 8 * c8) = o;
        if (j.lnb) { float sv = ((bflo(o.x) + bfhi(o.x)) + (bflo(o.y) + bfhi(o.y))) + ((bflo(o.z) + bfhi(o.z)) + (bflo(o.w) + bfhi(o.w)));
            sv += shx(sv, 1); sv += shx(sv, 2); sv += shx(sv, 4);
            if (c8 == 0) tmp[64 + n] = sv; } }
    LDS_WAIT(); asm volatile("" ::: "memory");
    if (j.lnb) {
        const int drow = rowmap(j.mode, n0 + lane);
        unsafeAtomicAdd(j.sn + SNT_N + drow, tmp[lane]); unsafeAtomicAdd(j.sn + drow, tmp[64 + lane]);
        LDS_WAIT(); asm volatile("" ::: "memory");
    }
}
__device__ __forceinline__ void cvt_rows(const Frame& F, const float* src, bf16* dst, size_t n) {
    for (size_t i = ((size_t)F.gw * 64 + LANE_) * 8; i < n; i += (size_t)F.NGW * 64 * 8) {
        const f32x4 a = __builtin_nontemporal_load((const f32x4*)(src + i)), b = __builtin_nontemporal_load((const f32x4*)(src + i + 4));
        u32x4 o; o.x = pk2(a.x, a.y); o.y = pk2(a.z, a.w); o.z = pk2(b.x, b.y); o.w = pk2(b.z, b.w);
        *(u32x4*)(dst + i) = o; }
}
__device__ __forceinline__ int t5_bucket(int dist) {
    if (dist < 16) return dist;
    const float df = (float)dist;
    int large = 16 + (int)(logf(df / 16.0f) / logf(128.0f) * 16.0f);
    return large < 31 ? large : 31;
}
__device__ __forceinline__ void p0_prologue(const Frame& F_, int l) {
    Frame F = F_;  F.ws = F_.ws + szero();
    LAS float* scr = (LAS float*)(F.lds + F.wave * 16640);
    LAS float* tmp = (LAS float*)(F.lds + 8 * 16640 + F.wave * 512);
#define TRJOB(SRC, LDW, KK, NN, DSTOFF, MODE, KS, LNB, SNOFF) if (!j.hit) { const int items = ((KK) / 64) * ((NN) / 64); if (r < items) { j.hit = true; j.src = (SRC); j.ldw = (LDW); j.K = (KK); j.nblk = (NN) / 64; \
        j.dstoff = (DSTOFF); j.mode = (MODE); j.ks = (KS); j.lnb = (LNB); j.sn = snt + (SNOFF); j.r = r; } else r -= items; }
    const float* wg = INP(4) + (size_t)l * 2 * D * FF; const float* wu = INP(5) + (size_t)l * 2 * D * FF; const float* wd = INP(6) + (size_t)l * 2 * FF * D;
    const float* win = INP(7) + (size_t)l * D * N_IN_SRC;
    const float* wbr = INP(17) + (size_t)l * D * D;
    const float* lng = INP(2); const float* lnb = INP(3);
    const float* g_f0 = l ? lng + (size_t)((l - 1) * 4 + 3) * D : nullptr; const float* b_f0 = l ? lnb + (size_t)((l - 1) * 4 + 3) * D : nullptr;
    const float* g_m = lng + (size_t)(l * 4 + 0) * D; const float* b_m = lnb + (size_t)(l * 4 + 0) * D;
    const float* g_x = lng + (size_t)(l * 4 + 1) * D; const float* b_x = lnb + (size_t)(l * 4 + 1) * D;
    const float* g_f1 = lng + (size_t)(l * 4 + 2) * D; const float* b_f1 = lnb + (size_t)(l * 4 + 2) * D;
    float* snt = (float*)(F.ws + CTL_SNT) + (size_t)l * 2 * SNT_N;
    constexpr int ITEMS = 6 * (D / 64) * (FF / 64) + (D / 64) * (N_IN_SRC / 64) + (512 / 64) * ((QW + KVW) / 64) + 2 * (D / 64) * (D / 64) + (D / 64) * ((512 + 1024) / 64) + (512 / 64) * (D / 64);
    auto select = [&](int it) -> TrJob {
        TrJob j; j.hit = false; j.src = nullptr; j.ks = nullptr; j.lnb = nullptr; j.sn = nullptr; j.ldw = 0; j.K = 0; j.nblk = 1; j.mode = 0; j.r = 0; j.dstoff = 0;
        if (it >= ITEMS) return j;
        int r = it;
        TRJOB(wg, FF, D, FF, W_GU0, 1, g_f0, b_f0, SNT_FFN0)
        TRJOB(wu, FF, D, FF, W_GU0, 2, g_f0, b_f0, SNT_FFN0)
        TRJOB(wd, D, FF, D, W_D0, 0, nullptr, nullptr, 0)
        TRJOB(wg + (size_t)D * FF, FF, D, FF, W_GU1, 1, g_f1, b_f1, SNT_FFN1)
        TRJOB(wu + (size_t)D * FF, FF, D, FF, W_GU1, 2, g_f1, b_f1, SNT_FFN1)
        TRJOB(wd + (size_t)FF * D, D, FF, D, W_D1, 0, nullptr, nullptr, 0)
        TRJOB(win, N_IN_SRC, D, NWIN_SRC, W_IN, 3, g_m, b_m, SNT_WIN)
        TRJOB(win + NWIN_SRC, N_IN_SRC, D, NGATE, W_GATE, 0, g_m, b_m, SNT_GATE)
        TRJOB(INP(10) + (size_t)l * 512 * QW, QW, 512, QW, W_UQ, 4, INP(8) + l * 512, nullptr, 0)
        TRJOB(INP(11) + (size_t)l * 512 * KVW, KVW, 512, KVW, W_UKV, 0, INP(9) + l * 512, nullptr, 0)
        TRJOB(wbr, D, D, D, W_PA, 0, nullptr, nullptr, 0)
        TRJOB(INP(18) + (size_t)l * D * D, D, D, D, W_OUT, 0, nullptr, nullptr, 0)
        TRJOB(INP(19) + (size_t)l * D * 512, 512, D, 512, W_XQ, 0, g_x, b_x, SNT_XQ)
        TRJOB(INP(20) + (size_t)l * D * 1024, 1024, D, 1024, W_XKV, 0, nullptr, nullptr, 0)
        TRJOB(INP(21) + (size_t)l * 512 * D, D, 512, D, W_XO, 0, nullptr, nullptr, 0)
        return j;
    };
    {
        f32x4 va[16], vb[16];
        int it = F.gw; TrJob ja = select(it); if (ja.hit) tr_load(ja, va, LANE_);
        while (ja.hit) {
            TrJob jb = select(it + F.NGW); if (jb.hit) tr_load(jb, vb, LANE_);
            tr_store(ja, va, F.ws, scr, tmp, LANE_);
            if (!jb.hit) break;
            it += 2 * F.NGW; ja = select(it); if (ja.hit) tr_load(ja, va, LANE_);
            tr_store(jb, vb, F.ws, scr, tmp, LANE_);
        }
    }
#undef TRJOB
    { bf16* pad = wsp<bf16>(F, W_IN) + (size_t)NWIN_SRC * D; const size_t n = (size_t)(NWIN - NWIN_SRC) * D;
      const unsigned z_ = (unsigned)vlaunder(0);
      for (size_t i = ((size_t)F.gw * 64 + LANE_) * 8; i < n; i += (size_t)F.NGW * 64 * 8) *(u32x4*)(pad + i) = (u32x4){z_, z_, z_, z_}; }
    { const float* ws_ = INP(14) + (size_t)l * 4 * 128 * 128; bf16* o = wsp<bf16>(F, TAB_SGUW);
      for (int i = F.gw * 64 + LANE_; i < 4 * 128 * 128; i += F.NGW * 64) { const int t = (i >> 7) & 127, s = i & 127; o[i] = (bf16)(pk2(s <= t ? ws_[i] : 0.f, 0.f) & 0xffffu); } }
    if (l == 0) {
        cvt_rows(F, INP(0), wsp<bf16>(F, WS_XB), (size_t)M * D);
        cvt_rows(F, INP(1), wsp<bf16>(F, WS_MEMB), (size_t)BATCH * MEM * D);
        float* cosT = wsp<float>(F, TAB_COS); float* sinT = wsp<float>(F, TAB_SIN);
        for (int i = F.gw * 64 + LANE_; i < SEQ * 32; i += F.NGW * 64) { const int pos = i >> 5, j = i & 31;
            const float inv = powf(10000.0f, -(float)(2 * j) / 64.0f); const float ang = (float)pos * inv; cosT[i] = cosf(ang); sinT[i] = sinf(ang); }
        float* bt = wsp<float>(F, TAB_BIAS); const float* rel = INP(16);
        for (int i = F.gw * 64 + LANE_; i < 12 * BIAS_STRIDE; i += F.NGW * 64) { const int gh = i / BIAS_STRIDE, j = i - gh * BIAS_STRIDE; const int g = gh >> 2;
            const int dil = g == 0 ? 1 : (g == 1 ? 4 : 16);
            bt[i] = j <= 128 ? rel[t5_bucket(j * dil) * 12 + gh] * LOG2E : 0.f; }
    }
}

__device__ __forceinline__ void ln_final(const Frame& F, const bf16* ZH, const bf16* ZLo, float* out, const float* g, const float* b) {
    const int lane_ = vlaunder(LANE_);
    for (int m = F.gw; m < M; m += F.NGW) {
        const GAS u32x4* hr = (const GAS u32x4*)(ZH + (size_t)m * D) + lane_; const GAS u32x4* lr = (const GAS u32x4*)(ZLo + (size_t)m * D) + lane_;
        float v[4][8]; float s = 0.f;
#pragma unroll
        for (int j = 0; j < 4; ++j) { const u32x4 h = hr[64 * j], l = lr[64 * j];
            v[j][0] = bflo(h.x) + bflo(l.x); v[j][1] = bfhi(h.x) + bfhi(l.x); v[j][2] = bflo(h.y) + bflo(l.y); v[j][3] = bfhi(h.y) + bfhi(l.y);
            v[j][4] = bflo(h.z) + bflo(l.z); v[j][5] = bfhi(h.z) + bfhi(l.z); v[j][6] = bflo(h.w) + bflo(l.w); v[j][7] = bfhi(h.w) + bfhi(l.w);
#pragma unroll
            for (int e = 0; e < 8; ++e) s += v[j][e]; }
        const float mean = wave_sum(s) * (1.f / D); float s2 = 0.f;
#pragma unroll
        for (int j = 0; j < 4; ++j)
#pragma unroll
            for (int e = 0; e < 8; ++e) { v[j][e] -= mean; s2 += v[j][e] * v[j][e]; }
        const float rstd = 1.f / sqrtf(wave_sum(s2) * (1.f / D) + LN_EPS);
        GAS f32x4* orow = (GAS f32x4*)(out + (size_t)m * D);
#pragma unroll
        for (int j = 0; j < 4; ++j) { const int c = 8 * (lane_ + 64 * j);
            const f32x4 g0 = *(const f32x4*)(g + c), g1 = *(const f32x4*)(g + c + 4), b0 = *(const f32x4*)(b + c), b1 = *(const f32x4*)(b + c + 4);
            orow[2 * (lane_ + 64 * j)] = (f32x4){v[j][0] * rstd * g0.x + b0.x, v[j][1] * rstd * g0.y + b0.y, v[j][2] * rstd * g0.z + b0.z, v[j][3] * rstd * g0.w + b0.w};
            orow[2 * (lane_ + 64 * j) + 1] = (f32x4){v[j][4] * rstd * g1.x + b1.x, v[j][5] * rstd * g1.y + b1.y, v[j][6] * rstd * g1.z + b1.z, v[j][7] * rstd * g1.w + b1.w}; }
    }
}

constexpr int AT_KN = 0, AT_KR = 16384, AT_V = 24576, AT_BUF = 43008, AT_BIAS = 4 * (16384 + 18432);
constexpr int VPITCH = 288;
template <int DK, int QT, int NWV, class Src, class Msk, bool PIPE = false>
__device__ __forceinline__ void attn_unit(const Frame& F, const Src& src, const Msk& msk, int kt0, int kt1) {
    constexpr int KS = DK / 32, NKC = DK == 192 ? 3 : 2, NT = 64 * NWV, NI = 1024 / NT, BUFB = (NWV == 8) ? AT_BUF : (AT_KR + 18432), OFF_V = (NWV == 8) ? AT_V : AT_KR;
    static_assert(NWV == 8 || DK == 128, "the half-workgroup form has no rope buffer");
    const int tid_ = vlaunder(TID_), lane = tid_ & 63, tid = tid_ & (NT - 1), w = F.wave & (NWV - 1), q16 = lane & 15, kq = lane >> 4;
    LAS unsigned char* lds = F.lds + (F.wave / NWV) * (2 * BUFB);
    bf16x8 qf[QT][KS];
#pragma unroll
    for (int qt = 0; qt < QT; ++qt) { const bf16* qr = src.qrow(w * 16 * QT + 16 * qt + q16);
#pragma unroll
        for (int ks = 0; ks < KS; ++ks) qf[qt][ks] = *(const bf16x8*)(qr + 32 * ks + 8 * kq); }
    f32x4 o[QT][8];
    float mrun[QT], lrun[QT];
    float z0 = 0.f; asm volatile("" : "+v"(z0));
#pragma unroll
    for (int qt = 0; qt < QT; ++qt) { mrun[qt] = NEGBIG; lrun[qt] = z0;
#pragma unroll
        for (int dt = 0; dt < 8; ++dt) o[qt][dt] = (f32x4){z0, z0, z0, z0}; }
    u32x4 kr[NI + (DK == 192 ? 1 : 0)], vr[NI];
#define AT_LOAD(kt) do { const int kb = 64 * (kt); \
        _Pragma("unroll") for (int i = 0; i < NI; ++i) { const int it = tid + NT * i, row = it >> 4, ch = it & 15; kr[i] = *(const u32x4*)src.kptr(kb + row, ch); vr[i] = *(const u32x4*)src.vptr(kb + row, ch); } \
        if (DK == 192) { const int row = tid >> 3, ch = tid & 7; kr[NI] = *(const u32x4*)src.kptr(kb + row, 16 + ch); } } while (0)
#define AT_STORE(buf) do { LAS unsigned char* bb = lds + (buf) * BUFB; \
        _Pragma("unroll") for (int i = 0; i < NI; ++i) { const int it = tid + NT * i, row = it >> 4, ch = it & 15; \
            *(LAS u32x4*)(bb + AT_KN + row * 256 + ((ch ^ (row & 15)) << 4)) = kr[i]; *(LAS u32x4*)(bb + OFF_V + row * VPITCH + (ch << 4)) = vr[i]; } \
        if (DK == 192) { const int row = tid >> 3, ch = tid & 7; *(LAS u32x4*)(bb + AT_KR + row * 128 + ((ch ^ ((row >> 1) & 7)) << 4)) = kr[NI]; } } while (0)
    if constexpr (PIPE) {
    static_assert(NWV == 8, "pipelined form: one unit per workgroup");
#define AT_LOADK(kt) do { const int kb = 64 * (kt); \
        _Pragma("unroll") for (int i = 0; i < NI; ++i) { const int it = tid + NT * i, row = it >> 4, ch = it & 15; kr[i] = *(const u32x4*)src.kptr(kb + row, ch); } \
        if (DK == 192) { const int row = tid >> 3, ch = tid & 7; kr[NI] = *(const u32x4*)src.kptr(kb + row, 16 + ch); } } while (0)
#define AT_LOADV(kt) do { const int kb = 64 * (kt); \
        _Pragma("unroll") for (int i = 0; i < NI; ++i) { const int it = tid + NT * i, row = it >> 4, ch = it & 15; vr[i] = *(const u32x4*)src.vptr(kb + row, ch); } } while (0)
#define AT_KBUF(slot) (lds + ((slot) < 2 ? (slot) * BUFB : 2 * BUFB))
#define AT_STOREK(slot) do { LAS unsigned char* bb = AT_KBUF(slot); \
        _Pragma("unroll") for (int i = 0; i < NI; ++i) { const int it = tid + NT * i, row = it >> 4, ch = it & 15; *(LAS u32x4*)(bb + AT_KN + row * 256 + ((ch ^ (row & 15)) << 4)) = kr[i]; } \
        if (DK == 192) { const int row = tid >> 3, ch = tid & 7; *(LAS u32x4*)(bb + AT_KR + row * 128 + ((ch ^ ((row >> 1) & 7)) << 4)) = kr[NI]; } } while (0)
#define AT_STOREV(buf) do { LAS unsigned char* bb = lds + (buf) * BUFB; \
        _Pragma("unroll") for (int i = 0; i < NI; ++i) { const int it = tid + NT * i, row = it >> 4, ch = it & 15; *(LAS u32x4*)(bb + OFF_V + row * VPITCH + (ch << 4)) = vr[i]; } } while (0)
#define AT_QKH(S_, slot, h) do { const LAS unsigned char* bb = AT_KBUF(slot); \
        _Pragma("unroll") for (int qt = 0; qt < QT; ++qt) _Pragma("unroll") for (int s2 = 0; s2 < 2; ++s2) S_[qt][s2] = (f32x4){0.f, 0.f, 0.f, 0.f}; \
        _Pragma("unroll") for (int s2 = 0; s2 < 2; ++s2) { const int row = 16 * (2 * (h) + s2) + q16; \
            _Pragma("unroll") for (int ks = 0; ks < KS; ++ks) { bf16x8 kf; \
                if (ks < 4) kf = *(const LAS bf16x8*)(bb + AT_KN + row * 256 + (((4 * ks + kq) ^ q16) << 4)); \
                else        kf = *(const LAS bf16x8*)(bb + AT_KR + row * 128 + (((4 * (ks - 4) + kq) ^ (q16 >> 1)) << 4)); \
                _Pragma("unroll") for (int qt = 0; qt < QT; ++qt) S_[qt][s2] = __builtin_amdgcn_mfma_f32_16x16x32_bf16(kf, qf[qt][ks], S_[qt][s2], 0, 0, 0); } } } while (0)
#define AT_SMPV(S_, kt, h, vbuf) do { bf16x8 pf[QT]; \
        _Pragma("unroll") for (int qt = 0; qt < QT; ++qt) { const int ql = w * 16 * QT + 16 * qt + q16; float mx = NEGBIG; \
            _Pragma("unroll") for (int s2 = 0; s2 < 2; ++s2) _Pragma("unroll") for (int j = 0; j < 4; ++j) { const float v = msk.apply(S_[qt][s2][j], ql, 64 * (kt) + 32 * (h) + 16 * s2 + 4 * kq + j); S_[qt][s2][j] = v; mx = fmaxf(mx, v); } \
            mx = xmax_16_32(mx); \
            const float mnew = fmaxf(mrun[qt], mx), alpha = __builtin_amdgcn_exp2f(mrun[qt] - mnew); mrun[qt] = mnew; float rs = 0.f; \
            _Pragma("unroll") for (int s2 = 0; s2 < 2; ++s2) _Pragma("unroll") for (int j = 0; j < 4; ++j) { const float p = __builtin_amdgcn_exp2f(S_[qt][s2][j] - mnew); S_[qt][s2][j] = p; rs += p; } \
            lrun[qt] = lrun[qt] * alpha + rs; \
            _Pragma("unroll") for (int dt = 0; dt < 8; ++dt) o[qt][dt] *= alpha; \
            u32x4 pw; pw.x = pk2(S_[qt][0][0], S_[qt][0][1]); pw.y = pk2(S_[qt][0][2], S_[qt][0][3]); pw.z = pk2(S_[qt][1][0], S_[qt][1][1]); pw.w = pk2(S_[qt][1][2], S_[qt][1][3]); \
            pf[qt] = __builtin_bit_cast(bf16x8, pw); } \
        const LAS unsigned char* vb = lds + (vbuf) * BUFB + OFF_V + (4 * kq + (q16 >> 2)) * VPITCH + (q16 & 3) * 8; \
        _Pragma("unroll") for (int dt = 0; dt < 8; ++dt) { \
            const s16x4 lo = __builtin_bit_cast(s16x4, __builtin_amdgcn_ds_read_tr16_b64_v4i16((LAS s16x4*)(vb + (32 * (h)) * VPITCH + dt * 32))); \
            const s16x4 hi = __builtin_bit_cast(s16x4, __builtin_amdgcn_ds_read_tr16_b64_v4i16((LAS s16x4*)(vb + (32 * (h) + 16) * VPITCH + dt * 32))); \
            const bf16x8 vf = __builtin_shufflevector(lo, hi, 0, 1, 2, 3, 4, 5, 6, 7); \
            _Pragma("unroll") for (int qt = 0; qt < QT; ++qt) o[qt][dt] = __builtin_amdgcn_mfma_f32_16x16x32_bf16(vf, pf[qt], o[qt][dt], 0, 0, 0); } } while (0)
    f32x4 sa[QT][2], sb[QT][2];
    AT_LOADK(kt0); AT_LOADV(kt0); AT_STOREK(0); AT_STOREV(0);
    if (kt0 + 1 < kt1) { AT_LOADK(kt0 + 1); AT_STOREK(1); }
    __syncthreads();
    if (msk.active(w, kt0)) AT_QKH(sa, 0, 0);
    int k0 = 0, k1 = 1, k2 = 2;
    for (int kt = kt0; kt < kt1; ++kt) {
        const int buf = (kt - kt0) & 1;
        if (kt + 2 < kt1) AT_LOADK(kt + 2);
        if (kt + 1 < kt1) AT_LOADV(kt + 1);
        const bool act = msk.active(w, kt), actn = (kt + 1 < kt1) && msk.active(w, kt + 1);
        if (act) { AT_QKH(sb, k0, 1); AT_SMPV(sa, kt, 0, buf); }
        if (actn) AT_QKH(sa, k1, 0);
        if (act) AT_SMPV(sb, kt, 1, buf);
        if (kt + 2 < kt1) AT_STOREK(k2);
        if (kt + 1 < kt1) AT_STOREV(buf ^ 1);
        __syncthreads();
        { const int t_ = k0; k0 = k1; k1 = k2; k2 = t_; }
    }
#undef AT_LOADK
#undef AT_LOADV
#undef AT_KBUF
#undef AT_STOREK
#undef AT_STOREV
#undef AT_QKH
#undef AT_SMPV
    } else {
    AT_LOAD(kt0); AT_STORE(0);
    __syncthreads();
    for (int kt = kt0; kt < kt1; ++kt) {
        const int buf = (kt - kt0) & 1;
        if (kt + 1 < kt1) AT_LOAD(kt + 1);
        if (msk.active(w, kt)) {
            const LAS unsigned char* bb = lds + buf * BUFB;
            f32x4 s[QT][4];
#pragma unroll
            for (int qt = 0; qt < QT; ++qt)
#pragma unroll
                for (int sub = 0; sub < 4; ++sub) s[qt][sub] = (f32x4){0.f, 0.f, 0.f, 0.f};
            {
                constexpr int KR = 6, NSTEP = 4 * KS;
                bf16x8 kfr[KR];
#define AT_KS_(idx) ((idx) >> 2)
#define AT_SUB_(idx) ((idx) & 3)
#define AT_KF(idx) (AT_KS_(idx) < 4 ? *(const LAS bf16x8*)(bb + AT_KN + (16 * AT_SUB_(idx) + q16) * 256 + (((4 * AT_KS_(idx) + kq) ^ q16) << 4)) \
                                     : *(const LAS bf16x8*)(bb + AT_KR + (16 * AT_SUB_(idx) + q16) * 128 + (((4 * (AT_KS_(idx) - 4) + kq) ^ (q16 >> 1)) << 4)))
#pragma unroll
                for (int i = 0; i < KR - 1; ++i) kfr[i] = AT_KF(i);
#pragma unroll
                for (int idx = 0; idx < NSTEP; ++idx) {
                    if (idx + KR - 1 < NSTEP) kfr[(idx + KR - 1) % KR] = AT_KF(idx + KR - 1);
#pragma unroll
                    for (int qt = 0; qt < QT; ++qt) s[qt][AT_SUB_(idx)] = __builtin_amdgcn_mfma_f32_16x16x32_bf16(kfr[idx % KR], qf[qt][AT_KS_(idx)], s[qt][AT_SUB_(idx)], 0, 0, 0);
                }
#undef AT_KF
#undef AT_KS_
#undef AT_SUB_
            }
            bf16x8 pf[QT][2];
#pragma unroll
            for (int qt = 0; qt < QT; ++qt) {
                const int ql = w * 16 * QT + 16 * qt + q16;
                float mx = NEGBIG;
#pragma unroll
                for (int sub = 0; sub < 4; ++sub)
#pragma unroll
                    for (int j = 0; j < 4; ++j) { const float v = msk.apply(s[qt][sub][j], ql, 64 * kt + 16 * sub + 4 * kq + j); s[qt][sub][j] = v; mx = fmaxf(mx, v); }
                mx = xmax_16_32(mx);
                const float mnew = fmaxf(mrun[qt], mx), alpha = __builtin_amdgcn_exp2f(mrun[qt] - mnew);
                mrun[qt] = mnew;
                float rs = 0.f;
#pragma unroll
                for (int sub = 0; sub < 4; ++sub)
#pragma unroll
                    for (int j = 0; j < 4; ++j) { const float p = __builtin_amdgcn_exp2f(s[qt][sub][j] - mnew); s[qt][sub][j] = p; rs += p; }
                lrun[qt] = lrun[qt] * alpha + rs;
#pragma unroll
                for (int dt = 0; dt < 8; ++dt) o[qt][dt] *= alpha;
#pragma unroll
                for (int c = 0; c < 2; ++c) {
                    u32x4 pw; pw.x = pk2(s[qt][2 * c][0], s[qt][2 * c][1]); pw.y = pk2(s[qt][2 * c][2], s[qt][2 * c][3]);
                    pw.z = pk2(s[qt][2 * c + 1][0], s[qt][2 * c + 1][1]); pw.w = pk2(s[qt][2 * c + 1][2], s[qt][2 * c + 1][3]);
                    pf[qt][c] = __builtin_bit_cast(bf16x8, pw);
                }
            }
            const LAS unsigned char* vb = bb + OFF_V + (4 * kq + (q16 >> 2)) * VPITCH + (q16 & 3) * 8;
            {
                constexpr int VR = 4;
                s16x4 vlo[VR], vhi[VR];
#define AT_VLO(st) __builtin_bit_cast(s16x4, __builtin_amdgcn_ds_read_tr16_b64_v4i16((LAS s16x4*)(vb + (32 * ((st) >> 3)) * VPITCH + ((st) & 7) * 32)))
#define AT_VHI(st) __builtin_bit_cast(s16x4, __builtin_amdgcn_ds_read_tr16_b64_v4i16((LAS s16x4*)(vb + (32 * ((st) >> 3) + 16) * VPITCH + ((st) & 7) * 32)))
#pragma unroll
                for (int i = 0; i < VR - 1; ++i) { vlo[i] = AT_VLO(i); vhi[i] = AT_VHI(i); }
#pragma unroll
                for (int st = 0; st < 16; ++st) {
                    if (st + VR - 1 < 16) { vlo[(st + VR - 1) % VR] = AT_VLO(st + VR - 1); vhi[(st + VR - 1) % VR] = AT_VHI(st + VR - 1); }
                    const bf16x8 vf = __builtin_shufflevector(vlo[st % VR], vhi[st % VR], 0, 1, 2, 3, 4, 5, 6, 7);
#pragma unroll
                    for (int qt = 0; qt < QT; ++qt) o[qt][st & 7] = __builtin_amdgcn_mfma_f32_16x16x32_bf16(vf, pf[qt][st >> 3], o[qt][st & 7], 0, 0, 0);
                }
#undef AT_VLO
#undef AT_VHI
            }
        }
        if (kt + 1 < kt1) AT_STORE(buf ^ 1);
        __syncthreads();
    }
    }
#undef AT_LOAD
#undef AT_STORE
#pragma unroll
    for (int qt = 0; qt < QT; ++qt) {
        float l = xsum_16_32(lrun[qt]);
        const float inv = 1.0f / l;
        const int ql = w * 16 * QT + 16 * qt + q16;
        bf16* orow = src.orow(ql);
#pragma unroll
        for (int dt = 0; dt < 8; ++dt) { const f32x4 v = o[qt][dt] * inv; *(u32x2*)(orow + 16 * dt + 4 * kq) = (u32x2){pk2(v.x, v.y), pk2(v.z, v.w)}; }
        if (kq == 0) src.put_lse(ql, (mrun[qt] + __builtin_amdgcn_logf(l)) * LN2);
    }
}

struct MlaSrc {
    const bf16* Q; const bf16* KV; const bf16* KPE; bf16* O; size_t rb; int h, q0;
    __device__ __forceinline__ const bf16* qrow(int r) const { return Q + (rb + q0 + r) * QW + h * 192; }
    __device__ __forceinline__ const bf16* kptr(int key, int ch) const { return ch < 16 ? KV + (rb + key) * KVW + h * 256 + ch * 8 : KPE + (rb + key) * 64 + (ch - 16) * 8; }
    __device__ __forceinline__ const bf16* vptr(int key, int ch) const { return KV + (rb + key) * KVW + h * 256 + 128 + ch * 8; }
    __device__ __forceinline__ bf16* orow(int r) const { return O + (rb + q0 + r) * 1024 + h * 128; }
    __device__ __forceinline__ void put_lse(int, float) const {}
};
struct MlaMsk {
    int q0; float c;
    __device__ __forceinline__ bool active(int w, int kt) const { return 64 * kt <= q0 + 32 * w + 31; }
    __device__ __forceinline__ float apply(float s, int ql, int key) const { return key <= q0 + ql ? s * c : NEGBIG; }
};
struct XaSrc {
    const bf16* Q; const bf16* KVX; bf16* O; size_t rb, kb; int h, q0;
    __device__ __forceinline__ const bf16* qrow(int r) const { return Q + (rb + q0 + r) * 512 + h * 128; }
    __device__ __forceinline__ const bf16* kptr(int key, int ch) const { return KVX + (kb + key) * 1024 + h * 128 + ch * 8; }
    __device__ __forceinline__ const bf16* vptr(int key, int ch) const { return KVX + (kb + key) * 1024 + 512 + h * 128 + ch * 8; }
    __device__ __forceinline__ bf16* orow(int r) const { return O + (rb + q0 + r) * 512 + h * 128; }
    __device__ __forceinline__ void put_lse(int, float) const {}
};
struct XaMsk {
    float c;
    __device__ __forceinline__ bool active(int, int) const { return true; }
    __device__ __forceinline__ float apply(float s, int, int) const { return s * c; }
};
struct DilSrc {
    bf16* QKV; float* LSE; size_t rb; int dil, r, n, col;
    __device__ __forceinline__ size_t row(int sub) const { return rb + (size_t)sub * dil + r; }
    __device__ __forceinline__ const bf16* qrow(int q) const { return QKV + row(128 * n + q) * QKVW + col; }
    __device__ __forceinline__ const bf16* kptr(int k, int ch) const { return QKV + row(128 * (n - 1) + k) * QKVW + 1536 + col + ch * 8; }
    __device__ __forceinline__ const bf16* vptr(int k, int ch) const { return QKV + row(128 * (n - 1) + k) * QKVW + 3072 + col + ch * 8; }
    __device__ __forceinline__ bf16* orow(int q) const { return QKV + row(128 * n + q) * QKVW + col; }
    __device__ __forceinline__ void put_lse(int q, float v) const { LSE[row(128 * n + q) * 4] = v; }
};
struct DilMsk {
    const LAS float* bias; float c;
    __device__ __forceinline__ bool active(int w, int kt) const { return 64 * kt + 63 >= 32 * w && 64 * kt <= 32 * w + 31 + 128; }
    __device__ __forceinline__ float apply(float s, int ql, int k) const { const int j = ql + 128 - k; const int jc = j < 0 ? 0 : (j > 128 ? 128 : j); const float bv = bias[jc]; return (j >= 0 && j <= 128) ? s * c + bv : NEGBIG; }
};

constexpr int SG_PITCH = 1056;
__device__ __forceinline__ void sgu_unit(const Frame& F, bf16* Z, const float* lng, const float* lnb, const bf16* SW, const float* bs, int unit) {
    const int lane = vlaunder(LANE_), w = F.wave, q16 = lane & 15, kq = lane >> 4;
    const size_t m0 = (size_t)unit * 128;
    LAS unsigned char* lds = F.lds;
    float gg[8], bb[8];
    { const f32x4 g0 = *(const f32x4*)(lng + 8 * lane), g1 = *(const f32x4*)(lng + 8 * lane + 4), b0 = *(const f32x4*)(lnb + 8 * lane), b1 = *(const f32x4*)(lnb + 8 * lane + 4);
      gg[0] = g0.x; gg[1] = g0.y; gg[2] = g0.z; gg[3] = g0.w; gg[4] = g1.x; gg[5] = g1.y; gg[6] = g1.z; gg[7] = g1.w;
      bb[0] = b0.x; bb[1] = b0.y; bb[2] = b0.z; bb[3] = b0.w; bb[4] = b1.x; bb[5] = b1.y; bb[6] = b1.z; bb[7] = b1.w; }
#pragma unroll 1
    for (int hb = 0; hb < 2; ++hb) {
        u32x4 raw[8]; float s[8], q[8];
#pragma unroll
        for (int i = 0; i < 8; ++i) raw[i] = *(const u32x4*)(Z + (m0 + 16 * w + 8 * hb + i) * ZW + 512 + 8 * lane);
#pragma unroll
        for (int i = 0; i < 8; ++i) s[i] = ((bflo(raw[i].x) + bfhi(raw[i].x)) + (bflo(raw[i].y) + bfhi(raw[i].y))) + ((bflo(raw[i].z) + bfhi(raw[i].z)) + (bflo(raw[i].w) + bfhi(raw[i].w)));
#pragma unroll
        for (int o = 1; o < 64; o <<= 1) {
#pragma unroll
            for (int i = 0; i < 8; ++i) s[i] += shx_l(s[i], o, lane); }
#pragma unroll
        for (int i = 0; i < 8; ++i) { const float mean = s[i] * (1.f / 512.f); s[i] = mean;
            const float v[8] = {bflo(raw[i].x) - mean, bfhi(raw[i].x) - mean, bflo(raw[i].y) - mean, bfhi(raw[i].y) - mean, bflo(raw[i].z) - mean, bfhi(raw[i].z) - mean, bflo(raw[i].w) - mean, bfhi(raw[i].w) - mean};
            float a2 = 0.f;
#pragma unroll
            for (int j = 0; j < 8; ++j) a2 += v[j] * v[j];
            q[i] = a2; }
#pragma unroll
        for (int o = 1; o < 64; o <<= 1) {
#pragma unroll
            for (int i = 0; i < 8; ++i) q[i] += shx_l(q[i], o, lane); }
#pragma unroll
        for (int i = 0; i < 8; ++i) { const float mean = s[i], rstd = 1.f / sqrtf(q[i] * (1.f / 512.f) + LN_EPS);
            float v[8] = {bflo(raw[i].x), bfhi(raw[i].x), bflo(raw[i].y), bfhi(raw[i].y), bflo(raw[i].z), bfhi(raw[i].z), bflo(raw[i].w), bfhi(raw[i].w)};
#pragma unroll
            for (int j = 0; j < 8; ++j) v[j] = (v[j] - mean) * rstd * gg[j] + bb[j];
            u32x4 o; o.x = pk2(v[0], v[1]); o.y = pk2(v[2], v[3]); o.z = pk2(v[4], v[5]); o.w = pk2(v[6], v[7]);
            *(LAS u32x4*)(lds + (16 * w + 8 * hb + i) * SG_PITCH + lane * 16) = o; }
    }
    __syncthreads();
    const int g = w >> 1, th = w & 1;
    bf16x8 wf[4][4];
#pragma unroll
    for (int tt = 0; tt < 4; ++tt) { const bf16* wr_ = SW + (size_t)g * 128 * 128 + (size_t)(16 * (4 * th + tt) + q16) * 128;
#pragma unroll
        for (int ks = 0; ks < 4; ++ks) { const u32x2 a = *(const u32x2*)(wr_ + 32 * ks + 4 * kq), b = *(const u32x2*)(wr_ + 32 * ks + 16 + 4 * kq);
            wf[tt][ks] = __builtin_bit_cast(bf16x8, (u32x4){a.x, a.y, b.x, b.y}); } }
    const LAS unsigned char* vb = lds + (4 * kq + (q16 >> 2)) * SG_PITCH + g * 256 + (q16 & 3) * 8;
    float bias4[4];
#pragma unroll
    for (int tt = 0; tt < 4; ++tt) bias4[tt] = bs[g * 128 + 16 * (4 * th + tt) + q16];
    u32x2 uu[4], un[4];
#pragma unroll
    for (int tt = 0; tt < 4; ++tt) uu[tt] = *(const u32x2*)(Z + (m0 + 16 * (4 * th + tt) + q16) * ZW + g * 128 + 4 * kq);
#pragma unroll 1
    for (int dt = 0; dt < 8; ++dt) {
        f32x4 acc[4];
#pragma unroll
        for (int tt = 0; tt < 4; ++tt) acc[tt] = (f32x4){0.f, 0.f, 0.f, 0.f};
        if (dt < 7) {
#pragma unroll
            for (int tt = 0; tt < 4; ++tt) un[tt] = *(const u32x2*)(Z + (m0 + 16 * (4 * th + tt) + q16) * ZW + g * 128 + 16 * (dt + 1) + 4 * kq);
        }
#pragma unroll
        for (int ks = 0; ks < 4; ++ks) {
            const s16x4 lo = __builtin_bit_cast(s16x4, __builtin_amdgcn_ds_read_tr16_b64_v4i16((LAS s16x4*)(vb + (32 * ks) * SG_PITCH + dt * 32)));
            const s16x4 hi = __builtin_bit_cast(s16x4, __builtin_amdgcn_ds_read_tr16_b64_v4i16((LAS s16x4*)(vb + (32 * ks + 16) * SG_PITCH + dt * 32)));
            const bf16x8 af = __builtin_shufflevector(lo, hi, 0, 1, 2, 3, 4, 5, 6, 7);
#pragma unroll
            for (int tt = 0; tt < 4; ++tt) acc[tt] = __builtin_amdgcn_mfma_f32_16x16x32_bf16(af, wf[tt][ks], acc[tt], 0, 0, 0);
        }
#pragma unroll
        for (int tt = 0; tt < 4; ++tt) {
            const int t = 16 * (4 * th + tt) + q16;
            const float bias = bias4[tt];
            bf16* up = Z + (m0 + t) * ZW + g * 128 + 16 * dt + 4 * kq;
            const float o0 = bflo(uu[tt].x) * (acc[tt].x + bias), o1 = bfhi(uu[tt].x) * (acc[tt].y + bias), o2 = bflo(uu[tt].y) * (acc[tt].z + bias), o3 = bfhi(uu[tt].y) * (acc[tt].w + bias);
            *(u32x2*)up = (u32x2){pk2(o0, o1), pk2(o2, o3)};
        }
#pragma unroll
        for (int tt = 0; tt < 4; ++tt) uu[tt] = un[tt];
    }
    __syncthreads();
}

__device__ __forceinline__ void dil_combine(const Frame& F, const bf16* QKV, const float* LSE, bf16* OC) {
    const int lane = vlaunder(LANE_), hh = lane >> 4;
    for (int m = F.gw; m < M; m += F.NGW) {
        const float l0 = LSE[((size_t)0 * M + m) * 4 + hh], l1 = LSE[((size_t)1 * M + m) * 4 + hh], l2 = LSE[((size_t)2 * M + m) * 4 + hh];
        const float mx = fmaxf(l0, fmaxf(l1, l2));
        float w0 = __expf(l0 - mx), w1 = __expf(l1 - mx), w2 = __expf(l2 - mx);
        const float inv = 1.0f / (w0 + w1 + w2); w0 *= inv; w1 *= inv; w2 *= inv;
        const bf16* qr = QKV + (size_t)m * QKVW + hh * 128 + (lane & 15) * 8;
        const u32x4 a = *(const u32x4*)qr, b = *(const u32x4*)(qr + 512), c = *(const u32x4*)(qr + 1024);
        u32x4 o;
        o.x = pk2(w0 * bflo(a.x) + w1 * bflo(b.x) + w2 * bflo(c.x), w0 * bfhi(a.x) + w1 * bfhi(b.x) + w2 * bfhi(c.x));
        o.y = pk2(w0 * bflo(a.y) + w1 * bflo(b.y) + w2 * bflo(c.y), w0 * bfhi(a.y) + w1 * bfhi(b.y) + w2 * bfhi(c.y));
        o.z = pk2(w0 * bflo(a.z) + w1 * bflo(b.z) + w2 * bflo(c.z), w0 * bfhi(a.z) + w1 * bfhi(b.z) + w2 * bfhi(c.z));
        o.w = pk2(w0 * bflo(a.w) + w1 * bflo(b.w) + w2 * bflo(c.w), w0 * bfhi(a.w) + w1 * bfhi(b.w) + w2 * bfhi(c.w));
        *(u32x4*)(OC + (size_t)m * 512 + hh * 128 + (lane & 15) * 8) = o;
    }
}

struct Args { const float* in[22]; float* out; unsigned char* ws; };
#define GEMM_CALL(EPI, E, Aptr, LDA, Bptr, MM, NN, KK) do { pg8::Gemm g_{(Aptr), (Bptr), (LDA), (MM), (NN), (KK)}; pg8::StaticOrder S_; S_.init((MM), (NN), F.G, (int)blockIdx.x); \
        pg8::gemm_phase<EPI, pg8::StaticOrder, true, true>(F.lds, g_, S_, (E)); } while (0)

#define GEMM_CALL_REV(EPI, E, Aptr, LDA, Bptr, MM, NN, KK) do { pg8::Gemm g_{(Aptr), (Bptr), (LDA), (MM), (NN), (KK)}; pg8::RevOrder S_; S_.init((MM), (NN), F.G, (int)blockIdx.x); \
        pg8::gemm_phase<EPI, pg8::RevOrder, true, true>(F.lds, g_, S_, (E)); } while (0)

__global__ void __launch_bounds__(NTHR, 2) fwd_kernel(Args args) {
    extern __shared__ __attribute__((aligned(16))) unsigned char lds_raw[];
    Frame F;
    F.lds = (LAS unsigned char*)lds_raw;
    F.wave = __builtin_amdgcn_readfirstlane(TID_ >> 6);
    F.G = gridDim.x; { const int bx = blockIdx.x; F.vcu = (F.G % 8 == 0) ? (bx % 8) * (F.G / 8) + bx / 8 : bx; }
    F.gw = F.vcu * NWAVES + F.wave; F.NGW = F.G * NWAVES;
    F.ws = args.ws; F.ctl = (gu32*)(args.ws + WS_CTL); F.out = args.out;
    volatile LAS unsigned* MISC = (volatile LAS unsigned*)(F.lds + MISC_OFF);
    for (int u = TID_; u < (LDS_BYTES - LDSCTL_OFF) / 4; u += NTHR) ((LAS unsigned*)(F.lds + LDSCTL_OFF))[u] = 0u;
    __syncthreads();
    if (TID_ < 22) *(LAS unsigned long long*)(F.lds + PTR_OFF + 8 * TID_) = (unsigned long long)args.in[TID_];
    __syncthreads();
    XcdBarrier bar = xcd_barrier_post((unsigned*)(F.ctl + CW_BAR), MISC + 8);
#define GRID_BAR() xcd_barrier(bar)
#ifndef TP
#define TP 0
#endif
#define TPW ((LAS unsigned long long*)(F.lds + LDSCTL_OFF + 768))
#define PB(id) do { if (TP == (id) && TID_ == 0) TPW[0] = __builtin_amdgcn_s_memrealtime(); } while (0)
#define PE(id) do { if (TP == (id) && TID_ == 0) TPW[1] += __builtin_amdgcn_s_memrealtime() - TPW[0]; } while (0)

#define WSL ws_launder(F.ws)
#define XB ((bf16*)(WSL + WS_XB))
#define HB ((bf16*)(WSL + R_H))
#define cosT ((const float*)(WSL + TAB_COS))
#define sinT ((const float*)(WSL + TAB_SIN))
#define ZLO ((bf16*)(F.out + szero()))
#define ZL2 ((bf16*)(WSL + R_KVM))
#define ZLAST ((bf16*)(WSL + R_QM))
#define CQ ((bf16*)(WSL + R_CQ))
#define CKV ((bf16*)(WSL + R_CKV))
#define ZB ((bf16*)(WSL + R_Z))
#define QKV ((bf16*)(WSL + R_QKV))
#define KPE ((bf16*)(WSL + R_KPE))
#define QM ((bf16*)(WSL + R_QM))
#define KVM ((bf16*)(WSL + R_KVM))
#define OA ((bf16*)(WSL + R_OA))
#define OC ((bf16*)(WSL + R_OC))
#define GATE01 ((unsigned char*)(F.out + szero()) + 2 * GATE_PLANE)
#define GATE2 ((unsigned char*)(WSL + R_GATE2))
#define MG ((bf16*)(WSL + R_MERGED))
#define KVX ((bf16*)(WSL + WS_KVX))
#define QX ((bf16*)(WSL + R_QX))
#define OX ((bf16*)(WSL + R_OX))
#define LSE ((float*)(WSL + WS_LSE))
#define WP(off) ((bf16*)(WSL + (off)))
#define ssq_q ((float*)(WSL + CTL_SSQ) + (size_t)(l * 2 + 0) * M)
#define ssq_kv ((float*)(WSL + CTL_SSQ) + (size_t)(l * 2 + 1) * M)
#define STATS(site) ((float*)(WSL + CTL_STATS) + (size_t)(site) * M * 2)
#define SNP(off) ((const float*)(WSL + CTL_SNT) + (size_t)l * 2 * SNT_N + (off))
#define LNG(site) (INP(2) + (size_t)(site) * D)
#define LNB(site) (INP(3) + (size_t)(site) * D)
#define LNFOLD(site, off) LnFold{STATS(site), SNP(off), SNP(off) + SNT_N}
#define NOLN LnFold{nullptr, nullptr, nullptr}

    for (int l = 0; l < DEPTH; ++l) {
        PB(10); p0_prologue(F, l);
        GRID_BAR(); PE(10);
        for (int f = 0; f < 2; ++f) {
            if (f == 1) {
                PB(6); { EpiWinGate E{EpiWin{CQ, CKV, ZB, QKV, KPE, ssq_q, ssq_kv, cosT, sinT, LNFOLD(l * 4 + 0, SNT_WIN)}, EpiGate8{GATE01, GATE2, LNFOLD(l * 4 + 0, SNT_GATE)}};
                  GEMM_CALL(EpiWinGate, E, XB, D, WP(W_IN), M, NWIN + NGATE, D); }
                if ((int)blockIdx.x >= F.G / 2) { EpiBf<0> E{KVX, 1024, nullptr, nullptr, nullptr, NOLN}; pg8::Gemm g_{WP(WS_MEMB), WP(W_XKV), D, BATCH * MEM, 1024, D}; pg8::StaticOrder S_; S_.init(BATCH * MEM, 1024, F.G / 2, (int)blockIdx.x - F.G / 2);
                    pg8::gemm_phase<EpiBf<0>, pg8::StaticOrder, true, true>(F.lds, g_, S_, E); }
                GRID_BAR(); PE(6);
                PB(4); { EpiBf<2> E{QM, QW, ssq_q, cosT, sinT, NOLN}; GEMM_CALL(EpiBf<2>, E, CQ, 512, WP(W_UQ), M, QW, 512); }
                { EpiBf<1> E{KVM, KVW, ssq_kv, nullptr, nullptr, NOLN}; GEMM_CALL(EpiBf<1>, E, CKV, 512, WP(W_UKV), M, KVW, 512); }
                PB(25); for (int u = blockIdx.x; u < BATCH * 16; u += F.G)
                    sgu_unit(F, ZB, INP(12) + l * 512, INP(13) + l * 512, WP(TAB_SGUW), INP(15) + l * 512, u); PE(25);
                for (int u0 = blockIdx.x; u0 < 3 * BATCH * 16 * 4; u0 += 2 * F.G) {
                    const int u = u0 + (F.wave >> 2) * F.G;
                    const int hh = u & 3, blk = (u >> 2) & 15, b = (u >> 6) & 15, g = u >> 10;
                    const int dil = g == 0 ? 1 : (g == 1 ? 4 : 16), nb = 16 / dil;
                    const int r = blk / nb, n = blk - r * nb;
                    LAS float* bl = (LAS float*)(F.lds + AT_BIAS);
                    { const int t_ = vlaunder(TID_); if (t_ < BIAS_STRIDE) bl[t_] = ((const float*)(WSL + TAB_BIAS))[(g * 4 + hh) * BIAS_STRIDE + t_]; }
                    DilSrc src{QKV, LSE + (size_t)g * M * 4 + hh, (size_t)b * SEQ, dil, r, n, (4 * g + hh) * 128};
                    DilMsk msk{bl, 0.08838834764831845f * LOG2E};
                    attn_unit<128, 2, 4>(F, src, msk, n == 0 ? 2 : 0, 4);
                }
                GRID_BAR(); PE(4);
                PB(5); PB(18); for (int u = blockIdx.x; u < BATCH * 8 * 8; u += F.G) {
                    const int c = (F.G == 256) ? F.vcu : u % F.G, i = u / F.G;
                    int bh, qb;
                    if (F.G == 256) { bh = 2 * (c >> 2) + (i & 1); qb = (i >> 1) ? 7 - (c & 3) : (c & 3); } else { bh = u >> 3; qb = u & 7; }
                    const int b = bh >> 3, h = bh & 7;
                    MlaSrc src{QM, KVM, KPE, OA, (size_t)b * SEQ, h, qb * 256};
                    MlaMsk msk{qb * 256, 0.07216878364870322f * LOG2E};
                    attn_unit<192, 2, 8>(F, src, msk, 0, (qb + 1) * 4);
                }
                PE(18); PB(19); dil_combine(F, QKV, LSE, OC); PE(19);
                GRID_BAR(); PE(5);
                PB(2); { EpiMerge E{GATE01, GATE2, MG}; pg8::Gemm g_{nullptr, WP(W_PA), D, M, D, D}; pg8::ASeg3 AS_{OA, ZB, OC, 1024, 512, 16, 24};
                  pg8::StaticOrder S_; S_.init(M, D, F.G, (int)blockIdx.x); pg8::gemm_phase_seg<EpiMerge, pg8::StaticOrder, true, pg8::ASeg3>(F.lds, g_, AS_, S_, E); }
                GRID_BAR(); PE(2);
                PB(3); { EpiResidLn E{nullptr, XB, ZLO, ZLO, STATS(l * 4 + 0), LNG(l * 4 + 0), LNB(l * 4 + 0), STATS(l * 4 + 1), ALPHA, 1.0f}; GEMM_CALL(EpiResidLn, E, MG, D, WP(W_OUT), M, D, D); }
                GRID_BAR(); PE(3);
                { EpiBf<0> E{QX, 512, nullptr, nullptr, nullptr, LNFOLD(l * 4 + 1, SNT_XQ)}; GEMM_CALL(EpiBf<0>, E, XB, D, WP(W_XQ), M, 512, D); }
                GRID_BAR();
                for (int u = blockIdx.x; u < BATCH * 4 * 8; u += F.G) {
                    const int qb = u & 7, h = (u >> 3) & 3, b = u >> 5;
                    XaSrc src{QX, KVX, OX, (size_t)b * SEQ, (size_t)b * MEM, h, qb * 256};
                    XaMsk msk{0.08838834764831845f * LOG2E};
                    attn_unit<128, 2, 8>(F, src, msk, 0, 4);
                }
                GRID_BAR();
                { EpiResidLn E{nullptr, XB, ZLO, (l == DEPTH - 1) ? ZL2 : ZLO, STATS(l * 4 + 1), LNG(l * 4 + 1), LNB(l * 4 + 1), STATS(l * 4 + 2), ALPHA, 1.0f}; GEMM_CALL(EpiResidLn, E, OX, 512, WP(W_XO), M, D, 512); }
                GRID_BAR();
            }
            const int site_in = f ? l * 4 + 2 : l * 4 - 1, site_out = f ? l * 4 + 3 : l * 4;
            const bool raw_in = (l == 0 && f == 0);
            if (TP == 12 || TP == 13) {
                PG8_LAS unsigned long long* st_ = (PG8_LAS unsigned long long*)(F.lds + LDSCTL_OFF + 1024); if (TID_ == 0) st_[0] = (unsigned long long)(unsigned)vlaunder(0); __syncthreads();
                { EpiSwiglu E{HB, raw_in ? NOLN : LNFOLD(site_in, f ? SNT_FFN1 : SNT_FFN0)}; pg8::Gemm g_{XB, WP(f ? W_GU1 : W_GU0), D, M, 2 * FF, D}; pg8::ProbeOrder S_; S_.init(M, 2 * FF, F.G, (int)blockIdx.x); S_.st = st_;
                  pg8::gemm_phase<EpiSwiglu, pg8::ProbeOrder, true, true>(F.lds, g_, S_, E); }
                if (TID_ == 0) TPW[1] += (TP == 12) ? st_[1 + 6] - st_[1 + 0] : st_[1 + 20] - st_[1 + 14];
            } else {
            PB(7); { EpiSwiglu E{HB, raw_in ? NOLN : LNFOLD(site_in, f ? SNT_FFN1 : SNT_FFN0)}; GEMM_CALL(EpiSwiglu, E, XB, D, WP(f ? W_GU1 : W_GU0), M, 2 * FF, D); } }
            GRID_BAR(); PE(7);
            if (TP == 14 || TP == 15) {
                PG8_LAS unsigned long long* st_ = (PG8_LAS unsigned long long*)(F.lds + LDSCTL_OFF + 1024); if (TID_ == 0) st_[0] = (unsigned long long)(unsigned)vlaunder(0); __syncthreads();
                { EpiResidLn E{raw_in ? INP(0) : nullptr, XB, ZLO, (l == DEPTH - 1 && f == 1) ? ZLAST : ZLO, STATS(raw_in ? 0 : site_in), LNG(raw_in ? 0 : site_in), LNB(raw_in ? 0 : site_in), STATS(site_out), ALPHA, 0.5f};
                  pg8::Gemm g_{HB, WP(f ? W_D1 : W_D0), FF_LD, M, D, FF}; pg8::ProbeOrder S_; S_.init(M, D, F.G, (int)blockIdx.x); S_.st = st_;
                  pg8::gemm_phase<EpiResidLn, pg8::ProbeOrder, true, true>(F.lds, g_, S_, E); }
                if (TID_ == 0) TPW[1] += (TP == 14) ? st_[1 + 2] - st_[1 + 0] : st_[1 + 3] - st_[1 + 2];
            } else {
            const bool lastseam = (l == DEPTH - 1 && f == 1);
            if (lastseam && F.G == 256) {
                EpiResidLnFinal E{XB, ZL2, STATS(site_in), LNG(site_in), LNB(site_in), STATS(site_out), (unsigned*)(F.ctl + CW_PCNT), INP(2) + (size_t)7 * D, INP(3) + (size_t)7 * D, F.out + szero(), ALPHA, 0.5f};
                pg8::Gemm g_{HB, WP(W_D1), FF_LD, M, D, FF}; pg8::RevOrder S_; S_.init(M, D, F.G, (int)blockIdx.x); pg8::gemm_phase<EpiResidLnFinal, pg8::RevOrder, true, true>(F.lds, g_, S_, E);
            } else {
            PB(8); { EpiResidLn E{raw_in ? INP(0) : nullptr, XB, lastseam ? ZL2 : ZLO, lastseam ? ZLAST : ZLO, STATS(raw_in ? 0 : site_in), LNG(raw_in ? 0 : site_in), LNB(raw_in ? 0 : site_in), STATS(site_out), ALPHA, 0.5f};
                pg8::Gemm g_{HB, WP(f ? W_D1 : W_D0), FF_LD, M, D, FF}; pg8::RevOrder S_; S_.init(M, D, F.G, (int)blockIdx.x); pg8::gemm_phase<EpiResidLn, pg8::RevOrder, true, true>(F.lds, g_, S_, E); }
            GRID_BAR(); PE(8); } }
            if (TP == 16 || TP == 17) {
                PG8_LAS unsigned long long* st_ = (PG8_LAS unsigned long long*)(F.lds + LDSCTL_OFF + 1024); if (TID_ == 0) st_[0] = (unsigned long long)(unsigned)vlaunder(0); __syncthreads();
                for (int pass_ = 0; pass_ < 2; ++pass_) {
                    EpiBf<0> E{(bf16*)(F.ws + R_KVM + 32 * MiB + szero()), D, nullptr, nullptr, nullptr, NOLN}; pg8::Gemm g_{HB, WP(f ? W_D1 : W_D0), FF_LD, 16384, D, FF}; pg8::ProbeOrder S_; S_.init(16384, D, F.G, (int)blockIdx.x); S_.st = st_;
                    pg8::gemm_phase<EpiBf<0>, pg8::ProbeOrder, true, true>(F.lds, g_, S_, E); GRID_BAR();
                }
                if (TID_ == 0) TPW[1] += (TP == 16) ? st_[1 + 1] - st_[1 + 0] : st_[1 + 3] - st_[1 + 2];
            }
        }
    }
    if (F.G != 256) ln_final(F, XB, ZLAST, F.out + szero(), INP(2) + (size_t)7 * D, INP(3) + (size_t)7 * D);
    if (TP > 0 && blockIdx.x == 0 && TID_ == 0) { const unsigned long long t0 = __builtin_amdgcn_s_memrealtime(); const unsigned long long w_ = 4ull * TPW[1]; while (__builtin_amdgcn_s_memrealtime() - t0 < w_) __builtin_amdgcn_s_sleep(8); }

}

extern "C" void kernel_launch(void* const* d_in, const int* in_sizes, int n_in, void* d_out, int out_size, void* d_ws, size_t ws_size, hipStream_t stream) {
    static int grid = 0;
    if (grid == 0) {
        if (n_in != 22 || in_sizes[0] != M * D || out_size != M * D || ws_size < WS_NEED) {
            fprintf(stderr, "kernel_launch: unexpected problem: n_in %d in0 %d out %d ws %zu (need %zu); nothing launched\n", n_in, n_in > 0 ? in_sizes[0] : -1, out_size, ws_size, (size_t)WS_NEED); grid = -1; return; }
        int dev = 0, cus = 0, per_cu = 0;
        if (hipGetDevice(&dev) != hipSuccess || hipDeviceGetAttribute(&cus, hipDeviceAttributeMultiprocessorCount, dev) != hipSuccess) { grid = -1; return; }
        if (hipFuncSetAttribute((const void*)fwd_kernel, hipFuncAttributeMaxDynamicSharedMemorySize, LDS_BYTES) != hipSuccess) { fprintf(stderr, "kernel_launch: hipFuncSetAttribute failed\n"); grid = -1; return; }
        if (hipOccupancyMaxActiveBlocksPerMultiprocessor(&per_cu, (const void*)fwd_kernel, NTHR, LDS_BYTES) != hipSuccess || per_cu < 1)
            fprintf(stderr, "kernel_launch: note: occupancy query reports %d workgroups per CU\n", per_cu);
        (void)hipGetLastError();
        if (cus != 256) { fprintf(stderr, "kernel_launch: built for a 256-CU device (unit deals and the paired dilated-attention units assume 256 workgroups), found %d CUs; nothing launched\n", cus); grid = -1; return; }
        grid = cus;
    }
    if (grid < 0) return;
    if (hipMemsetAsync((char*)d_ws + WS_CTL, 0, CTL_ZERO_BYTES, stream) != hipSuccess) return;
    Args a{};
    for (int i = 0; i < 22; ++i) a.in[i] = (const float*)d_in[i];
    a.out = (float*)d_out; a.ws = (unsigned char*)d_ws;
    hipLaunchKernelGGL(fwd_kernel, dim3(grid), dim3(NTHR), LDS_BYTES, stream, a);
    const hipError_t le = hipPeekAtLastError();
    if (le != hipSuccess) fprintf(stderr, "kernel_launch: launch failed: %s\n", hipGetErrorName(le));
}
```
